# Optimizing an MI355X kernel written in HIP

```python
import math
import jax, jax.numpy as jnp
from jax import lax
import numpy as np

D_MODEL = 2048
BATCH = 4
SEQ = 8192
DEPTH = 2

PLE_DIM = 256
D_FF = 5632
MIX_WIDTH = D_MODEL
GROUP_WIDTH = MIX_WIDTH // 4

A_HEADS = 4
A_HEAD_DIM = GROUP_WIDTH // (2 * A_HEADS)
A_QBLOCK = 128
N_BUCKETS = 32
MAX_DISTANCE = 128

B_HEADS = 4
B_HEAD_DIM = GROUP_WIDTH // B_HEADS
B_CHUNK = 128
ROPE_BASE = 10000.0

C_GROUPS = 4
C_CHUNK = 128
C_GROUP_DIM = GROUP_WIDTH // C_GROUPS

D_HEADS = 4
D_EXPAND = 128
D_HEAD_DIM = GROUP_WIDTH // D_HEADS
D_CHUNK = 64

A_COLS = 3 * GROUP_WIDTH
B_COLS = 4 * GROUP_WIDTH
C_COLS = 2 * GROUP_WIDTH
D_COLS = 4 * GROUP_WIDTH
IN_COLS = A_COLS + B_COLS + C_COLS + D_COLS

ALPHA = (2 * DEPTH) ** 0.25
BETA = (8 * DEPTH) ** -0.25
LN_EPS = 1e-5
MASK_VALUE = -1e30
LB_FLOOR = 1e-30

kernel_name = "hybrid_parallel_heads_diffattn_retnet_gmlp_hgrn2"


def layer_norm(x, g, b):
    xf = x.astype(jnp.float32)
    mu = jnp.mean(xf, axis=-1, keepdims=True)
    var = jnp.mean(jnp.square(xf - mu), axis=-1, keepdims=True)
    return ((xf - mu) * lax.rsqrt(var + LN_EPS) * g.astype(jnp.float32) + b.astype(jnp.float32)).astype(x.dtype)


def head_norm(x):
    xf = x.astype(jnp.float32)
    mu = jnp.mean(xf, axis=-1, keepdims=True)
    var = jnp.mean(jnp.square(xf - mu), axis=-1, keepdims=True)
    return ((xf - mu) * lax.rsqrt(var + LN_EPS)).astype(x.dtype)


def rms_norm(x, g):
    xf = x.astype(jnp.float32)
    return (xf * lax.rsqrt(jnp.mean(xf * xf, axis=-1, keepdims=True) + LN_EPS) * g.astype(jnp.float32)).astype(x.dtype)


def swiglu(x, w_in, w_out):
    gate, up = jnp.split(x @ w_in, 2, axis=-1)
    return (jax.nn.silu(gate) * up) @ w_out


def t5_bucket(n):
    n = jnp.maximum(n, 0)
    max_exact = N_BUCKETS // 2
    nf = jnp.maximum(n, 1).astype(jnp.float32)
    large = max_exact + (jnp.log(nf / max_exact) / math.log(MAX_DISTANCE / max_exact)
                         * (N_BUCKETS - max_exact)).astype(jnp.int32)
    large = jnp.minimum(large, N_BUCKETS - 1)
    return jnp.where(n < max_exact, n, large)


def rotary(x, positions):
    d = x.shape[-1]
    inv = ROPE_BASE ** (-jnp.linspace(0.0, 1.0, d // 2, dtype=jnp.float32))
    ang = positions.astype(jnp.float32)[..., None] * inv
    cos, sin = jnp.cos(ang)[:, :, None, :], jnp.sin(ang)[:, :, None, :]
    xf = x.astype(jnp.float32)
    x1, x2 = xf[..., 0::2], xf[..., 1::2]
    out = jnp.stack([x1 * cos - x2 * sin, x1 * sin + x2 * cos], axis=-1)
    return out.reshape(x.shape).astype(x.dtype)


def diff_attention(q, k, v, positions, rel_bias, lam, lam_init, norm_g):
    bsz, seq = q.shape[:2]
    nb = seq // A_QBLOCK
    scale = A_HEAD_DIM ** -0.5
    qb = jnp.moveaxis(q.reshape(bsz, nb, A_QBLOCK, A_HEADS, 2, A_HEAD_DIM), 1, 0)
    pb = jnp.moveaxis(positions.reshape(bsz, nb, A_QBLOCK), 1, 0)
    starts = jnp.arange(nb, dtype=jnp.int32) * A_QBLOCK
    k_idx = jnp.arange(seq, dtype=jnp.int32)

    def block(args):
        qi, pi, s0 = args
        logits = jnp.einsum('bqhcd,bkhcd->bhcqk', qi, k).astype(jnp.float32) * scale
        rel = pi[:, :, None] - positions[:, None, :]
        bias = jnp.moveaxis(rel_bias.astype(jnp.float32)[t5_bucket(rel)], -1, 1)
        q_idx = s0 + jnp.arange(A_QBLOCK, dtype=jnp.int32)
        causal = q_idx[:, None] >= k_idx[None, :]
        logits = jnp.where(causal, logits + bias[:, :, None], MASK_VALUE)
        probs = jax.nn.softmax(logits, axis=-1)
        w = probs[:, :, 0] - lam * probs[:, :, 1]
        return jnp.einsum('bhqk,bkhd->bqhd', w.astype(v.dtype), v)

    o = lax.map(block, (qb, pb, starts))
    o = jnp.moveaxis(o, 0, 1).reshape(bsz, seq, A_HEADS, 2 * A_HEAD_DIM)
    o = rms_norm(o, norm_g) * (1.0 - lam_init)
    return o.reshape(bsz, seq, GROUP_WIDTH)


def retention(q, k, v, g):
    bsz, seq = q.shape[:2]
    n = seq // B_CHUNK
    log_g = jnp.log(1.0 - 2.0 ** (-5.0 - jnp.arange(B_HEADS, dtype=jnp.float32)))
    j = jnp.arange(B_CHUNK, dtype=jnp.float32)
    diff = j[:, None] - j[None, :]
    decay_mask = jnp.where(diff >= 0, jnp.exp(log_g[:, None, None] * jnp.maximum(diff, 0.0)), 0.0)
    q_dec = jnp.exp(log_g[None, :] * (j[:, None] + 1.0))
    k_dec = jnp.exp(log_g[:, None] * (B_CHUNK - 1.0 - j[None, :]))
    chunk_dec = jnp.exp(log_g * B_CHUNK)
    k = k * (B_HEAD_DIM ** -0.5)

    def to_chunks(t):
        return jnp.moveaxis(t.astype(jnp.float32).reshape(bsz, n, B_CHUNK, B_HEADS, -1), 1, 0)

    def step(state, inp):
        qc, kc, vc = inp
        scores = jnp.einsum('bthd,bshd->bhts', qc, kc) * decay_mask
        o = jnp.einsum('bhts,bshd->bthd', scores, vc)
        o = o + jnp.einsum('bthd,bhde->bthe', qc, state) * q_dec[None, :, :, None]
        state = state * chunk_dec[None, :, None, None] + jnp.einsum('bshd,bshe,hs->bhde', kc, vc, k_dec)
        return state, o

    s0 = jnp.zeros((bsz, B_HEADS, B_HEAD_DIM, B_HEAD_DIM), jnp.float32)
    _, o = lax.scan(step, s0, (to_chunks(q), to_chunks(k), to_chunks(v)))
    o = jnp.moveaxis(o, 0, 1).reshape(bsz, seq, B_HEADS, B_HEAD_DIM)
    o = head_norm(o).reshape(bsz, seq, GROUP_WIDTH).astype(v.dtype)
    return o * jax.nn.silu(g)


def spatial_gating(u, v, w_s, b_s, ln_g, ln_b):
    bsz, seq = u.shape[:2]
    n = seq // C_CHUNK
    v = layer_norm(v, ln_g, ln_b)
    vc = v.reshape(bsz, n, C_CHUNK, C_GROUPS, C_GROUP_DIM)
    mask = jnp.tril(jnp.ones((C_CHUNK, C_CHUNK), dtype=w_s.dtype))
    w = w_s * mask[None]
    mixed = jnp.einsum('gts,bnsgc->bntgc', w, vc) + b_s.T[:, :, None]
    return u * mixed.reshape(bsz, seq, GROUP_WIDTH)


def hgrn2(q, f_raw, i_in, g, lb, norm_g):
    bsz, seq = q.shape[:2]
    n = seq // D_CHUNK
    lb = lb.reshape(D_HEADS, D_EXPAND).astype(jnp.float32)
    z = f_raw.astype(jnp.float32)
    log_lb = jnp.log(jnp.maximum(lb, LB_FLOOR))
    log_f = jnp.logaddexp(jax.nn.log_sigmoid(z), log_lb + jax.nn.log_sigmoid(-z))
    key = -jnp.expm1(log_f)
    causal = jnp.tril(jnp.ones((D_CHUNK, D_CHUNK), dtype=bool))

    def to_chunks(t):
        return jnp.moveaxis(t.astype(jnp.float32).reshape(bsz, n, D_CHUNK, D_HEADS, -1), 1, 0)

    def step(state, inp):
        qc, kc, vc, lfc = inp
        b = jnp.cumsum(lfc, axis=1)
        o_inter = jnp.einsum('bthk,bhkv->bthv', qc * jnp.exp(b), state)
        rel = jnp.where(causal[None, :, :, None, None], b[:, :, None] - b[:, None, :], MASK_VALUE)
        a = jnp.einsum('bthk,bshk,btshk->bhts', qc, kc, jnp.exp(rel))
        o_intra = jnp.einsum('bhts,bshv->bthv', a, vc)
        b_last = b[:, -1]
        state = state * jnp.exp(b_last)[..., None] + jnp.einsum(
            'bshk,bshv->bhkv', kc * jnp.exp(b_last[:, None] - b), vc)
        return state, o_inter + o_intra

    s0 = jnp.zeros((bsz, D_HEADS, D_EXPAND, D_HEAD_DIM), jnp.float32)
    _, o = lax.scan(step, s0, (to_chunks(q), to_chunks(key), to_chunks(i_in), to_chunks(log_f)))
    o = jnp.moveaxis(o, 0, 1).reshape(bsz, seq, GROUP_WIDTH).astype(i_in.dtype)
    return rms_norm(o, norm_g) * jax.nn.silu(g)


def token_mixing(x, positions, layer_idx, w_in, w_out, rel_bias, diff_lambda, diff_norm_g,
                 gmlp_ln_g, gmlp_ln_b, gmlp_w_s, gmlp_b_s, lower_bound, hgrn_norm_g):
    bsz, seq = x.shape[:2]
    h = x @ w_in
    a_part, b_part, c_part, d_part = jnp.split(
        h, [A_COLS, A_COLS + B_COLS, A_COLS + B_COLS + C_COLS], axis=-1)

    qa, ka, va = jnp.split(a_part, 3, axis=-1)
    qa = qa.reshape(bsz, seq, A_HEADS, 2, A_HEAD_DIM)
    ka = ka.reshape(bsz, seq, A_HEADS, 2, A_HEAD_DIM)
    va = va.reshape(bsz, seq, A_HEADS, 2 * A_HEAD_DIM)
    lam_init = 0.8 - 0.6 * math.exp(-0.3 * layer_idx)
    lq1, lk1, lq2, lk2 = [diff_lambda[j].astype(jnp.float32) for j in range(4)]
    lam = jnp.exp(jnp.sum(lq1 * lk1)) - jnp.exp(jnp.sum(lq2 * lk2)) + lam_init
    out_a = diff_attention(qa, ka, va, positions, rel_bias, lam, lam_init, diff_norm_g)

    qb, kb, vb, gb = jnp.split(b_part, 4, axis=-1)
    qb = rotary(qb.reshape(bsz, seq, B_HEADS, B_HEAD_DIM), positions)
    kb = rotary(kb.reshape(bsz, seq, B_HEADS, B_HEAD_DIM), positions)
    vb = vb.reshape(bsz, seq, B_HEADS, B_HEAD_DIM)
    out_b = retention(qb, kb, vb, gb)

    uc, vc = jnp.split(jax.nn.gelu(c_part, approximate=False), 2, axis=-1)
    out_c = spatial_gating(uc, vc, gmlp_w_s, gmlp_b_s, gmlp_ln_g, gmlp_ln_b)

    qd, fd, idd, gd = jnp.split(d_part, 4, axis=-1)
    out_d = hgrn2(qd.reshape(bsz, seq, D_HEADS, D_EXPAND), fd.reshape(bsz, seq, D_HEADS, D_EXPAND),
                  idd.reshape(bsz, seq, D_HEADS, D_HEAD_DIM), gd, lower_bound, hgrn_norm_g)

    return jnp.concatenate([out_a, out_b, out_c, out_d], axis=-1) @ w_out


def setup_inputs(seed: int = 0) -> dict:
    key = jax.random.key(seed)
    ks = jax.random.split(key, 24)
    f32 = jnp.float32

    def nrm(k, shape, fan_in, gain=1.0):
        return jax.random.normal(k, shape, f32) * (fan_in ** -0.5) * gain

    x = jax.random.normal(ks[0], (BATCH, SEQ, D_MODEL), f32)
    p = jax.random.normal(ks[1], (DEPTH, BATCH, SEQ, PLE_DIM), f32)
    offset = jax.random.randint(ks[2], (BATCH, 1), 0, 1024, dtype=jnp.int32)
    positions = offset + jnp.arange(SEQ, dtype=jnp.int32)[None, :]
    return {
        "x": x,
        "p": p,
        "positions": positions,
        "ffn1_w_in": nrm(ks[3], (DEPTH, D_MODEL, 2 * D_FF), D_MODEL),
        "ffn1_w_out": nrm(ks[4], (DEPTH, D_FF, D_MODEL), D_FF, BETA),
        "w_mix_in": nrm(ks[5], (DEPTH, D_MODEL, IN_COLS), D_MODEL),
        "w_mix_out": nrm(ks[6], (DEPTH, MIX_WIDTH, D_MODEL), MIX_WIDTH, BETA),
        "rel_bias": 0.1 * jax.random.normal(ks[7], (N_BUCKETS, A_HEADS), f32),
        "diff_lambda": 0.1 * jax.random.normal(ks[8], (DEPTH, 4, A_HEAD_DIM), f32),
        "diff_norm_g": 1.0 + 0.02 * jax.random.normal(ks[9], (DEPTH, 2 * A_HEAD_DIM), f32),
        "gmlp_ln_g": 1.0 + 0.02 * jax.random.normal(ks[10], (DEPTH, GROUP_WIDTH), f32),
        "gmlp_ln_b": 0.02 * jax.random.normal(ks[11], (DEPTH, GROUP_WIDTH), f32),
        "gmlp_w_s": nrm(ks[12], (DEPTH, C_GROUPS, C_CHUNK, C_CHUNK), C_CHUNK),
        "gmlp_b_s": 1.0 + 0.02 * jax.random.normal(ks[13], (DEPTH, C_GROUPS, C_CHUNK), f32),
        "hgrn_lb_logits": 0.5 * jax.random.normal(ks[14], (DEPTH, D_HEADS * D_EXPAND), f32),
        "hgrn_norm_g": 1.0 + 0.02 * jax.random.normal(ks[15], (DEPTH, GROUP_WIDTH), f32),
        "ffn2_w_in": nrm(ks[16], (DEPTH, D_MODEL, 2 * D_FF), D_MODEL),
        "ffn2_w_out": nrm(ks[17], (DEPTH, D_FF, D_MODEL), D_FF, BETA),
        "ple_w_gate": nrm(ks[18], (DEPTH, D_MODEL, D_MODEL), D_MODEL),
        "ple_w_proj": nrm(ks[19], (DEPTH, PLE_DIM, D_MODEL), PLE_DIM, BETA),
        "ln_g": 1.0 + 0.02 * jax.random.normal(ks[20], (DEPTH, 4, D_MODEL), f32),
        "ln_b": 0.02 * jax.random.normal(ks[21], (DEPTH, 4, D_MODEL), f32),
    }


def reference(x, p, positions, ffn1_w_in, ffn1_w_out, w_mix_in, w_mix_out, rel_bias, diff_lambda,
              diff_norm_g, gmlp_ln_g, gmlp_ln_b, gmlp_w_s, gmlp_b_s, hgrn_lb_logits, hgrn_norm_g,
              ffn2_w_in, ffn2_w_out, ple_w_gate, ple_w_proj, ln_g, ln_b):
    lb_soft = jax.nn.softmax(hgrn_lb_logits.astype(jnp.float32), axis=0)
    lower_bounds = jnp.cumsum(lb_soft, axis=0) - lb_soft[0]
    for i in range(DEPTH):
        x = layer_norm(ALPHA * x + 0.5 * swiglu(x, ffn1_w_in[i], ffn1_w_out[i]), ln_g[i, 0], ln_b[i, 0])
        mix = token_mixing(x, positions, i, w_mix_in[i], w_mix_out[i], rel_bias, diff_lambda[i],
                           diff_norm_g[i], gmlp_ln_g[i], gmlp_ln_b[i], gmlp_w_s[i], gmlp_b_s[i],
                           lower_bounds[i], hgrn_norm_g[i])
        x = layer_norm(ALPHA * x + mix, ln_g[i, 1], ln_b[i, 1])
        x = layer_norm(ALPHA * x + 0.5 * swiglu(x, ffn2_w_in[i], ffn2_w_out[i]), ln_g[i, 2], ln_b[i, 2])
        gate = jax.nn.sigmoid(x @ ple_w_gate[i])
        x = layer_norm(ALPHA * x + gate * (p[i] @ ple_w_proj[i]), ln_g[i, 3], ln_b[i, 3])
    return x
```

```cpp
#include <hip/hip_runtime.h>
#include <hip/hip_cooperative_groups.h>
#include <math.h>
#include <stdio.h>
#include <string.h>
namespace cg = cooperative_groups;

#define LAS __attribute__((address_space(3)))
typedef unsigned short bf16_t;
typedef short bf16x8 __attribute__((ext_vector_type(8)));
typedef short s16x4 __attribute__((ext_vector_type(4)));
typedef float f32x2 __attribute__((ext_vector_type(2)));
typedef float f32x4 __attribute__((ext_vector_type(4)));
typedef float f32x16 __attribute__((ext_vector_type(16)));
typedef unsigned u32x2 __attribute__((ext_vector_type(2)));
typedef unsigned u32x4 __attribute__((ext_vector_type(4)));

constexpr int MTOK = 32768, SEQ = 8192, DM = 2048, DFF = 5632, INC = 6656, PLE = 256, DEPTH = 2;
constexpr float ALPHA = 1.41421356237f;
constexpr float LOG2E = 1.44269504089f;
constexpr int LDS_BYTES = 147456;
constexpr int NPH = 1 + 13 * DEPTH;

constexpr size_t SZ_W1IN = (size_t)2 * DFF * DM * 2, SZ_W1OUT = (size_t)DM * DFF * 2, SZ_WMI = (size_t)INC * DM * 2, SZ_WMO = (size_t)DM * DM * 2,
                 SZ_WG = (size_t)DM * DM * 2, SZ_WE = (size_t)DM * PLE * 2;
constexpr size_t WS_W1IN = 0, WS_W1OUT = WS_W1IN + DEPTH * SZ_W1IN, WS_WMI = WS_W1OUT + DEPTH * SZ_W1OUT, WS_WMO = WS_WMI + DEPTH * SZ_WMI,
                 WS_W2IN = WS_WMO + DEPTH * SZ_WMO, WS_W2OUT = WS_W2IN + DEPTH * SZ_W1IN, WS_WG = WS_W2OUT + DEPTH * SZ_W1OUT, WS_WE = WS_WG + DEPTH * SZ_WG,
                 WS_H = WS_WE + DEPTH * SZ_WE, WS_XB = WS_H + (size_t)MTOK * INC * 2, WS_PB = WS_XB + (size_t)MTOK * DM * 2,
                 WS_CS = WS_PB + (size_t)DEPTH * MTOK * PLE * 2, WS_SSQ = WS_CS + (size_t)MTOK * 64 * 8, WS_TAB = WS_SSQ + (size_t)MTOK * 4 * 4,
                 WS_STAT = WS_TAB + 65536, WS_END = WS_STAT + (size_t)2 * MTOK * 4 * 8 * 2 * 4;
constexpr int TB_LOGLB = 0  , TB_LUT = 1024  , TB_LAM = 1600  , TB_PMAX = 1664  , TB_Q = 2304  ;

struct Params {
    const float* x; const float* p; const int* pos;
    const float *ffn1_in, *ffn1_out, *mix_in, *mix_out, *rel_bias, *dlam, *dnorm_g, *g_ln_g, *g_ln_b, *g_ws, *g_bs, *lb_logits, *hg_norm_g,
        *ffn2_in, *ffn2_out, *ple_gate, *ple_proj, *ln_g, *ln_b;
    float* out; unsigned char* ws;
    int ph_lo, ph_hi;
    double inv[64];
};

__device__ __forceinline__ unsigned cvt_pk_bf16(float lo, float hi) { unsigned r; asm("v_cvt_pk_bf16_f32 %0, %1, %2" : "=v"(r) : "v"(lo), "v"(hi)); return r; }
__device__ __forceinline__ float bf_lo(unsigned w) { return __uint_as_float(w << 16); }
__device__ __forceinline__ float bf_hi(unsigned w) { return __uint_as_float(w & 0xffff0000u); }
__device__ __forceinline__ unsigned off_b(unsigned row, unsigned ch) { return 256u * row + 16u * (ch ^ (((row & 3u) << 2) | ((row >> 2) & 3u))); }
__device__ __forceinline__ s16x4 tr_read(LAS const unsigned char* img, unsigned lane, unsigned rowbase, unsigned c) {
    const unsigned blk = (lane >> 4) & 1u, qq = (lane & 15u) >> 2, p = lane & 3u;
    return __builtin_amdgcn_ds_read_tr16_b64_v4i16((LAS s16x4*)(img + off_b(rowbase + qq, 4u * c + 2u * blk + (p >> 1)) + 8u * (p & 1u)));
}
__device__ __forceinline__ bf16x8 cat8(s16x4 a, s16x4 b) { bf16x8 r; r[0] = a[0]; r[1] = a[1]; r[2] = a[2]; r[3] = a[3]; r[4] = b[0]; r[5] = b[1]; r[6] = b[2]; r[7] = b[3]; return r; }
__device__ __forceinline__ bf16x8 pack8(float a0, float a1, float a2, float a3, float a4, float a5, float a6, float a7) {
    u32x4 w; w.x = cvt_pk_bf16(a0, a1); w.y = cvt_pk_bf16(a2, a3); w.z = cvt_pk_bf16(a4, a5); w.w = cvt_pk_bf16(a6, a7);
    return __builtin_bit_cast(bf16x8, w);
}
__device__ __forceinline__ f32x16 mfma32(bf16x8 a, bf16x8 b, f32x16 c) { return __builtin_amdgcn_mfma_f32_32x32x16_bf16(a, b, c, 0, 0, 0); }
__device__ __forceinline__ float silu_f(float v) { return v * __builtin_amdgcn_rcpf(1.0f + __expf(-v)); }
__device__ __forceinline__ float shx(float v, int off, int lane) { return __int_as_float(__builtin_amdgcn_ds_bpermute((lane ^ off) << 2, __float_as_int(v))); }
__device__ __forceinline__ int shxi(int v, int off, int lane) { return __builtin_amdgcn_ds_bpermute((lane ^ off) << 2, v); }
__device__ __forceinline__ float swapadd16(float a, float b) { auto r = __builtin_amdgcn_permlane16_swap(__float_as_uint(a), __float_as_uint(b), false, false); return __uint_as_float(r[0]) + __uint_as_float(r[1]); }
__device__ __forceinline__ float swapadd32(float a, float b) { auto r = __builtin_amdgcn_permlane32_swap(__float_as_uint(a), __float_as_uint(b), false, false); return __uint_as_float(r[0]) + __uint_as_float(r[1]); }
__device__ __forceinline__ int opaque_tid() { int t = threadIdx.x; asm volatile("" : "+v"(t)); return t; }
__device__ __forceinline__ int opaque_bid() { int t = blockIdx.x; asm volatile("" : "+s"(t)); return t; }
__device__ __forceinline__ f32x16 zero16() { f32x16 z; for (int i = 0; i < 16; ++i) z[i] = 0.f; return z; }

namespace pg8 {
constexpr int BM = 256, BK = 64, HALF = 128, HTB = HALF * BK * 2, STAGE_BYTES = 8 * HTB, NXCD = 8, WGM = 8;
__device__ __forceinline__ int lds_byte(int r, int c) { const int st = (r >> 4) * 2 + (c >> 5), rr = r & 15, cc = c & 31, ob = rr * 64 + cc * 2; return st * 1024 + (ob ^ (((ob >> 9) & 1) << 5)); }
__device__ __forceinline__ void stage_rc(int b, int& R, int& C) { const int st = b / 1024, sb = b % 1024, swz = sb ^ (((sb >> 9) & 1) << 5); R = (st >> 1) * 16 + swz / 64; C = (st & 1) * 32 + (swz % 64) / 2; }
__device__ __forceinline__ int perm32(int rho) { const int n = rho >> 4, i = rho & 15; return 8 * (i >> 2) + 4 * n + (i & 3); }
struct Unit { int pm, pn; };
struct Gemm { const bf16_t* A; const bf16_t* Bt; int M, N, K; };
struct StaticOrder {
    int nM, nN, nwg, G, c;
    __device__ void init(int M, int N, int G_, int c_) { nM = M / BM; nN = N / BM; nwg = nM * nN; G = G_; c = c_; }
    __device__ bool next(int i, Unit& u) const {
        const long L = (long)i * G + c; if (L >= nwg) return false;
        int wgid = (int)L; { const int q = nwg / NXCD, r = nwg % NXCD, xcd = wgid % NXCD, off = wgid / NXCD; wgid = (xcd < r ? xcd * (q + 1) : r * (q + 1) + (xcd - r) * q) + off; }
        const int nig = WGM * nN, gid = wgid / nig, fm = gid * WGM, gsz = (nM - fm) < WGM ? (nM - fm) : WGM;
        u.pm = fm + ((wgid % nig) % gsz); u.pn = (wgid % nig) / gsz; return true;
    }
};
template <class Epi>
__device__ __forceinline__ void gemm_phase(LAS unsigned char* lds, const Gemm g, const StaticOrder& S, const Epi& E) {
    const int tid = opaque_tid(), wid = __builtin_amdgcn_readfirstlane(tid >> 6), lane = tid & 63, wr = wid >> 2, wc = wid & 3, fr = lane & 15, fq = lane >> 4;
    const int K = g.K, nt = K / BK;
    unsigned voffA[2], voffB[2];
#pragma unroll
    for (int i = 0; i < 2; ++i) { int R, C; stage_rc(tid * 16 + i * 8192, R, C); const int Rb = Epi::PERM ? ((R & ~31) + perm32(R & 31)) : R;
        voffA[i] = (unsigned)(R * K + C) * 2u; voffB[i] = (unsigned)(Rb * K + C) * 2u; }
    const size_t kstep = (size_t)(BK * 2), hstep = (size_t)HALF * K * 2, tstep = 2 * hstep;
    const unsigned ldsw = (unsigned)wid * 1024u;
    const int aoff = lds_byte(wr * 64 + fr, fq * 8), boff = lds_byte(wc * 32 + fr, fq * 8);
#define PG8_SA(b, h) (((b) * 2 + (h)) * HTB)
#define PG8_SB(b, h) ((4 + (b) * 2 + (h)) * HTB)
#define PG8_STAGE(bufoff, gbase, voff) do { _Pragma("unroll") for (int _i = 0; _i < 2; ++_i) \
        __builtin_amdgcn_global_load_lds((const unsigned*)((const char*)(gbase) + (voff)[_i]), (LAS unsigned*)(lds + (bufoff) + ldsw + _i * 8192), 16, 0, 0); } while (0)
#define PG8_LDA(dst, b, h) do { _Pragma("unroll") for (int m = 0; m < 4; ++m) _Pragma("unroll") for (int k = 0; k < 2; ++k) dst[m][k] = *(const LAS bf16x8*)(lds + PG8_SA(b, h) + aoff + m * 2048 + k * 1024); } while (0)
#define PG8_LDB(dst, b, h) do { _Pragma("unroll") for (int n = 0; n < 2; ++n) _Pragma("unroll") for (int k = 0; k < 2; ++k) dst[n][k] = *(const LAS bf16x8*)(lds + PG8_SB(b, h) + boff + n * 2048 + k * 1024); } while (0)
#define PG8_MMA(ai, bj, At, Bt) do { __builtin_amdgcn_s_setprio(1); _Pragma("unroll") for (int m = 0; m < 4; ++m) _Pragma("unroll") for (int n = 0; n < 2; ++n) _Pragma("unroll") for (int k = 0; k < 2; ++k) \
        acc[ai][bj][m][n] = __builtin_amdgcn_mfma_f32_16x16x32_bf16(Bt[n][k], At[m][k], acc[ai][bj][m][n], 0, 0, 0); __builtin_amdgcn_s_setprio(0); } while (0)
#define PG8_WAIT_V(n) asm volatile("s_waitcnt vmcnt(" #n ")" ::: "memory")
#define PG8_WAIT_L(n) asm volatile("s_waitcnt lgkmcnt(" #n ")" ::: "memory")
#define PG8_BAR __builtin_amdgcn_s_barrier()
#define PG8_SCHED __builtin_amdgcn_sched_barrier(0)
    Unit cur, nxt; int ui = 0;
    if (!S.next(0, cur)) return;
    f32x4 acc[2][2][4][2];
#pragma unroll
    for (int a = 0; a < 2; ++a)
#pragma unroll
        for (int b = 0; b < 2; ++b)
#pragma unroll
            for (int m = 0; m < 4; ++m)
#pragma unroll
                for (int n = 0; n < 2; ++n) acc[a][b][m][n] = (f32x4){0.f, 0.f, 0.f, 0.f};
    bf16x8 At[4][2], B0[2][2], B1[2][2];
    const char* cA = (const char*)g.A + (size_t)cur.pm * tstep; const char* cB = (const char*)g.Bt + (size_t)cur.pn * tstep;
    PG8_STAGE(PG8_SB(0, 0), cB, voffB); PG8_STAGE(PG8_SA(0, 0), cA, voffA); PG8_STAGE(PG8_SB(0, 1), cB + hstep, voffB); PG8_STAGE(PG8_SA(0, 1), cA + hstep, voffA);
    if (wr == 1) PG8_BAR;
    PG8_WAIT_V(4); PG8_BAR;
    PG8_STAGE(PG8_SB(1, 0), cB + kstep, voffB); PG8_STAGE(PG8_SA(1, 0), cA + kstep, voffA); PG8_STAGE(PG8_SB(1, 1), cB + hstep + kstep, voffB);
    PG8_WAIT_V(6); PG8_BAR;
    for (;;) {
        const bool has_next = S.next(ui + 1, nxt);
        const char* nA = has_next ? (const char*)g.A + (size_t)nxt.pm * tstep : cA; const char* nB = has_next ? (const char*)g.Bt + (size_t)nxt.pn * tstep : cB;
        for (int t = 0; t < nt; t += 2) {
            const bool last = (t == nt - 2);
            const char* a1 = cA + (size_t)(t + 1) * kstep;
            const char* a2 = last ? nA : cA + (size_t)(t + 2) * kstep; const char* b2 = last ? nB : cB + (size_t)(t + 2) * kstep;
            const char* a3 = a2 + kstep; const char* b3 = b2 + kstep;
            PG8_LDB(B0, 0, 0); PG8_SCHED; PG8_LDA(At, 0, 0); PG8_STAGE(PG8_SA(1, 1), a1 + hstep, voffA);
            PG8_WAIT_L(8); PG8_BAR; PG8_WAIT_L(0); PG8_MMA(0, 0, At, B0); PG8_BAR; PG8_SCHED;
            PG8_LDB(B1, 0, 1); PG8_STAGE(PG8_SB(0, 0), b2, voffB);
            PG8_BAR; PG8_WAIT_L(0); PG8_MMA(0, 1, At, B1); PG8_BAR;
            PG8_LDA(At, 0, 1); PG8_STAGE(PG8_SA(0, 0), a2, voffA);
            PG8_BAR; PG8_WAIT_L(0); PG8_MMA(1, 0, At, B0); PG8_BAR; PG8_SCHED;
            PG8_STAGE(PG8_SB(0, 1), b2 + hstep, voffB);
            PG8_WAIT_V(6); PG8_BAR; PG8_MMA(1, 1, At, B1); PG8_BAR;
            PG8_LDB(B0, 1, 0); PG8_SCHED; PG8_LDA(At, 1, 0); PG8_STAGE(PG8_SA(0, 1), a2 + hstep, voffA);
            PG8_WAIT_L(8); PG8_BAR; PG8_WAIT_L(0); PG8_MMA(0, 0, At, B0); PG8_BAR; PG8_SCHED;
            PG8_LDB(B1, 1, 1); PG8_STAGE(PG8_SB(1, 0), b3, voffB);
            PG8_BAR; PG8_WAIT_L(0); PG8_MMA(0, 1, At, B1); PG8_BAR;
            PG8_LDA(At, 1, 1); PG8_STAGE(PG8_SA(1, 0), a3, voffA);
            PG8_BAR; PG8_WAIT_L(0); PG8_MMA(1, 0, At, B0); PG8_BAR; PG8_SCHED;
            PG8_STAGE(PG8_SB(1, 1), b3 + hstep, voffB);
            PG8_WAIT_V(6); PG8_BAR; PG8_MMA(1, 1, At, B1); PG8_BAR;
        }
        E(acc, cur, wr, wc, fr, fq);
        if (!has_next) break;
#pragma unroll
        for (int a = 0; a < 2; ++a)
#pragma unroll
            for (int b = 0; b < 2; ++b)
#pragma unroll
                for (int m = 0; m < 4; ++m)
#pragma unroll
                    for (int n = 0; n < 2; ++n) acc[a][b][m][n] = (f32x4){0.f, 0.f, 0.f, 0.f};
        cur = nxt; cA = nA; cB = nB; ++ui;
    }
    PG8_WAIT_V(0);
    if (wr == 0) PG8_BAR;
    PG8_BAR;
#undef PG8_SA
#undef PG8_SB
#undef PG8_STAGE
#undef PG8_LDA
#undef PG8_LDB
#undef PG8_MMA
#undef PG8_WAIT_V
#undef PG8_WAIT_L
#undef PG8_BAR
#undef PG8_SCHED
}
}
using pg8::Unit; using pg8::BM; using pg8::HALF;
typedef f32x4 Acc[2][2][4][2];

__device__ __forceinline__ float gelu_f(float v) {
    const float av = fabsf(v), t = __builtin_amdgcn_rcpf(av * 0.2316418882f + 1.0f);
    float q = t * 0.5307027145f + (-0.7265760135f); q = q * t + 0.7107068705f; q = q * t + (-0.142248368f); q = q * t + 0.127414796f; q = q * t;
    const float e = __builtin_amdgcn_exp2f((v * v) * (-0.72134752044f));
    const float m = v * (q * e);
    return v < 0.f ? m : v - m;
}

struct EpiSwiGLU {
    static constexpr bool PERM = true;
    bf16_t* H;
    __device__ __forceinline__ void operator()(const Acc& acc, const Unit& u, int wr, int wc, int fr, int fq) const {
        const int row0 = u.pm * BM + wr * 64 + fr, col0 = u.pn * 128 + wc * 32 + 8 * fq;
#pragma unroll
        for (int ai = 0; ai < 2; ++ai)
#pragma unroll
            for (int m = 0; m < 4; ++m) {
                float h[8];
#pragma unroll
                for (int n = 0; n < 2; ++n)
#pragma unroll
                    for (int j = 0; j < 4; ++j) h[4 * n + j] = silu_f(acc[ai][0][m][n][j]) * acc[ai][1][m][n][j];
                u32x4 w; w.x = cvt_pk_bf16(h[0], h[1]); w.y = cvt_pk_bf16(h[2], h[3]); w.z = cvt_pk_bf16(h[4], h[5]); w.w = cvt_pk_bf16(h[6], h[7]);
                *(u32x4*)(H + (size_t)(row0 + ai * HALF + m * 16) * DFF + col0) = w;
            }
    }
};
struct EpiRes {
    static constexpr bool PERM = false;
    const float* res; const bf16_t* resb; float* out; float scale;
    __device__ __forceinline__ void operator()(const Acc& acc, const Unit& u, int wr, int wc, int fr, int fq) const {
        const int row0 = u.pm * BM + wr * 64 + fr, col0 = u.pn * BM + wc * 32 + 4 * fq;
#pragma unroll
        for (int ai = 0; ai < 2; ++ai)
#pragma unroll
            for (int m = 0; m < 4; ++m) { const size_t ro = (size_t)(row0 + ai * HALF + m * 16) * DM + col0;
#pragma unroll
                for (int bj = 0; bj < 2; ++bj)
#pragma unroll
                    for (int n = 0; n < 2; ++n) { f32x4 r;
                        if (res) r = *(const f32x4*)(res + ro + bj * HALF + n * 16);
                        else { const u32x2 w = *(const u32x2*)(resb + ro + bj * HALF + n * 16); r = (f32x4){bf_lo(w.x), bf_hi(w.x), bf_lo(w.y), bf_hi(w.y)}; }
                        *(f32x4*)(out + ro + bj * HALF + n * 16) = r * ALPHA + acc[ai][bj][m][n] * scale; } }
    }
};
struct EpiPE {
    static constexpr bool PERM = false;
    float* pe;
    __device__ __forceinline__ void operator()(const Acc& acc, const Unit& u, int wr, int wc, int fr, int fq) const {
        const int row0 = u.pm * BM + wr * 64 + fr, col0 = u.pn * BM + wc * 32 + 4 * fq;
#pragma unroll
        for (int ai = 0; ai < 2; ++ai)
#pragma unroll
            for (int m = 0; m < 4; ++m) { const size_t ro = (size_t)(row0 + ai * HALF + m * 16) * DM + col0;
#pragma unroll
                for (int bj = 0; bj < 2; ++bj)
#pragma unroll
                    for (int n = 0; n < 2; ++n) *(f32x4*)(pe + ro + bj * HALF + n * 16) = acc[ai][bj][m][n]; }
    }
};
struct EpiGate {
    static constexpr bool PERM = false;
    float* X; const float* pe; const bf16_t* xb;
    __device__ __forceinline__ void operator()(const Acc& acc, const Unit& u, int wr, int wc, int fr, int fq) const {
        const int row0 = u.pm * BM + wr * 64 + fr, col0 = u.pn * BM + wc * 32 + 4 * fq;
#pragma unroll
        for (int ai = 0; ai < 2; ++ai)
#pragma unroll
            for (int m = 0; m < 4; ++m) { const size_t ro = (size_t)(row0 + ai * HALF + m * 16) * DM + col0;
#pragma unroll
                for (int bj = 0; bj < 2; ++bj)
#pragma unroll
                    for (int n = 0; n < 2; ++n) { const u32x2 w = *(const u32x2*)(xb + ro + bj * HALF + n * 16); const f32x4 r = (f32x4){bf_lo(w.x), bf_hi(w.x), bf_lo(w.y), bf_hi(w.y)}; const f32x4 pv = *(const f32x4*)(pe + ro + bj * HALF + n * 16);
                        f32x4 o;
#pragma unroll
                        for (int j = 0; j < 4; ++j) o[j] = r[j] * ALPHA + pv[j] * __builtin_amdgcn_rcpf(1.0f + __expf(-acc[ai][bj][m][n][j]));
                        *(f32x4*)(X + ro + bj * HALF + n * 16) = o; } }
    }
};
struct EpiMixIn {
    static constexpr bool PERM = true;
    bf16_t* Hm; const f32x2* cs; const float* loglb;
    __device__ __forceinline__ void operator()(const Acc& acc, const Unit& u, int wr, int wc, int fr, int fq) const {
        const int row0 = u.pm * BM + wr * 64 + fr;
        const int pn = u.pn;
        const int mode = (pn == 6 || pn == 7) ? 1 : (pn == 8 || pn == 9) ? 2 : (pn >= 14 && pn <= 17) ? 3 : (pn == 20 || pn == 21) ? 4 : 0;
#pragma unroll
        for (int ai = 0; ai < 2; ++ai)
#pragma unroll
            for (int m = 0; m < 4; ++m) {
                const int row = row0 + ai * HALF + m * 16;
#pragma unroll
                for (int bj = 0; bj < 2; ++bj) {
                    const int col = pn * BM + bj * HALF + wc * 32 + 8 * fq;
                    float v[8];
#pragma unroll
                    for (int n = 0; n < 2; ++n)
#pragma unroll
                        for (int j = 0; j < 4; ++j) v[4 * n + j] = acc[ai][bj][m][n][j];
                    if (mode == 1 || mode == 2) {
                        const int i0 = (col & 127) >> 1;
                        const f32x4 c01 = *(const f32x4*)(cs + (size_t)row * 64 + i0), c23 = *(const f32x4*)(cs + (size_t)row * 64 + i0 + 2);
                        const float sc = (mode == 2) ? 0.08838834764831845f : 1.0f;
                        const float cc[4] = {c01[0], c01[2], c23[0], c23[2]}, ss[4] = {c01[1], c01[3], c23[1], c23[3]};
#pragma unroll
                        for (int q = 0; q < 4; ++q) { const float x1 = v[2 * q], x2 = v[2 * q + 1]; v[2 * q] = (x1 * cc[q] - x2 * ss[q]) * sc; v[2 * q + 1] = (x1 * ss[q] + x2 * cc[q]) * sc; }
                    } else if (mode == 3) {
#pragma unroll
                        for (int q = 0; q < 8; ++q) v[q] = gelu_f(v[q]);
                    } else if (mode == 4) {
                        const int k0 = col - 5120;
                        const f32x4 l0 = *(const f32x4*)(loglb + k0), l1 = *(const f32x4*)(loglb + k0 + 4);
#pragma unroll
                        for (int q = 0; q < 8; ++q) { const float z = v[q], llb = q < 4 ? l0[q] : l1[q - 4];
                            const float az = fabsf(z), sp = __logf(1.0f + __expf(-az));
                            const float lsp = fminf(z, 0.f) - sp, lsn = fminf(-z, 0.f) - sp;
                            const float a = lsp, b = llb + lsn, mx = fmaxf(a, b), mn = fminf(a, b);
                            v[q] = mx + __logf(1.0f + __expf(mn - mx)); }
                    }
                    u32x4 w; w.x = cvt_pk_bf16(v[0], v[1]); w.y = cvt_pk_bf16(v[2], v[3]); w.z = cvt_pk_bf16(v[4], v[5]); w.w = cvt_pk_bf16(v[6], v[7]);
                    *(u32x4*)(Hm + (size_t)row * INC + col) = w;
                }
            }
    }
};

__device__ void conv_wT(const float* __restrict__ src, bf16_t* __restrict__ dst, int K, int N, int swiglu, LAS unsigned char* lds) {
    const int tid = opaque_tid(), bid = opaque_bid(), tilesN = N / 64, tilesK = K / 64, total = tilesN * tilesK;
    LAS bf16_t* t16 = (LAS bf16_t*)lds;
    for (int tile = bid; tile < total; tile += gridDim.x) {
        const int tn = tile % tilesN, tk = tile / tilesN;
        const int r = tid >> 4, c4 = (tid & 15) * 4;
#pragma unroll
        for (int p = 0; p < 2; ++p) {
            const f32x4 v = *(const f32x4*)(src + (size_t)(tk * 64 + r + 32 * p) * N + tn * 64 + c4);
#pragma unroll
            for (int j = 0; j < 4; ++j) t16[(c4 + j) * 72 + r + 32 * p] = (bf16_t)(cvt_pk_bf16(v[j], 0.f) & 0xffffu);
        }
        __syncthreads();
        const int n = tid >> 3, k8 = (tid & 7) * 8;
        const u32x4 w = *(const LAS u32x4*)(lds + n * 144 + k8 * 2);
        int nsrc = tn * 64 + n, ndst = nsrc;
        if (swiglu) { const int bj = nsrc >= DFF ? 1 : 0, hid = nsrc - DFF * bj; ndst = 256 * (hid >> 7) + 128 * bj + (hid & 127); }
        *(u32x4*)(dst + (size_t)ndst * K + tk * 64 + k8) = w;
        __syncthreads();
    }
}
__device__ void conv_flat(const float* __restrict__ src, bf16_t* __restrict__ dst, size_t n) {
    const size_t stride = (size_t)gridDim.x * 512 * 8;
    for (size_t i = ((size_t)opaque_bid() * 512 + opaque_tid()) * 8; i < n; i += stride) {
        const f32x4 a = *(const f32x4*)(src + i), b = *(const f32x4*)(src + i + 4);
        u32x4 w; w.x = cvt_pk_bf16(a[0], a[1]); w.y = cvt_pk_bf16(a[2], a[3]); w.z = cvt_pk_bf16(b[0], b[1]); w.w = cvt_pk_bf16(b[2], b[3]);
        *(u32x4*)(dst + i) = w;
    }
}
__device__ void prep_phase(const Params& P, LAS unsigned char* lds) {
    unsigned char* ws = P.ws;
    const int tid = opaque_tid(), bid = opaque_bid();
    float* tabf = (float*)(ws + WS_TAB); int* tabi = (int*)(ws + WS_TAB);
    if (bid == 0) {
        { const float l0 = P.lb_logits[tid], l1 = P.lb_logits[512 + tid]; const float s1 = 1.0f / (1.0f + expf(l0 - l1));
          tabf[TB_LOGLB + tid] = logf(1e-30f); tabf[TB_LOGLB + 512 + tid] = logf(fmaxf(s1, 1e-30f)); }
        for (int i2 = tid; i2 < 4 * 129; i2 += 512) { const int h = i2 / 129, n = i2 % 129; int bk;
            if (n < 16) bk = n; else { bk = 16 + (int)(logf((float)n / 16.0f) / 2.0794415416798357f * 16.0f); bk = bk > 31 ? 31 : bk; }
            tabf[TB_LUT + h * 132 + n] = P.rel_bias[bk * 4 + h] * LOG2E; }
        if (tid < DEPTH) { float s1 = 0.f, s2 = 0.f; const float* dl = P.dlam + tid * 256;
            for (int j = 0; j < 64; ++j) { s1 += dl[j] * dl[64 + j]; s2 += dl[128 + j] * dl[192 + j]; }
            const float lam_init = 0.8f - 0.6f * expf(-0.3f * (float)tid);
            tabf[TB_LAM + tid] = expf(s1) - expf(s2) + lam_init; }
        { const int b = tid >> 7, t = tid & 127; int mx = -2147483647 - 1; const int* pp = P.pos + b * SEQ + t * 64;
          for (int j = 0; j < 64; ++j) mx = pp[j] > mx ? pp[j] : mx; tabi[TB_PMAX + tid] = mx; }
        if (tid < 2) ((unsigned*)tabi)[TB_Q + tid] = 0u;
        if (tid < 2) ((unsigned*)tabi)[4000 + tid] = 0u;
    }
    { f32x2* cs = (f32x2*)(ws + WS_CS);
      for (size_t i = (size_t)bid * 512 + tid; i < (size_t)MTOK * 64; i += (size_t)gridDim.x * 512) {
          const int tok = (int)(i >> 6), fi = (int)(i & 63);
          const double ang = (double)P.pos[tok] * P.inv[fi];
          const double rev = ang * 0.15915494309189535; const float fr = (float)(rev - rint(rev));
          cs[i] = (f32x2){__builtin_amdgcn_cosf(fr), __builtin_amdgcn_sinf(fr)};
      } }
    conv_flat(P.x, (bf16_t*)(ws + WS_XB), (size_t)MTOK * DM);
    conv_flat(P.p, (bf16_t*)(ws + WS_PB), (size_t)DEPTH * MTOK * PLE);
    for (int L = 0; L < DEPTH; ++L) {
        conv_wT(P.ffn1_in + (size_t)L * DM * 2 * DFF, (bf16_t*)(ws + WS_W1IN + L * SZ_W1IN), DM, 2 * DFF, 1, lds);
        conv_wT(P.ffn1_out + (size_t)L * DFF * DM, (bf16_t*)(ws + WS_W1OUT + L * SZ_W1OUT), DFF, DM, 0, lds);
        conv_wT(P.mix_in + (size_t)L * DM * INC, (bf16_t*)(ws + WS_WMI + L * SZ_WMI), DM, INC, 0, lds);
        conv_wT(P.mix_out + (size_t)L * DM * DM, (bf16_t*)(ws + WS_WMO + L * SZ_WMO), DM, DM, 0, lds);
        conv_wT(P.ffn2_in + (size_t)L * DM * 2 * DFF, (bf16_t*)(ws + WS_W2IN + L * SZ_W1IN), DM, 2 * DFF, 1, lds);
        conv_wT(P.ffn2_out + (size_t)L * DFF * DM, (bf16_t*)(ws + WS_W2OUT + L * SZ_W1OUT), DFF, DM, 0, lds);
        conv_wT(P.ple_gate + (size_t)L * DM * DM, (bf16_t*)(ws + WS_WG + L * SZ_WG), DM, DM, 0, lds);
        conv_wT(P.ple_proj + (size_t)L * PLE * DM, (bf16_t*)(ws + WS_WE + L * SZ_WE), PLE, DM, 0, lds);
    }
}

__device__ void ln_phase(float* X, const float* __restrict__ g, const float* __restrict__ b, bf16_t* Xb, bool write_x) {
    const int tid = opaque_tid(); const int lane = tid & 63, gw = opaque_bid() * 8 + (tid >> 6), nw = gridDim.x * 8;
    for (int row = gw; row < MTOK; row += nw) {
        float* xr = X + (size_t)row * DM;
        f32x4 v[8]; float s = 0.f;
#pragma unroll
        for (int i = 0; i < 8; ++i) { v[i] = *(const f32x4*)(xr + (i * 64 + lane) * 4); s += v[i][0] + v[i][1] + v[i][2] + v[i][3]; }
#pragma unroll
        for (int o = 32; o >= 1; o >>= 1) s += shx(s, o, lane);
        const float mu = s * (1.0f / DM); float q = 0.f;
#pragma unroll
        for (int i = 0; i < 8; ++i)
#pragma unroll
            for (int j = 0; j < 4; ++j) { const float d = v[i][j] - mu; q += d * d; }
#pragma unroll
        for (int o = 32; o >= 1; o >>= 1) q += shx(q, o, lane);
        const float rs = rsqrtf(q * (1.0f / DM) + 1e-5f);
#pragma unroll
        for (int i = 0; i < 8; ++i) { const int c = (i * 64 + lane) * 4; const f32x4 gg = *(const f32x4*)(g + c), bb = *(const f32x4*)(b + c); f32x4 o;
#pragma unroll
            for (int j = 0; j < 4; ++j) o[j] = (v[i][j] - mu) * rs * gg[j] + bb[j];
            if (write_x) *(f32x4*)(xr + c) = o; u32x2 w; w.x = cvt_pk_bf16(o[0], o[1]); w.y = cvt_pk_bf16(o[2], o[3]); *(u32x2*)(Xb + (size_t)row * DM + c) = w; }
    }
}

__device__ void attn_unit(const Params& P, int layer, int b, int h, int qblk, LAS unsigned char* lds) {
    const int tid = opaque_tid(), wid = __builtin_amdgcn_readfirstlane(tid >> 6), lane_ = tid & 63, lane = lane_, l31 = lane & 31, hh = lane >> 5;
    const int c = wid & 1, rb = wid >> 1;
    const bf16_t* Hm = (const bf16_t*)(P.ws + WS_H);
    const float* tabf = (const float*)(P.ws + WS_TAB); const int* tabi = (const int*)(P.ws + WS_TAB);
    LAS float* lut = (LAS float*)(lds + 66048); LAS int* posk = (LAS int*)(lds + 65536); LAS int* pkmx = (LAS int*)(lds + 66576);
    const int q0w = qblk * 128 + rb * 32, qrow = q0w + l31;
    const size_t tok = (size_t)b * SEQ + qrow;
    bf16x8 qf[4];
    { const bf16_t* qp = Hm + tok * INC + h * 128 + c * 64 + 8 * hh;
#pragma unroll
      for (int ks = 0; ks < 4; ++ks) qf[ks] = *(const bf16x8*)(qp + 16 * ks); }
    const int pq = P.pos[b * SEQ + qrow];
    int pqmin = pq;
#pragma unroll
    for (int o = 16; o >= 1; o >>= 1) { const int t = shxi(pqmin, o, lane); pqmin = t < pqmin ? t : pqmin; }
    pqmin = __builtin_amdgcn_readfirstlane(pqmin);
    f32x16 O[4];
#pragma unroll
    for (int d = 0; d < 4; ++d) O[d] = zero16();
    float mrun = -1e30f, lrun = 0.f;
    const int nt = 2 * qblk + 2;
    const float sc2 = 0.125f * LOG2E;
    const int srow = (tid >> 4), sch = tid & 15;
    const bf16_t* gK = Hm + ((size_t)b * SEQ) * INC + 512 + h * 128 + sch * 8;
    const bf16_t* gV = gK + 512;
    u32x4 st[4];
    __syncthreads();
    if (tid < 129) lut[tid] = tabf[TB_LUT + h * 132 + tid];
#define ATT_LOAD(kt) do { const size_t r0 = (size_t)((kt) * 64 + srow) * INC; st[0] = *(const u32x4*)(gK + r0); st[1] = *(const u32x4*)(gK + r0 + (size_t)32 * INC); \
        st[2] = *(const u32x4*)(gV + r0); st[3] = *(const u32x4*)(gV + r0 + (size_t)32 * INC); } while (0)
#define ATT_STORE(buf, kt) do { LAS unsigned char* kb = lds + (buf) * 32768; *(LAS u32x4*)(kb + off_b(srow, sch)) = st[0]; *(LAS u32x4*)(kb + off_b(srow + 32, sch)) = st[1]; \
        *(LAS u32x4*)(kb + 16384 + off_b(srow, sch)) = st[2]; *(LAS u32x4*)(kb + 16384 + off_b(srow + 32, sch)) = st[3]; \
        if (tid < 64) { int pv_ = P.pos[b * SEQ + (kt) * 64 + tid]; posk[(buf) * 64 + tid] = pv_; _Pragma("unroll") for (int o_ = 32; o_ >= 1; o_ >>= 1) { const int t_ = shxi(pv_, o_, lane_); pv_ = t_ > pv_ ? t_ : pv_; } if (tid == 0) pkmx[buf] = pv_; } } while (0)
    ATT_LOAD(0); ATT_STORE(0, 0);
    __syncthreads();
    for (int kt = 0; kt < nt; ++kt) {
        const int buf = kt & 1, k0 = kt * 64;
        if (kt + 1 < nt) ATT_LOAD(kt + 1);
        if (k0 <= q0w + 31) {
            int lane = lane_; asm volatile("" : "+v"(lane)); const int l31 = lane & 31, hh = lane >> 5;
            LAS const unsigned char* Kimg = lds + buf * 32768; LAS const unsigned char* Vimg = Kimg + 16384;
            f32x16 S[2];
#pragma unroll
            for (int s2 = 0; s2 < 2; ++s2) { S[s2] = zero16();
#pragma unroll
                for (int ks = 0; ks < 4; ++ks) { const bf16x8 a = *(const LAS bf16x8*)(Kimg + off_b(32 * s2 + l31, 8 * c + 2 * ks + hh)); S[s2] = mfma32(a, qf[ks], S[s2]); } }
            const bool far = (pqmin - pkmx[buf]) >= 128;
            const bool needmask = (k0 + 63 > q0w);
            float mnew, rsum = 0.f;
            if (far && !needmask) {
                const float cb = lut[128];
                float mx = S[0][0];
#pragma unroll
                for (int s2 = 0; s2 < 2; ++s2)
#pragma unroll
                    for (int i = 0; i < 16; ++i) mx = fmaxf(mx, S[s2][i]);
                mx = fmaxf(mx, shx(mx, 32, lane));
                mnew = fmaxf(mrun, mx * sc2 + cb);
                const float off = cb - mnew;
#pragma unroll
                for (int s2 = 0; s2 < 2; ++s2)
#pragma unroll
                    for (int i = 0; i < 16; ++i) { const float pe = __builtin_amdgcn_exp2f(S[s2][i] * sc2 + off); S[s2][i] = pe; rsum += pe; }
            } else {
                if (far) { const float cb = lut[128];
#pragma unroll
                    for (int s2 = 0; s2 < 2; ++s2)
#pragma unroll
                        for (int i = 0; i < 16; ++i) S[s2][i] = S[s2][i] * sc2 + cb;
                } else {
#pragma unroll
                    for (int s2 = 0; s2 < 2; ++s2)
#pragma unroll
                        for (int i = 0; i < 16; ++i) { const int kk = 32 * s2 + 8 * (i >> 2) + 4 * hh + (i & 3); int rel = pq - posk[buf * 64 + kk]; rel = rel < 0 ? 0 : (rel > 128 ? 128 : rel);
                            S[s2][i] = S[s2][i] * sc2 + lut[rel]; }
                }
                if (needmask) {
#pragma unroll
                    for (int s2 = 0; s2 < 2; ++s2)
#pragma unroll
                        for (int i = 0; i < 16; ++i) { const int kk = k0 + 32 * s2 + 8 * (i >> 2) + 4 * hh + (i & 3); if (kk > qrow) S[s2][i] = -1e30f; }
                }
                float mx = S[0][0];
#pragma unroll
                for (int s2 = 0; s2 < 2; ++s2)
#pragma unroll
                    for (int i = 0; i < 16; ++i) mx = fmaxf(mx, S[s2][i]);
                mx = fmaxf(mx, shx(mx, 32, lane));
                mnew = fmaxf(mrun, mx);
#pragma unroll
                for (int s2 = 0; s2 < 2; ++s2)
#pragma unroll
                    for (int i = 0; i < 16; ++i) { const float pe = __builtin_amdgcn_exp2f(S[s2][i] - mnew); S[s2][i] = pe; rsum += pe; }
            }
            const float alpha = __builtin_amdgcn_exp2f(mrun - mnew);
            rsum += shx(rsum, 32, lane);
            lrun = lrun * alpha + rsum; mrun = mnew;
            if (__builtin_amdgcn_ballot_w64(alpha != 1.0f) != 0ull) {
#pragma unroll
                for (int d = 0; d < 4; ++d)
#pragma unroll
                    for (int i = 0; i < 16; ++i) O[d][i] *= alpha;
            }
#pragma unroll
            for (int s2 = 0; s2 < 2; ++s2)
#pragma unroll
                for (int sp = 0; sp < 2; ++sp) {
                    const bf16x8 pf = pack8(S[s2][8 * sp + 0], S[s2][8 * sp + 1], S[s2][8 * sp + 2], S[s2][8 * sp + 3], S[s2][8 * sp + 4], S[s2][8 * sp + 5], S[s2][8 * sp + 6], S[s2][8 * sp + 7]);
                    const unsigned rbase = 32 * s2 + 16 * sp + 4 * hh;
#pragma unroll
                    for (int d = 0; d < 4; ++d) { const bf16x8 va = cat8(tr_read(Vimg, lane, rbase, d), tr_read(Vimg, lane, rbase + 8, d)); O[d] = mfma32(va, pf, O[d]); }
                }
        }
        if (kt + 1 < nt) ATT_STORE(buf ^ 1, kt + 1);
        __syncthreads();
    }
#undef ATT_LOAD
#undef ATT_STORE
    LAS float* X = (LAS float*)lds;
    const float inv_l = 1.0f / lrun;
    if (c == 1) {
#pragma unroll
        for (int d = 0; d < 4; ++d)
#pragma unroll
            for (int i = 0; i < 16; ++i) X[(rb * 64 + d * 16 + i) * 64 + lane] = O[d][i] * inv_l;
    }
    __syncthreads();
    if (c == 0) {
        const float lam = tabf[TB_LAM + layer];
        const float lam_init = 0.8f - 0.6f * __expf(-0.3f * (float)layer);
        float ss = 0.f;
#pragma unroll
        for (int d = 0; d < 4; ++d)
#pragma unroll
            for (int i = 0; i < 16; ++i) { const float v = O[d][i] * inv_l - lam * X[(rb * 64 + d * 16 + i) * 64 + lane]; O[d][i] = v; ss += v * v; }
        ss += shx(ss, 32, lane);
        const float rs = rsqrtf(ss * (1.0f / 128.0f) + 1e-5f) * (1.0f - lam_init);
        bf16_t* Ob = (bf16_t*)(P.ws + WS_XB) + tok * DM + h * 128;
        const float* ng = P.dnorm_g + layer * 128;
#pragma unroll
        for (int d = 0; d < 4; ++d)
#pragma unroll
            for (int g4 = 0; g4 < 4; ++g4) { const int e0 = 32 * d + 8 * g4 + 4 * hh; const f32x4 gg = *(const f32x4*)(ng + e0);
                u32x2 w; w.x = cvt_pk_bf16(O[d][4 * g4] * rs * gg[0], O[d][4 * g4 + 1] * rs * gg[1]); w.y = cvt_pk_bf16(O[d][4 * g4 + 2] * rs * gg[2], O[d][4 * g4 + 3] * rs * gg[3]);
                *(u32x2*)(Ob + e0) = w; }
    }
    __syncthreads();
}

__device__ void gla_stream(const Params& P, int layer, int type, int b, int h, int sl, LAS unsigned char* lds) {
    const int tid = opaque_tid(), wid = __builtin_amdgcn_readfirstlane(tid >> 6), lane = tid & 63;
    const bf16_t* Hm = (const bf16_t*)(P.ws + WS_H);
    bf16_t* Ob = (bf16_t*)(P.ws + WS_XB);
    float* stat = (float*)(P.ws + WS_STAT);
    const int qcol = (type ? 4608 : 1536) + h * 128, kcol = (type ? 5120 : 2048) + h * 128, vcol = (type ? 5632 : 2560) + h * 128 + 32 * sl,
              ocol = (type ? 1536 : 512) + h * 128 + 32 * sl;
    const float gam = 1.0f - exp2f(-5.0f - (float)h);
    LAS float* FF = (LAS float*)lds; LAS unsigned* QK = (LAS unsigned*)lds + 2048; LAS float* VF = FF + 4096; LAS float* OP = FF + 4608;
    const int e_l = tid & 15, kg = tid >> 4;
    const int stok = tid >> 5, sc4 = (tid & 31) * 4;
    const int vtok = (tid >> 4) & 15, vc2 = (tid & 15) * 2;
    float S0[4] = {0.f, 0.f, 0.f, 0.f}, S1[4] = {0.f, 0.f, 0.f, 0.f};
    u32x2 pq2, pk2; unsigned pv1 = 0u;
    const bf16_t* gbase = Hm + ((size_t)b * SEQ + stok) * INC + sc4;
    const bf16_t* vbase = Hm + ((size_t)b * SEQ + vtok) * INC + vcol + vc2;
#define GLS_LOAD(bt) do { const bf16_t* gp = gbase + (size_t)(bt) * 16 * INC; pq2 = *(const u32x2*)(gp + qcol); pk2 = *(const u32x2*)(gp + kcol); \
        if (tid < 256) pv1 = *(const unsigned*)(vbase + (size_t)(bt) * 16 * INC); } while (0)
    GLS_LOAD(0);
    __syncthreads();
    for (int bt = 0; bt < 512; ++bt) {
        const size_t T0 = (size_t)b * SEQ + (size_t)bt * 16;
        { const int o = stok * 128 + sc4;
          if (type) { const float l0 = bf_lo(pk2.x), l1 = bf_hi(pk2.x), l2 = bf_lo(pk2.y), l3 = bf_hi(pk2.y);
              *(LAS f32x4*)(FF + o) = (f32x4){__expf(l0), __expf(l1), __expf(l2), __expf(l3)};
              const unsigned k01 = cvt_pk_bf16(1.0f - __expf(l0), 1.0f - __expf(l1)), k23 = cvt_pk_bf16(1.0f - __expf(l2), 1.0f - __expf(l3));
              *(LAS u32x4*)(QK + o) = (u32x4){(pq2.x & 0xffffu) | (k01 << 16), (pq2.x >> 16) | (k01 & 0xffff0000u), (pq2.y & 0xffffu) | (k23 << 16), (pq2.y >> 16) | (k23 & 0xffff0000u)}; }
          else {
              *(LAS u32x4*)(QK + o) = (u32x4){(pq2.x & 0xffffu) | (pk2.x << 16), (pq2.x >> 16) | (pk2.x & 0xffff0000u), (pq2.y & 0xffffu) | (pk2.y << 16), (pq2.y >> 16) | (pk2.y & 0xffff0000u)}; }
          if (tid < 256) { VF[vtok * 32 + vc2] = bf_lo(pv1); VF[vtok * 32 + vc2 + 1] = bf_hi(pv1); } }
        if (bt + 1 < 512) GLS_LOAD(bt + 1);
        __syncthreads();
        float accs[32];
#pragma unroll
        for (int tt = 0; tt < 16; ++tt) {
            const float v0 = VF[tt * 32 + e_l], v1 = VF[tt * 32 + 16 + e_l];
            f32x4 f4 = (f32x4){gam, gam, gam, gam}; if (type) f4 = *(const LAS f32x4*)(FF + tt * 128 + 4 * kg);
            const u32x4 qk = *(const LAS u32x4*)(QK + tt * 128 + 4 * kg);
            const unsigned qw[4] = {qk.x, qk.y, qk.z, qk.w};
            float a0 = 0.f, a1 = 0.f;
#pragma unroll
            for (int j = 0; j < 4; ++j) { const float q = bf_lo(qw[j]), c = bf_hi(qw[j]);
                S0[j] = f4[j] * S0[j] + c * v0; S1[j] = f4[j] * S1[j] + c * v1; a0 += q * S0[j]; a1 += q * S1[j]; }
            accs[2 * tt] = a0; accs[2 * tt + 1] = a1;
        }
        { const bool b0 = (lane & 16) != 0, b1 = (lane & 32) != 0;
          float r16[16];
#pragma unroll
          for (int i = 0; i < 16; ++i) r16[i] = swapadd16(accs[i], accs[16 + i]);
          float r8[8];
#pragma unroll
          for (int i = 0; i < 8; ++i) r8[i] = swapadd32(r16[i], r16[8 + i]);
          const int vb = (b0 ? 16 : 0) + (b1 ? 8 : 0);
#pragma unroll
          for (int i = 0; i < 8; ++i) { const int vi = vb + i; OP[((vi >> 1) * 8 + wid) * 32 + (vi & 1) * 16 + e_l] = r8[i]; } }
        __syncthreads();
        { const int tt = tid >> 5, e32 = tid & 31; const size_t tok = T0 + tt;
            float o = 0.f;
#pragma unroll
            for (int w = 0; w < 8; ++w) o += OP[(tt * 8 + w) * 32 + e32];
            Ob[tok * DM + ocol + e32] = (bf16_t)(cvt_pk_bf16(o, 0.f) & 0xffffu);
            float s1 = o, s2 = o * o;
#pragma unroll
            for (int of = 16; of >= 1; of >>= 1) { s1 += shx(s1, of, lane); s2 += shx(s2, of, lane); }
            if (e32 == 0) *(f32x4*)(stat + ((((size_t)type * MTOK + tok) * 4 + h) * 8 + 2 * sl) * 2) = (f32x4){s1, s2, 0.f, 0.f}; }
    }
#undef GLS_LOAD
    __syncthreads();
}

__device__ void gla_post_phase(const Params& P, int layer) {
    bf16_t* Ob = (bf16_t*)(P.ws + WS_XB); const bf16_t* Hm = (const bf16_t*)(P.ws + WS_H); const float* stat = (const float*)(P.ws + WS_STAT);
    const float* ng = P.hg_norm_g + layer * 512;
    const int tid = opaque_tid(); const int lane = tid & 63, gw = opaque_bid() * 8 + (tid >> 6), nw = gridDim.x * 8;
    const int hd = lane >> 4;
    for (int tok = gw; tok < MTOK; tok += nw) {
        { const float* sp = stat + (((size_t)tok) * 4 + hd) * 16; float s1 = 0.f, s2 = 0.f;
#pragma unroll
          for (int q = 0; q < 4; ++q) { const f32x4 a = *(const f32x4*)(sp + 4 * q); s1 += a[0] + a[2]; s2 += a[1] + a[3]; }
          const float mu = s1 * (1.0f / 128.0f), var = fmaxf(s2 * (1.0f / 128.0f) - mu * mu, 0.f), rs = rsqrtf(var + 1e-5f);
          u32x4* p = (u32x4*)(Ob + (size_t)tok * DM + 512 + lane * 8); const u32x4 w = *p; const u32x4 g = *(const u32x4*)(Hm + (size_t)tok * INC + 3072 + lane * 8);
          const unsigned ww[4] = {w.x, w.y, w.z, w.w}, gg[4] = {g.x, g.y, g.z, g.w}; unsigned oo[4];
#pragma unroll
          for (int j = 0; j < 4; ++j) oo[j] = cvt_pk_bf16((bf_lo(ww[j]) - mu) * rs * silu_f(bf_lo(gg[j])), (bf_hi(ww[j]) - mu) * rs * silu_f(bf_hi(gg[j])));
          *p = (u32x4){oo[0], oo[1], oo[2], oo[3]}; }
        { const float* sp = stat + (((size_t)MTOK + tok) * 4) * 16; float s2 = 0.f;
#pragma unroll
          for (int q = 0; q < 16; ++q) { const f32x4 a = *(const f32x4*)(sp + 4 * q); s2 += a[1] + a[3]; }
          const float rs = rsqrtf(s2 * (1.0f / 512.0f) + 1e-5f);
          u32x4* p = (u32x4*)(Ob + (size_t)tok * DM + 1536 + lane * 8); const u32x4 w = *p; const u32x4 g = *(const u32x4*)(Hm + (size_t)tok * INC + 6144 + lane * 8);
          const f32x4 n0 = *(const f32x4*)(ng + lane * 8), n1 = *(const f32x4*)(ng + lane * 8 + 4);
          const unsigned ww[4] = {w.x, w.y, w.z, w.w}, gg[4] = {g.x, g.y, g.z, g.w}; const float nn[8] = {n0[0], n0[1], n0[2], n0[3], n1[0], n1[1], n1[2], n1[3]}; unsigned oo[4];
#pragma unroll
          for (int j = 0; j < 4; ++j) oo[j] = cvt_pk_bf16(bf_lo(ww[j]) * rs * nn[2 * j] * silu_f(bf_lo(gg[j])), bf_hi(ww[j]) * rs * nn[2 * j + 1] * silu_f(bf_hi(gg[j])));
          *p = (u32x4){oo[0], oo[1], oo[2], oo[3]}; }
    }
}

__device__ void gmlp_unit(const Params& P, int layer, int b, int chunk, LAS unsigned char* lds) {
    constexpr unsigned VIMG = 0, WIMG = 32768, MU = 65536, RS = 66048;
    const int tid = opaque_tid(), wid = __builtin_amdgcn_readfirstlane(tid >> 6), lane = tid & 63, l31 = lane & 31, hh = lane >> 5;
    const bf16_t* Hm = (const bf16_t*)(P.ws + WS_H);
    bf16_t* Ob = (bf16_t*)(P.ws + WS_XB);
    const size_t T0 = (size_t)b * SEQ + chunk * 128;
    __syncthreads();
    for (int i = 0; i < 16; ++i) { const int t = wid * 16 + i; const u32x4 w = *(const u32x4*)(Hm + (T0 + t) * INC + 4096 + lane * 8);
        const float v[8] = {bf_lo(w.x), bf_hi(w.x), bf_lo(w.y), bf_hi(w.y), bf_lo(w.z), bf_hi(w.z), bf_lo(w.w), bf_hi(w.w)};
        float s = 0.f;
#pragma unroll
        for (int j = 0; j < 8; ++j) s += v[j];
#pragma unroll
        for (int o = 32; o >= 1; o >>= 1) s += shx(s, o, lane);
        const float mu = s * (1.0f / 512.0f); float q = 0.f;
#pragma unroll
        for (int j = 0; j < 8; ++j) { const float d = v[j] - mu; q += d * d; }
#pragma unroll
        for (int o = 32; o >= 1; o >>= 1) q += shx(q, o, lane);
        if (lane == 0) { ((LAS float*)(lds + MU))[t] = mu; ((LAS float*)(lds + RS))[t] = rsqrtf(q * (1.0f / 512.0f) + 1e-5f); } }
    __syncthreads();
    const int tb = wid & 3, ct0 = 2 * (wid >> 2);
    for (int g = 0; g < 4; ++g) {
        const float* lg = P.g_ln_g + layer * 512 + g * 128; const float* lb = P.g_ln_b + layer * 512 + g * 128;
        const float* Wg = P.g_ws + ((size_t)(layer * 4 + g)) * 128 * 128;
#pragma unroll
        for (int i = 0; i < 4; ++i) { const int n = tid + 512 * i, s = n >> 4, ch = n & 15;
            const u32x4 w = *(const u32x4*)(Hm + (T0 + s) * INC + 4096 + g * 128 + ch * 8);
            const float mu = ((LAS float*)(lds + MU))[s], rs = ((LAS float*)(lds + RS))[s];
            const f32x4 g0 = *(const f32x4*)(lg + ch * 8), g1 = *(const f32x4*)(lg + ch * 8 + 4), b0 = *(const f32x4*)(lb + ch * 8), b1 = *(const f32x4*)(lb + ch * 8 + 4);
            const float v[8] = {bf_lo(w.x), bf_hi(w.x), bf_lo(w.y), bf_hi(w.y), bf_lo(w.z), bf_hi(w.z), bf_lo(w.w), bf_hi(w.w)};
            float y[8];
#pragma unroll
            for (int j = 0; j < 8; ++j) y[j] = (v[j] - mu) * rs * (j < 4 ? g0[j] : g1[j - 4]) + (j < 4 ? b0[j] : b1[j - 4]);
            *(LAS bf16x8*)(lds + VIMG + off_b(s, ch)) = pack8(y[0], y[1], y[2], y[3], y[4], y[5], y[6], y[7]);
            const f32x4 w0 = *(const f32x4*)(Wg + s * 128 + ch * 8), w1 = *(const f32x4*)(Wg + s * 128 + ch * 8 + 4);
            float ww[8];
#pragma unroll
            for (int j = 0; j < 8; ++j) ww[j] = (ch * 8 + j <= s) ? (j < 4 ? w0[j] : w1[j - 4]) : 0.f;
            *(LAS bf16x8*)(lds + WIMG + off_b(s, ch)) = pack8(ww[0], ww[1], ww[2], ww[3], ww[4], ww[5], ww[6], ww[7]); }
        __syncthreads();
        f32x16 acc[2]; acc[0] = zero16(); acc[1] = zero16();
        for (int ks = 0; ks < 2 * (tb + 1); ++ks) {
            const bf16x8 bw = *(const LAS bf16x8*)(lds + WIMG + off_b(32 * tb + l31, 2 * ks + hh));
#pragma unroll
            for (int e = 0; e < 2; ++e) { const bf16x8 av = cat8(tr_read(lds + VIMG, lane, 16 * ks + 8 * hh, ct0 + e), tr_read(lds + VIMG, lane, 16 * ks + 8 * hh + 4, ct0 + e)); acc[e] = mfma32(av, bw, acc[e]); }
        }
        { const int t = 32 * tb + l31; const size_t tok = T0 + t; const float bs = P.g_bs[(layer * 4 + g) * 128 + t];
#pragma unroll
          for (int e = 0; e < 2; ++e)
#pragma unroll
              for (int g4 = 0; g4 < 4; ++g4) { const int c0 = 32 * (ct0 + e) + 8 * g4 + 4 * hh;
                  const u32x2 uw = *(const u32x2*)(Hm + tok * INC + 3584 + g * 128 + c0);
                  u32x2 w; w.x = cvt_pk_bf16(bf_lo(uw.x) * (acc[e][4 * g4] + bs), bf_hi(uw.x) * (acc[e][4 * g4 + 1] + bs)); w.y = cvt_pk_bf16(bf_lo(uw.y) * (acc[e][4 * g4 + 2] + bs), bf_hi(uw.y) * (acc[e][4 * g4 + 3] + bs));
                  *(u32x2*)(Ob + tok * DM + 1024 + g * 128 + c0) = w; } }
        __syncthreads();
    }
}

__device__ void mixer_phase(const Params& P, int layer, LAS unsigned char* lds) {
    unsigned* qc = (unsigned*)(P.ws + WS_TAB) + TB_Q + layer;
    LAS unsigned* slot = (LAS unsigned*)(lds + LDS_BYTES - 16);
    for (;;) {
        __syncthreads();
        if (threadIdx.x == 0) *slot = atomicAdd(qc, 1u);
        __syncthreads();
        const int item = (int)*slot;
        if (item >= 128 + 512 + 256) break;
        if (item < 128) { const int st = item >> 2; gla_stream(P, layer, 1 - (st >> 4), (st >> 2) & 3, st & 3, item & 3, lds); }
        else if (item < 640) { const int a = item - 128, bh = a >> 5, pr = a & 31;
            for (int u2 = 0; u2 < 2; ++u2) attn_unit(P, layer, bh >> 2, bh & 3, u2 ? pr : 63 - pr, lds); }
        else { const int c = item - 640; gmlp_unit(P, layer, c >> 6, c & 63, lds); }
    }
}

__device__ void dnorm_phase(const Params& P) {
    bf16_t* Ob = (bf16_t*)(P.ws + WS_XB); const float* ssq = (const float*)(P.ws + WS_SSQ);
    const int tid = opaque_tid(); const int lane = tid & 63, gw = opaque_bid() * 8 + (tid >> 6), nw = gridDim.x * 8;
    for (int tok = gw; tok < MTOK; tok += nw) {
        const f32x4 s = *(const f32x4*)(ssq + (size_t)tok * 4);
        const float rs = rsqrtf((s[0] + s[1] + s[2] + s[3]) * (1.0f / 512.0f) + 1e-5f);
        u32x4* p = (u32x4*)(Ob + (size_t)tok * DM + 1536 + lane * 8);
        const u32x4 w = *p; u32x4 o;
        o.x = cvt_pk_bf16(bf_lo(w.x) * rs, bf_hi(w.x) * rs); o.y = cvt_pk_bf16(bf_lo(w.y) * rs, bf_hi(w.y) * rs);
        o.z = cvt_pk_bf16(bf_lo(w.z) * rs, bf_hi(w.z) * rs); o.w = cvt_pk_bf16(bf_lo(w.w) * rs, bf_hi(w.w) * rs);
        *p = o;
#ifdef ZG
        { unsigned z0 = 0u; asm volatile("" : "+v"(z0)); *(u32x4*)(Ob + (size_t)tok * DM + ZG * 512 + lane * 8) = (u32x4){z0, z0, z0, z0}; }
#endif
    }
}


__device__ void diag_phase(const Params& P) {
    const bf16_t* Hm = (const bf16_t*)(P.ws + WS_H); const bf16_t* Ob = (const bf16_t*)(P.ws + WS_XB);
    unsigned* flag = (unsigned*)(P.ws + WS_TAB) + 4000;
    const float* cs = (const float*)(P.ws + WS_CS);
    unsigned f = 0;
    const size_t gt = (size_t)opaque_bid() * 512 + opaque_tid(), gn = (size_t)gridDim.x * 512;
    for (size_t i = gt; i < (size_t)MTOK * 2048; i += gn) { const size_t tok = i >> 11; const int c = (int)(i & 2047);
        const unsigned short v = Hm[tok * INC + 1536 + c]; if ((v & 0x7f80) == 0x7f80) f |= (c < 1024) ? 1u : 2u; }
    for (size_t i = gt; i < (size_t)MTOK * 512; i += gn) { const size_t tok = i >> 9; const int c = (int)(i & 511);
        const unsigned short v = Ob[tok * DM + 512 + c]; if ((v & 0x7f80) == 0x7f80) f |= 4u; }
    for (size_t i = gt; i < (size_t)MTOK * 128; i += gn) { if (!(fabsf(cs[i]) < 1e30f)) f |= 8u; }
    if (f) atomicOr(flag, f);
}


__device__ __forceinline__ void grid_barrier(unsigned* ctr, unsigned nbar) {
    asm volatile("s_waitcnt vmcnt(0)" ::: "memory");
    __syncthreads();
    if (threadIdx.x == 0) {
        __builtin_amdgcn_fence(__ATOMIC_RELEASE, "agent");
        asm volatile("s_waitcnt vmcnt(0)" ::: "memory");
        const unsigned gsz = gridDim.x >> 3;
        unsigned* gc = ctr + (blockIdx.x & 7u) * 32u; unsigned* glob = ctr + 8u * 32u;
        const unsigned old = __hip_atomic_fetch_add(gc, 1u, __ATOMIC_RELAXED, __HIP_MEMORY_SCOPE_AGENT);
        if (old + 1u == nbar * gsz) __hip_atomic_fetch_add(glob, 1u, __ATOMIC_RELAXED, __HIP_MEMORY_SCOPE_AGENT);
        while (__hip_atomic_load(glob, __ATOMIC_RELAXED, __HIP_MEMORY_SCOPE_AGENT) < nbar * 8u) __builtin_amdgcn_s_sleep(1);
        __builtin_amdgcn_fence(__ATOMIC_ACQUIRE, "agent");
        asm volatile("s_waitcnt vmcnt(0)" ::: "memory");
    }
    __syncthreads();
}

template <class Epi> __device__ __forceinline__ void run_gemm(LAS unsigned char* lds, const bf16_t* A, const bf16_t* Bt, int N, int K, const Epi& E) {
    pg8::Gemm g; g.A = A; g.Bt = Bt; g.M = MTOK; g.N = N; g.K = K;
    pg8::StaticOrder S; S.init(MTOK, N, (int)gridDim.x, opaque_bid());
    pg8::gemm_phase<Epi>(lds, g, S, E);
}

typedef const __attribute__((address_space(4))) Params* KParamsPtr;
__global__ __launch_bounds__(512, 2) void fwd_megakernel(const Params Pin) {
    extern __shared__ __attribute__((aligned(16))) unsigned char shm[];
    LAS unsigned char* lds = (LAS unsigned char*)shm;
    cg::grid_group grid = cg::this_grid();
    const KParamsPtr kp = (KParamsPtr)__builtin_amdgcn_kernarg_segment_ptr();
    unsigned nbar = 0u;
    for (int ph = Pin.ph_lo; ph < Pin.ph_hi; ++ph) {
        if (Pin.ph_lo < 0) grid.sync();
        if (ph > Pin.ph_lo) { nbar += 1u; grid_barrier((unsigned*)(Pin.ws + WS_TAB) + 8000, nbar); }
        KParamsPtr kq = kp; asm volatile("" : "+s"(kq));
        const Params& P = *(const Params*)kq;
        unsigned char* ws = P.ws;
        float* X = P.out;
        bf16_t* Xb = (bf16_t*)(ws + WS_XB);
        bf16_t* Hb = (bf16_t*)(ws + WS_H);
        if (ph == 0) { prep_phase(P, lds); continue; }
        const int L = (ph - 1) / 13, s = (ph - 1) % 13;
        switch (s) {
        case 0: { EpiSwiGLU E; E.H = Hb; run_gemm(lds, Xb, (const bf16_t*)(ws + WS_W1IN + L * SZ_W1IN), 2 * DFF, DM, E); } break;
        case 1: { EpiRes E; E.res = (L == 0) ? P.x : nullptr; E.resb = Xb; E.out = X; E.scale = 0.5f; run_gemm(lds, Hb, (const bf16_t*)(ws + WS_W1OUT + L * SZ_W1OUT), DM, DFF, E); } break;
        case 2: ln_phase(X, P.ln_g + (L * 4 + 0) * DM, P.ln_b + (L * 4 + 0) * DM, Xb, true); break;
        case 3: { EpiMixIn E; E.Hm = Hb; E.cs = (const f32x2*)(ws + WS_CS); E.loglb = (const float*)(ws + WS_TAB) + TB_LOGLB + L * 512;
                  run_gemm(lds, Xb, (const bf16_t*)(ws + WS_WMI + L * SZ_WMI), INC, DM, E); } break;
        case 4: mixer_phase(P, L, lds); break;
        case 5: gla_post_phase(P, L); break;
        case 6: { EpiRes E; E.res = X; E.resb = nullptr; E.out = X; E.scale = 1.0f; run_gemm(lds, Xb, (const bf16_t*)(ws + WS_WMO + L * SZ_WMO), DM, DM, E); } break;
        case 7: ln_phase(X, P.ln_g + (L * 4 + 1) * DM, P.ln_b + (L * 4 + 1) * DM, Xb, false); break;
        case 8: { EpiSwiGLU E; E.H = Hb; run_gemm(lds, Xb, (const bf16_t*)(ws + WS_W2IN + L * SZ_W1IN), 2 * DFF, DM, E); } break;
        case 9: { EpiRes E; E.res = nullptr; E.resb = Xb; E.out = X; E.scale = 0.5f; run_gemm(lds, Hb, (const bf16_t*)(ws + WS_W2OUT + L * SZ_W1OUT), DM, DFF, E); } break;
        case 10: ln_phase(X, P.ln_g + (L * 4 + 2) * DM, P.ln_b + (L * 4 + 2) * DM, Xb, false); break;
        case 11: { EpiPE E1; E1.pe = (float*)(ws + WS_H); run_gemm(lds, (const bf16_t*)(ws + WS_PB) + (size_t)L * MTOK * PLE, (const bf16_t*)(ws + WS_WE + L * SZ_WE), DM, PLE, E1);
                   EpiGate E2; E2.X = X; E2.pe = (const float*)(ws + WS_H); E2.xb = Xb; run_gemm(lds, Xb, (const bf16_t*)(ws + WS_WG + L * SZ_WG), DM, DM, E2); } break;
        case 12: ln_phase(X, P.ln_g + (L * 4 + 3) * DM, P.ln_b + (L * 4 + 3) * DM, Xb, L == DEPTH - 1); break;
        }
    }
}

extern "C" void kernel_launch(void* const* d_in, const int* in_sizes, int n_in, void* d_out, int out_size, void* d_ws, size_t ws_size, hipStream_t stream) {
    static int grid = 0;
    if (grid == 0) {
        if (n_in != 22 || out_size != MTOK * DM || ws_size < WS_END) { fprintf(stderr, "kernel_launch: unexpected shapes (n_in %d out %d ws %zu need %zu)\n", n_in, out_size, ws_size, (size_t)WS_END); grid = -1; return; }
        int dev = 0, cus = 0, per_cu = 0;
        (void)hipGetDevice(&dev); (void)hipDeviceGetAttribute(&cus, hipDeviceAttributeMultiprocessorCount, dev);
        if (hipFuncSetAttribute((const void*)fwd_megakernel, hipFuncAttributeMaxDynamicSharedMemorySize, LDS_BYTES) != hipSuccess) { fprintf(stderr, "kernel_launch: hipFuncSetAttribute failed\n"); grid = -1; return; }
        if (hipOccupancyMaxActiveBlocksPerMultiprocessor(&per_cu, (const void*)fwd_megakernel, 512, LDS_BYTES) != hipSuccess || per_cu < 1) { fprintf(stderr, "kernel_launch: occupancy query says %d\n", per_cu); per_cu = 1; }
        (void)hipGetLastError();
        grid = cus & ~7;
    }
    if (grid < 0) return;
    Params p; memset(&p, 0, sizeof(p));
    p.x = (const float*)d_in[0]; p.p = (const float*)d_in[1]; p.pos = (const int*)d_in[2];
    p.ffn1_in = (const float*)d_in[3]; p.ffn1_out = (const float*)d_in[4]; p.mix_in = (const float*)d_in[5]; p.mix_out = (const float*)d_in[6];
    p.rel_bias = (const float*)d_in[7]; p.dlam = (const float*)d_in[8]; p.dnorm_g = (const float*)d_in[9]; p.g_ln_g = (const float*)d_in[10]; p.g_ln_b = (const float*)d_in[11];
    p.g_ws = (const float*)d_in[12]; p.g_bs = (const float*)d_in[13]; p.lb_logits = (const float*)d_in[14]; p.hg_norm_g = (const float*)d_in[15];
    p.ffn2_in = (const float*)d_in[16]; p.ffn2_out = (const float*)d_in[17]; p.ple_gate = (const float*)d_in[18]; p.ple_proj = (const float*)d_in[19];
    p.ln_g = (const float*)d_in[20]; p.ln_b = (const float*)d_in[21];
    p.out = (float*)d_out; p.ws = (unsigned char*)d_ws;
    p.ph_lo = 0; p.ph_hi = NPH;
    for (int i = 0; i < 64; ++i) p.inv[i] = pow(10000.0, -(double)i / 63.0);
    (void)hipMemsetAsync((unsigned char*)d_ws + WS_TAB + 32000, 0, 9 * 128, stream);
    void* args[] = {&p};
    hipError_t e = hipLaunchCooperativeKernel((const void*)fwd_megakernel, dim3(grid), dim3(512), args, LDS_BYTES, stream);
    if (e != hipSuccess) fprintf(stderr, "kernel_launch: cooperative launch failed: %s (grid %d)\n", hipGetErrorString(e), grid);
}
```

```cpp
#include <hip/hip_runtime.h>
#include <hip/hip_cooperative_groups.h>
#include <math.h>
#include <stdio.h>
#include <string.h>
namespace cg = cooperative_groups;

#define LAS __attribute__((address_space(3)))
typedef unsigned short bf16_t;
typedef short bf16x8 __attribute__((ext_vector_type(8)));
typedef short s16x4 __attribute__((ext_vector_type(4)));
typedef float f32x2 __attribute__((ext_vector_type(2)));
typedef float f32x4 __attribute__((ext_vector_type(4)));
typedef float f32x16 __attribute__((ext_vector_type(16)));
typedef unsigned u32x2 __attribute__((ext_vector_type(2)));
typedef unsigned u32x4 __attribute__((ext_vector_type(4)));

constexpr int MTOK = 32768, SEQ = 8192, DM = 2048, DFF = 5632, INC = 6656, PLE = 256, DEPTH = 2;
constexpr float ALPHA = 1.41421356237f;
constexpr float LOG2E = 1.44269504089f;
constexpr int LDS_BYTES = 147456;
constexpr int NPH = 1 + 13 * DEPTH;

constexpr size_t SZ_W1IN = (size_t)2 * DFF * DM * 2, SZ_W1OUT = (size_t)DM * DFF * 2, SZ_WMI = (size_t)INC * DM * 2, SZ_WMO = (size_t)DM * DM * 2,
                 SZ_WG = (size_t)DM * DM * 2, SZ_WE = (size_t)DM * PLE * 2;
constexpr size_t WS_W1IN = 0, WS_W1OUT = WS_W1IN + DEPTH * SZ_W1IN, WS_WMI = WS_W1OUT + DEPTH * SZ_W1OUT, WS_WMO = WS_WMI + DEPTH * SZ_WMI,
                 WS_W2IN = WS_WMO + DEPTH * SZ_WMO, WS_W2OUT = WS_W2IN + DEPTH * SZ_W1IN, WS_WG = WS_W2OUT + DEPTH * SZ_W1OUT, WS_WE = WS_WG + DEPTH * SZ_WG,
                 WS_H = WS_WE + DEPTH * SZ_WE, WS_XB = WS_H + (size_t)MTOK * INC * 2, WS_PB = WS_XB + (size_t)MTOK * DM * 2,
                 WS_CS = WS_PB + (size_t)DEPTH * MTOK * PLE * 2, WS_SSQ = WS_CS + (size_t)MTOK * 64 * 8, WS_TAB = WS_SSQ + (size_t)MTOK * 4 * 4,
                 WS_STAT = WS_TAB + 65536, WS_END = WS_STAT + (size_t)2 * MTOK * 4 * 8 * 2 * 4;
constexpr int TB_LOGLB = 0  , TB_LUT = 1024  , TB_LAM = 1600  , TB_PMAX = 1664  , TB_Q = 2304  ;

struct Params {
    const float* x; const float* p; const int* pos;
    const float *ffn1_in, *ffn1_out, *mix_in, *mix_out, *rel_bias, *dlam, *dnorm_g, *g_ln_g, *g_ln_b, *g_ws, *g_bs, *lb_logits, *hg_norm_g,
        *ffn2_in, *ffn2_out, *ple_gate, *ple_proj, *ln_g, *ln_b;
    float* out; unsigned char* ws;
    int ph_lo, ph_hi;
    double inv[64];
};

__device__ __forceinline__ unsigned cvt_pk_bf16(float lo, float hi) { unsigned r; asm("v_cvt_pk_bf16_f32 %0, %1, %2" : "=v"(r) : "v"(lo), "v"(hi)); return r; }
__device__ __forceinline__ float bf_lo(unsigned w) { return __uint_as_float(w << 16); }
__device__ __forceinline__ float bf_hi(unsigned w) { return __uint_as_float(w & 0xffff0000u); }
__device__ __forceinline__ unsigned off_b(unsigned row, unsigned ch) { return 256u * row + 16u * (ch ^ (((row & 3u) << 2) | ((row >> 2) & 3u))); }
__device__ __forceinline__ s16x4 tr_read(LAS const unsigned char* img, unsigned lane, unsigned rowbase, unsigned c) {
    const unsigned blk = (lane >> 4) & 1u, qq = (lane & 15u) >> 2, p = lane & 3u;
    return __builtin_amdgcn_ds_read_tr16_b64_v4i16((LAS s16x4*)(img + off_b(rowbase + qq, 4u * c + 2u * blk + (p >> 1)) + 8u * (p & 1u)));
}
__device__ __forceinline__ bf16x8 cat8(s16x4 a, s16x4 b) { bf16x8 r; r[0] = a[0]; r[1] = a[1]; r[2] = a[2]; r[3] = a[3]; r[4] = b[0]; r[5] = b[1]; r[6] = b[2]; r[7] = b[3]; return r; }
__device__ __forceinline__ bf16x8 pack8(float a0, float a1, float a2, float a3, float a4, float a5, float a6, float a7) {
    u32x4 w; w.x = cvt_pk_bf16(a0, a1); w.y = cvt_pk_bf16(a2, a3); w.z = cvt_pk_bf16(a4, a5); w.w = cvt_pk_bf16(a6, a7);
    return __builtin_bit_cast(bf16x8, w);
}
__device__ __forceinline__ f32x16 mfma32(bf16x8 a, bf16x8 b, f32x16 c) { return __builtin_amdgcn_mfma_f32_32x32x16_bf16(a, b, c, 0, 0, 0); }
__device__ __forceinline__ float silu_f(float v) { return v * __builtin_amdgcn_rcpf(1.0f + __expf(-v)); }
__device__ __forceinline__ float shx(float v, int off, int lane) { return __int_as_float(__builtin_amdgcn_ds_bpermute((lane ^ off) << 2, __float_as_int(v))); }
__device__ __forceinline__ int shxi(int v, int off, int lane) { return __builtin_amdgcn_ds_bpermute((lane ^ off) << 2, v); }
__device__ __forceinline__ float swapadd16(float a, float b) { auto r = __builtin_amdgcn_permlane16_swap(__float_as_uint(a), __float_as_uint(b), false, false); return __uint_as_float(r[0]) + __uint_as_float(r[1]); }
__device__ __forceinline__ float swapadd32(float a, float b) { auto r = __builtin_amdgcn_permlane32_swap(__float_as_uint(a), __float_as_uint(b), false, false); return __uint_as_float(r[0]) + __uint_as_float(r[1]); }
__device__ __forceinline__ int opaque_tid() { int t = threadIdx.x; asm volatile("" : "+v"(t)); return t; }
__device__ __forceinline__ int opaque_bid() { int t = blockIdx.x; asm volatile("" : "+s"(t)); return t; }
__device__ __forceinline__ f32x16 zero16() { f32x16 z; for (int i = 0; i < 16; ++i) z[i] = 0.f; return z; }

namespace pg8 {
constexpr int BM = 256, BK = 64, HALF = 128, HTB = HALF * BK * 2, STAGE_BYTES = 8 * HTB, NXCD = 8, WGM = 8;
__device__ __forceinline__ int lds_byte(int r, int c) { const int st = (r >> 4) * 2 + (c >> 5), rr = r & 15, cc = c & 31, ob = rr * 64 + cc * 2; return st * 1024 + (ob ^ (((ob >> 9) & 1) << 5)); }
__device__ __forceinline__ void stage_rc(int b, int& R, int& C) { const int st = b / 1024, sb = b % 1024, swz = sb ^ (((sb >> 9) & 1) << 5); R = (st >> 1) * 16 + swz / 64; C = (st & 1) * 32 + (swz % 64) / 2; }
__device__ __forceinline__ int perm32(int rho) { const int n = rho >> 4, i = rho & 15; return 8 * (i >> 2) + 4 * n + (i & 3); }
struct Unit { int pm, pn; };
struct Gemm { const bf16_t* A; const bf16_t* Bt; int M, N, K; };
struct StaticOrder {
    int nM, nN, nwg, G, c;
    __device__ void init(int M, int N, int G_, int c_) { nM = M / BM; nN = N / BM; nwg = nM * nN; G = G_; c = c_; }
    __device__ bool next(int i, Unit& u) const {
        const long L = (long)i * G + c; if (L >= nwg) return false;
        int wgid = (int)L; { const int q = nwg / NXCD, r = nwg % NXCD, xcd = wgid % NXCD, off = wgid / NXCD; wgid = (xcd < r ? xcd * (q + 1) : r * (q + 1) + (xcd - r) * q) + off; }
        const int nig = WGM * nN, gid = wgid / nig, fm = gid * WGM, gsz = (nM - fm) < WGM ? (nM - fm) : WGM;
        u.pm = fm + ((wgid % nig) % gsz); u.pn = (wgid % nig) / gsz; return true;
    }
};
template <class Epi>
__device__ __forceinline__ void gemm_phase(LAS unsigned char* lds, const Gemm g, const StaticOrder& S, const Epi& E) {
    const int tid = opaque_tid(), wid = __builtin_amdgcn_readfirstlane(tid >> 6), lane = tid & 63, wr = wid >> 2, wc = wid & 3, fr = lane & 15, fq = lane >> 4;
    const int K = g.K, nt = K / BK;
    unsigned voffA[2], voffB[2];
#pragma unroll
    for (int i = 0; i < 2; ++i) { int R, C; stage_rc(tid * 16 + i * 8192, R, C); const int Rb = Epi::PERM ? ((R & ~31) + perm32(R & 31)) : R;
        voffA[i] = (unsigned)(R * K + C) * 2u; voffB[i] = (unsigned)(Rb * K + C) * 2u; }
    const size_t kstep = (size_t)(BK * 2), hstep = (size_t)HALF * K * 2, tstep = 2 * hstep;
    const unsigned ldsw = (unsigned)wid * 1024u;
    const int aoff = lds_byte(wr * 64 + fr, fq * 8), boff = lds_byte(wc * 32 + fr, fq * 8);
#define PG8_SA(b, h) (((b) * 2 + (h)) * HTB)
#define PG8_SB(b, h) ((4 + (b) * 2 + (h)) * HTB)
#define PG8_STAGE(bufoff, gbase, voff) do { _Pragma("unroll") for (int _i = 0; _i < 2; ++_i) \
        __builtin_amdgcn_global_load_lds((const unsigned*)((const char*)(gbase) + (voff)[_i]), (LAS unsigned*)(lds + (bufoff) + ldsw + _i * 8192), 16, 0, 0); } while (0)
#define PG8_LDA(dst, b, h) do { _Pragma("unroll") for (int m = 0; m < 4; ++m) _Pragma("unroll") for (int k = 0; k < 2; ++k) dst[m][k] = *(const LAS bf16x8*)(lds + PG8_SA(b, h) + aoff + m * 2048 + k * 1024); } while (0)
#define PG8_LDB(dst, b, h) do { _Pragma("unroll") for (int n = 0; n < 2; ++n) _Pragma("unroll") for (int k = 0; k < 2; ++k) dst[n][k] = *(const LAS bf16x8*)(lds + PG8_SB(b, h) + boff + n * 2048 + k * 1024); } while (0)
#define PG8_MMA(ai, bj, At, Bt) do { __builtin_amdgcn_s_setprio(1); _Pragma("unroll") for (int m = 0; m < 4; ++m) _Pragma("unroll") for (int n = 0; n < 2; ++n) _Pragma("unroll") for (int k = 0; k < 2; ++k) \
        acc[ai][bj][m][n] = __builtin_amdgcn_mfma_f32_16x16x32_bf16(Bt[n][k], At[m][k], acc[ai][bj][m][n], 0, 0, 0); __builtin_amdgcn_s_setprio(0); } while (0)
#define PG8_WAIT_V(n) asm volatile("s_waitcnt vmcnt(" #n ")" ::: "memory")
#define PG8_WAIT_L(n) asm volatile("s_waitcnt lgkmcnt(" #n ")" ::: "memory")
#define PG8_BAR __builtin_amdgcn_s_barrier()
#define PG8_SCHED __builtin_amdgcn_sched_barrier(0)
    Unit cur, nxt; int ui = 0;
    if (!S.next(0, cur)) return;
    f32x4 acc[2][2][4][2];
#pragma unroll
    for (int a = 0; a < 2; ++a)
#pragma unroll
        for (int b = 0; b < 2; ++b)
#pragma unroll
            for (int m = 0; m < 4; ++m)
#pragma unroll
                for (int n = 0; n < 2; ++n) acc[a][b][m][n] = (f32x4){0.f, 0.f, 0.f, 0.f};
    bf16x8 At[4][2], B0[2][2], B1[2][2];
    const char* cA = (const char*)g.A + (size_t)cur.pm * tstep; const char* cB = (const char*)g.Bt + (size_t)cur.pn * tstep;
    PG8_STAGE(PG8_SB(0, 0), cB, voffB); PG8_STAGE(PG8_SA(0, 0), cA, voffA); PG8_STAGE(PG8_SB(0, 1), cB + hstep, voffB); PG8_STAGE(PG8_SA(0, 1), cA + hstep, voffA);
    if (wr == 1) PG8_BAR;
    PG8_WAIT_V(4); PG8_BAR;
    PG8_STAGE(PG8_SB(1, 0), cB + kstep, voffB); PG8_STAGE(PG8_SA(1, 0), cA + kstep, voffA); PG8_STAGE(PG8_SB(1, 1), cB + hstep + kstep, voffB);
    PG8_WAIT_V(6); PG8_BAR;
    for (;;) {
        const bool has_next = S.next(ui + 1, nxt);
        const char* nA = has_next ? (const char*)g.A + (size_t)nxt.pm * tstep : cA; const char* nB = has_next ? (const char*)g.Bt + (size_t)nxt.pn * tstep : cB;
        for (int t = 0; t < nt; t += 2) {
            const bool last = (t == nt - 2);
            const char* a1 = cA + (size_t)(t + 1) * kstep;
            const char* a2 = last ? nA : cA + (size_t)(t + 2) * kstep; const char* b2 = last ? nB : cB + (size_t)(t + 2) * kstep;
            const char* a3 = a2 + kstep; const char* b3 = b2 + kstep;
            PG8_LDB(B0, 0, 0); PG8_SCHED; PG8_LDA(At, 0, 0); PG8_STAGE(PG8_SA(1, 1), a1 + hstep, voffA);
            PG8_WAIT_L(8); PG8_BAR; PG8_WAIT_L(0); PG8_MMA(0, 0, At, B0); PG8_BAR; PG8_SCHED;
            PG8_LDB(B1, 0, 1); PG8_STAGE(PG8_SB(0, 0), b2, voffB);
            PG8_BAR; PG8_WAIT_L(0); PG8_MMA(0, 1, At, B1); PG8_BAR;
            PG8_LDA(At, 0, 1); PG8_STAGE(PG8_SA(0, 0), a2, voffA);
            PG8_BAR; PG8_WAIT_L(0); PG8_MMA(1, 0, At, B0); PG8_BAR; PG8_SCHED;
            PG8_STAGE(PG8_SB(0, 1), b2 + hstep, voffB);
            PG8_WAIT_V(6); PG8_BAR; PG8_MMA(1, 1, At, B1); PG8_BAR;
            PG8_LDB(B0, 1, 0); PG8_SCHED; PG8_LDA(At, 1, 0); PG8_STAGE(PG8_SA(0, 1), a2 + hstep, voffA);
            PG8_WAIT_L(8); PG8_BAR; PG8_WAIT_L(0); PG8_MMA(0, 0, At, B0); PG8_BAR; PG8_SCHED;
            PG8_LDB(B1, 1, 1); PG8_STAGE(PG8_SB(1, 0), b3, voffB);
            PG8_BAR; PG8_WAIT_L(0); PG8_MMA(0, 1, At, B1); PG8_BAR;
            PG8_LDA(At, 1, 1); PG8_STAGE(PG8_SA(1, 0), a3, voffA);
            PG8_BAR; PG8_WAIT_L(0); PG8_MMA(1, 0, At, B0); PG8_BAR; PG8_SCHED;
            PG8_STAGE(PG8_SB(1, 1), b3 + hstep, voffB);
            PG8_WAIT_V(6); PG8_BAR; PG8_MMA(1, 1, At, B1); PG8_BAR;
        }
        E(acc, cur, wr, wc, fr, fq);
        if (!has_next) break;
#pragma unroll
        for (int a = 0; a < 2; ++a)
#pragma unroll
            for (int b = 0; b < 2; ++b)
#pragma unroll
                for (int m = 0; m < 4; ++m)
#pragma unroll
                    for (int n = 0; n < 2; ++n) acc[a][b][m][n] = (f32x4){0.f, 0.f, 0.f, 0.f};
        cur = nxt; cA = nA; cB = nB; ++ui;
    }
    PG8_WAIT_V(0);
    if (wr == 0) PG8_BAR;
    PG8_BAR;
#undef PG8_SA
#undef PG8_SB
#undef PG8_STAGE
#undef PG8_LDA
#undef PG8_LDB
#undef PG8_MMA
#undef PG8_WAIT_V
#undef PG8_WAIT_L
#undef PG8_BAR
#undef PG8_SCHED
}
}
using pg8::Unit; using pg8::BM; using pg8::HALF;
typedef f32x4 Acc[2][2][4][2];

__device__ __forceinline__ float gelu_f(float v) {
    const float av = fabsf(v), t = __builtin_amdgcn_rcpf(av * 0.2316418882f + 1.0f);
    float q = t * 0.5307027145f + (-0.7265760135f); q = q * t + 0.7107068705f; q = q * t + (-0.142248368f); q = q * t + 0.127414796f; q = q * t;
    const float e = __builtin_amdgcn_exp2f((v * v) * (-0.72134752044f));
    const float m = v * (q * e);
    return v < 0.f ? m : v - m;
}

struct EpiSwiGLU {
    static constexpr bool PERM = true;
    bf16_t* H;
    __device__ __forceinline__ void operator()(const Acc& acc, const Unit& u, int wr, int wc, int fr, int fq) const {
        const int row0 = u.pm * BM + wr * 64 + fr, col0 = u.pn * 128 + wc * 32 + 8 * fq;
#pragma unroll
        for (int ai = 0; ai < 2; ++ai)
#pragma unroll
            for (int m = 0; m < 4; ++m) {
                float h[8];
#pragma unroll
                for (int n = 0; n < 2; ++n)
#pragma unroll
                    for (int j = 0; j < 4; ++j) h[4 * n + j] = silu_f(acc[ai][0][m][n][j]) * acc[ai][1][m][n][j];
                u32x4 w; w.x = cvt_pk_bf16(h[0], h[1]); w.y = cvt_pk_bf16(h[2], h[3]); w.z = cvt_pk_bf16(h[4], h[5]); w.w = cvt_pk_bf16(h[6], h[7]);
                *(u32x4*)(H + (size_t)(row0 + ai * HALF + m * 16) * DFF + col0) = w;
            }
    }
};
struct EpiRes {
    static constexpr bool PERM = false;
    const float* res; const bf16_t* resb; float* out; float scale;
    __device__ __forceinline__ void operator()(const Acc& acc, const Unit& u, int wr, int wc, int fr, int fq) const {
        const int row0 = u.pm * BM + wr * 64 + fr, col0 = u.pn * BM + wc * 32 + 4 * fq;
#pragma unroll
        for (int ai = 0; ai < 2; ++ai)
#pragma unroll
            for (int m = 0; m < 4; ++m) { const size_t ro = (size_t)(row0 + ai * HALF + m * 16) * DM + col0;
#pragma unroll
                for (int bj = 0; bj < 2; ++bj)
#pragma unroll
                    for (int n = 0; n < 2; ++n) { f32x4 r;
                        if (res) r = *(const f32x4*)(res + ro + bj * HALF + n * 16);
                        else { const u32x2 w = *(const u32x2*)(resb + ro + bj * HALF + n * 16); r = (f32x4){bf_lo(w.x), bf_hi(w.x), bf_lo(w.y), bf_hi(w.y)}; }
                        *(f32x4*)(out + ro + bj * HALF + n * 16) = r * ALPHA + acc[ai][bj][m][n] * scale; } }
    }
};
struct EpiPE {
    static constexpr bool PERM = false;
    float* pe;
    __device__ __forceinline__ void operator()(const Acc& acc, const Unit& u, int wr, int wc, int fr, int fq) const {
        const int row0 = u.pm * BM + wr * 64 + fr, col0 = u.pn * BM + wc * 32 + 4 * fq;
#pragma unroll
        for (int ai = 0; ai < 2; ++ai)
#pragma unroll
            for (int m = 0; m < 4; ++m) { const size_t ro = (size_t)(row0 + ai * HALF + m * 16) * DM + col0;
#pragma unroll
                for (int bj = 0; bj < 2; ++bj)
#pragma unroll
                    for (int n = 0; n < 2; ++n) *(f32x4*)(pe + ro + bj * HALF + n * 16) = acc[ai][bj][m][n]; }
    }
};
struct EpiGate {
    static constexpr bool PERM = false;
    float* X; const float* pe; const bf16_t* xb;
    __device__ __forceinline__ void operator()(const Acc& acc, const Unit& u, int wr, int wc, int fr, int fq) const {
        const int row0 = u.pm * BM + wr * 64 + fr, col0 = u.pn * BM + wc * 32 + 4 * fq;
#pragma unroll
        for (int ai = 0; ai < 2; ++ai)
#pragma unroll
            for (int m = 0; m < 4; ++m) { const size_t ro = (size_t)(row0 + ai * HALF + m * 16) * DM + col0;
#pragma unroll
                for (int bj = 0; bj < 2; ++bj)
#pragma unroll
                    for (int n = 0; n < 2; ++n) { const u32x2 w = *(const u32x2*)(xb + ro + bj * HALF + n * 16); const f32x4 r = (f32x4){bf_lo(w.x), bf_hi(w.x), bf_lo(w.y), bf_hi(w.y)}; const f32x4 pv = *(const f32x4*)(pe + ro + bj * HALF + n * 16);
                        f32x4 o;
#pragma unroll
                        for (int j = 0; j < 4; ++j) o[j] = r[j] * ALPHA + pv[j] * __builtin_amdgcn_rcpf(1.0f + __expf(-acc[ai][bj][m][n][j]));
                        *(f32x4*)(X + ro + bj * HALF + n * 16) = o; } }
    }
};
struct EpiMixIn {
    static constexpr bool PERM = true;
    bf16_t* Hm; const f32x2* cs; const float* loglb;
    __device__ __forceinline__ void operator()(const Acc& acc, const Unit& u, int wr, int wc, int fr, int fq) const {
        const int row0 = u.pm * BM + wr * 64 + fr;
        const int pn = u.pn;
        const int mode = (pn == 6 || pn == 7) ? 1 : (pn == 8 || pn == 9) ? 2 : (pn >= 14 && pn <= 17) ? 3 : (pn == 20 || pn == 21) ? 4 : 0;
#pragma unroll
        for (int ai = 0; ai < 2; ++ai)
#pragma unroll
            for (int m = 0; m < 4; ++m) {
                const int row = row0 + ai * HALF + m * 16;
#pragma unroll
                for (int bj = 0; bj < 2; ++bj) {
                    const int col = pn * BM + bj * HALF + wc * 32 + 8 * fq;
                    float v[8];
#pragma unroll
                    for (int n = 0; n < 2; ++n)
#pragma unroll
                        for (int j = 0; j < 4; ++j) v[4 * n + j] = acc[ai][bj][m][n][j];
                    if (mode == 1 || mode == 2) {
                        const int i0 = (col & 127) >> 1;
                        const f32x4 c01 = *(const f32x4*)(cs + (size_t)row * 64 + i0), c23 = *(const f32x4*)(cs + (size_t)row * 64 + i0 + 2);
                        const float sc = (mode == 2) ? 0.08838834764831845f : 1.0f;
                        const float cc[4] = {c01[0], c01[2], c23[0], c23[2]}, ss[4] = {c01[1], c01[3], c23[1], c23[3]};
#pragma unroll
                        for (int q = 0; q < 4; ++q) { const float x1 = v[2 * q], x2 = v[2 * q + 1]; v[2 * q] = (x1 * cc[q] - x2 * ss[q]) * sc; v[2 * q + 1] = (x1 * ss[q] + x2 * cc[q]) * sc; }
                    } else if (mode == 3) {
#pragma unroll
                        for (int q = 0; q < 8; ++q) v[q] = gelu_f(v[q]);
                    } else if (mode == 4) {
                        const int k0 = col - 5120;
                        const f32x4 l0 = *(const f32x4*)(loglb + k0), l1 = *(const f32x4*)(loglb + k0 + 4);
#pragma unroll
                        for (int q = 0; q < 8; ++q) { const float z = v[q], llb = q < 4 ? l0[q] : l1[q - 4];
                            const float az = fabsf(z), sp = __logf(1.0f + __expf(-az));
                            const float lsp = fminf(z, 0.f) - sp, lsn = fminf(-z, 0.f) - sp;
                            const float a = lsp, b = llb + lsn, mx = fmaxf(a, b), mn = fminf(a, b);
                            v[q] = mx + __logf(1.0f + __expf(mn - mx)); }
                    }
                    u32x4 w; w.x = cvt_pk_bf16(v[0], v[1]); w.y = cvt_pk_bf16(v[2], v[3]); w.z = cvt_pk_bf16(v[4], v[5]); w.w = cvt_pk_bf16(v[6], v[7]);
                    *(u32x4*)(Hm + (size_t)row * INC + col) = w;
                }
            }
    }
};

__device__ void conv_wT(const float* __restrict__ src, bf16_t* __restrict__ dst, int K, int N, int swiglu, LAS unsigned char* lds) {
    const int tid = opaque_tid(), bid = opaque_bid(), tilesN = N / 64, tilesK = K / 64, total = tilesN * tilesK;
    LAS bf16_t* t16 = (LAS bf16_t*)lds;
    for (int tile = bid; tile < total; tile += gridDim.x) {
        const int tn = tile % tilesN, tk = tile / tilesN;
        const int r = tid >> 4, c4 = (tid & 15) * 4;
#pragma unroll
        for (int p = 0; p < 2; ++p) {
            const f32x4 v = *(const f32x4*)(src + (size_t)(tk * 64 + r + 32 * p) * N + tn * 64 + c4);
#pragma unroll
            for (int j = 0; j < 4; ++j) t16[(c4 + j) * 72 + r + 32 * p] = (bf16_t)(cvt_pk_bf16(v[j], 0.f) & 0xffffu);
        }
        __syncthreads();
        const int n = tid >> 3, k8 = (tid & 7) * 8;
        const u32x4 w = *(const LAS u32x4*)(lds + n * 144 + k8 * 2);
        int nsrc = tn * 64 + n, ndst = nsrc;
        if (swiglu) { const int bj = nsrc >= DFF ? 1 : 0, hid = nsrc - DFF * bj; ndst = 256 * (hid >> 7) + 128 * bj + (hid & 127); }
        *(u32x4*)(dst + (size_t)ndst * K + tk * 64 + k8) = w;
        __syncthreads();
    }
}
__device__ void conv_flat(const float* __restrict__ src, bf16_t* __restrict__ dst, size_t n) {
    const size_t stride = (size_t)gridDim.x * 512 * 8;
    for (size_t i = ((size_t)opaque_bid() * 512 + opaque_tid()) * 8; i < n; i += stride) {
        const f32x4 a = *(const f32x4*)(src + i), b = *(const f32x4*)(src + i + 4);
        u32x4 w; w.x = cvt_pk_bf16(a[0], a[1]); w.y = cvt_pk_bf16(a[2], a[3]); w.z = cvt_pk_bf16(b[0], b[1]); w.w = cvt_pk_bf16(b[2], b[3]);
        *(u32x4*)(dst + i) = w;
    }
}
__device__ void prep_phase(const Params& P, LAS unsigned char* lds) {
    unsigned char* ws = P.ws;
    const int tid = opaque_tid(), bid = opaque_bid();
    float* tabf = (float*)(ws + WS_TAB); int* tabi = (int*)(ws + WS_TAB);
    if (bid == 0) {
        { const float l0 = P.lb_logits[tid], l1 = P.lb_logits[512 + tid]; const float s1 = 1.0f / (1.0f + expf(l0 - l1));
          tabf[TB_LOGLB + tid] = logf(1e-30f); tabf[TB_LOGLB + 512 + tid] = logf(fmaxf(s1, 1e-30f)); }
        for (int i2 = tid; i2 < 4 * 129; i2 += 512) { const int h = i2 / 129, n = i2 % 129; int bk;
            if (n < 16) bk = n; else { bk = 16 + (int)(logf((float)n / 16.0f) / 2.0794415416798357f * 16.0f); bk = bk > 31 ? 31 : bk; }
            tabf[TB_LUT + h * 132 + n] = P.rel_bias[bk * 4 + h] * LOG2E; }
        if (tid < DEPTH) { float s1 = 0.f, s2 = 0.f; const float* dl = P.dlam + tid * 256;
            for (int j = 0; j < 64; ++j) { s1 += dl[j] * dl[64 + j]; s2 += dl[128 + j] * dl[192 + j]; }
            const float lam_init = 0.8f - 0.6f * expf(-0.3f * (float)tid);
            tabf[TB_LAM + tid] = expf(s1) - expf(s2) + lam_init; }
        { const int b = tid >> 7, t = tid & 127; int mx = -2147483647 - 1; const int* pp = P.pos + b * SEQ + t * 64;
          for (int j = 0; j < 64; ++j) mx = pp[j] > mx ? pp[j] : mx; tabi[TB_PMAX + tid] = mx; }
        if (tid < 2) ((unsigned*)tabi)[TB_Q + tid] = 0u;
        if (tid < 2) ((unsigned*)tabi)[4000 + tid] = 0u;
    }
    { f32x2* cs = (f32x2*)(ws + WS_CS);
      for (size_t i = (size_t)bid * 512 + tid; i < (size_t)MTOK * 64; i += (size_t)gridDim.x * 512) {
          const int tok = (int)(i >> 6), fi = (int)(i & 63);
          const double ang = (double)P.pos[tok] * P.inv[fi];
          const double rev = ang * 0.15915494309189535; const float fr = (float)(rev - rint(rev));
          cs[i] = (f32x2){__builtin_amdgcn_cosf(fr), __builtin_amdgcn_sinf(fr)};
      } }
    conv_flat(P.x, (bf16_t*)(ws + WS_XB), (size_t)MTOK * DM);
    conv_flat(P.p, (bf16_t*)(ws + WS_PB), (size_t)DEPTH * MTOK * PLE);
    for (int L = 0; L < DEPTH; ++L) {
        conv_wT(P.ffn1_in + (size_t)L * DM * 2 * DFF, (bf16_t*)(ws + WS_W1IN + L * SZ_W1IN), DM, 2 * DFF, 1, lds);
        conv_wT(P.ffn1_out + (size_t)L * DFF * DM, (bf16_t*)(ws + WS_W1OUT + L * SZ_W1OUT), DFF, DM, 0, lds);
        conv_wT(P.mix_in + (size_t)L * DM * INC, (bf16_t*)(ws + WS_WMI + L * SZ_WMI), DM, INC, 0, lds);
        conv_wT(P.mix_out + (size_t)L * DM * DM, (bf16_t*)(ws + WS_WMO + L * SZ_WMO), DM, DM, 0, lds);
        conv_wT(P.ffn2_in + (size_t)L * DM * 2 * DFF, (bf16_t*)(ws + WS_W2IN + L * SZ_W1IN), DM, 2 * DFF, 1, lds);
        conv_wT(P.ffn2_out + (size_t)L * DFF * DM, (bf16_t*)(ws + WS_W2OUT + L * SZ_W1OUT), DFF, DM, 0, lds);
        conv_wT(P.ple_gate + (size_t)L * DM * DM, (bf16_t*)(ws + WS_WG + L * SZ_WG), DM, DM, 0, lds);
        conv_wT(P.ple_proj + (size_t)L * PLE * DM, (bf16_t*)(ws + WS_WE + L * SZ_WE), PLE, DM, 0, lds);
    }
}

__device__ void ln_phase(float* X, const float* __restrict__ g, const float* __restrict__ b, bf16_t* Xb, bool write_x) {
    const int tid = opaque_tid(); const int lane = tid & 63, gw = opaque_bid() * 8 + (tid >> 6), nw = gridDim.x * 8;
    for (int row = gw; row + nw < MTOK; row += 2 * nw) {
        float* xr0 = X + (size_t)row * DM; float* xr1 = X + (size_t)(row + nw) * DM;
        bf16_t* xb0 = Xb + (size_t)row * DM; bf16_t* xb1 = Xb + (size_t)(row + nw) * DM;
        f32x4 v0[8], v1[8]; float s0 = 0.f, s1 = 0.f;
#pragma unroll
        for (int i = 0; i < 8; ++i) { v0[i] = *(const f32x4*)(xr0 + (i * 64 + lane) * 4); v1[i] = *(const f32x4*)(xr1 + (i * 64 + lane) * 4); }
#pragma unroll
        for (int i = 0; i < 8; ++i) { s0 += v0[i][0] + v0[i][1] + v0[i][2] + v0[i][3]; s1 += v1[i][0] + v1[i][1] + v1[i][2] + v1[i][3]; }
#pragma unroll
        for (int o = 32; o >= 1; o >>= 1) { s0 += shx(s0, o, lane); s1 += shx(s1, o, lane); }
        const float mu0 = s0 * (1.0f / DM), mu1 = s1 * (1.0f / DM); float q0 = 0.f, q1 = 0.f;
#pragma unroll
        for (int i = 0; i < 8; ++i)
#pragma unroll
            for (int j = 0; j < 4; ++j) { const float d0 = v0[i][j] - mu0, d1 = v1[i][j] - mu1; q0 += d0 * d0; q1 += d1 * d1; }
#pragma unroll
        for (int o = 32; o >= 1; o >>= 1) { q0 += shx(q0, o, lane); q1 += shx(q1, o, lane); }
        const float rs0 = rsqrtf(q0 * (1.0f / DM) + 1e-5f), rs1 = rsqrtf(q1 * (1.0f / DM) + 1e-5f);
#pragma unroll
        for (int i = 0; i < 8; ++i) { const int c = (i * 64 + lane) * 4; const f32x4 gg = *(const f32x4*)(g + c), bb = *(const f32x4*)(b + c); f32x4 o0, o1;
#pragma unroll
            for (int j = 0; j < 4; ++j) { o0[j] = (v0[i][j] - mu0) * rs0 * gg[j] + bb[j]; o1[j] = (v1[i][j] - mu1) * rs1 * gg[j] + bb[j]; }
            if (write_x) { *(f32x4*)(xr0 + c) = o0; *(f32x4*)(xr1 + c) = o1; }
            u32x2 w; w.x = cvt_pk_bf16(o0[0], o0[1]); w.y = cvt_pk_bf16(o0[2], o0[3]); *(u32x2*)(xb0 + c) = w;
            u32x2 w1; w1.x = cvt_pk_bf16(o1[0], o1[1]); w1.y = cvt_pk_bf16(o1[2], o1[3]); *(u32x2*)(xb1 + c) = w1; }
    }
}

__device__ void attn_unit(const Params& P, int layer, int b, int h, int qblk, LAS unsigned char* lds) {
    const int tid = opaque_tid(), wid = __builtin_amdgcn_readfirstlane(tid >> 6), lane_ = tid & 63, lane = lane_, l31 = lane & 31, hh = lane >> 5;
    const int c = wid & 1, rb = wid >> 1;
    const bf16_t* Hm = (const bf16_t*)(P.ws + WS_H);
    const float* tabf = (const float*)(P.ws + WS_TAB); const int* tabi = (const int*)(P.ws + WS_TAB);
    LAS float* lut = (LAS float*)(lds + 66048); LAS int* posk = (LAS int*)(lds + 65536); LAS int* pkmx = (LAS int*)(lds + 66576);
    const int q0w = qblk * 128 + rb * 32, qrow = q0w + l31;
    const size_t tok = (size_t)b * SEQ + qrow;
    bf16x8 qf[4];
    { const bf16_t* qp = Hm + tok * INC + h * 128 + c * 64 + 8 * hh;
#pragma unroll
      for (int ks = 0; ks < 4; ++ks) qf[ks] = *(const bf16x8*)(qp + 16 * ks); }
    const int pq = P.pos[b * SEQ + qrow];
    int pqmin = pq;
#pragma unroll
    for (int o = 16; o >= 1; o >>= 1) { const int t = shxi(pqmin, o, lane); pqmin = t < pqmin ? t : pqmin; }
    pqmin = __builtin_amdgcn_readfirstlane(pqmin);
    f32x16 O[4];
#pragma unroll
    for (int d = 0; d < 4; ++d) O[d] = zero16();
    float mrun = -1e30f, lrun = 0.f;
    const int nt = 2 * qblk + 2;
    const float sc2 = 0.125f * LOG2E;
    const int srow = (tid >> 4), sch = tid & 15;
    const bf16_t* gK = Hm + ((size_t)b * SEQ) * INC + 512 + h * 128 + sch * 8;
    const bf16_t* gV = gK + 512;
    u32x4 st[4];
    __syncthreads();
    if (tid < 129) lut[tid] = tabf[TB_LUT + h * 132 + tid];
#define ATT_LOAD(kt) do { const size_t r0 = (size_t)((kt) * 64 + srow) * INC; st[0] = *(const u32x4*)(gK + r0); st[1] = *(const u32x4*)(gK + r0 + (size_t)32 * INC); \
        st[2] = *(const u32x4*)(gV + r0); st[3] = *(const u32x4*)(gV + r0 + (size_t)32 * INC); } while (0)
#define ATT_STORE(buf, kt) do { LAS unsigned char* kb = lds + (buf) * 32768; *(LAS u32x4*)(kb + off_b(srow, sch)) = st[0]; *(LAS u32x4*)(kb + off_b(srow + 32, sch)) = st[1]; \
        *(LAS u32x4*)(kb + 16384 + off_b(srow, sch)) = st[2]; *(LAS u32x4*)(kb + 16384 + off_b(srow + 32, sch)) = st[3]; \
        if (tid < 64) { int pv_ = P.pos[b * SEQ + (kt) * 64 + tid]; posk[(buf) * 64 + tid] = pv_; _Pragma("unroll") for (int o_ = 32; o_ >= 1; o_ >>= 1) { const int t_ = shxi(pv_, o_, lane_); pv_ = t_ > pv_ ? t_ : pv_; } if (tid == 0) pkmx[buf] = pv_; } } while (0)
    ATT_LOAD(0); ATT_STORE(0, 0);
    __syncthreads();
    for (int kt = 0; kt < nt; ++kt) {
        const int buf = kt & 1, k0 = kt * 64;
        if (kt + 1 < nt) ATT_LOAD(kt + 1);
        if (k0 <= q0w + 31) {
            int lane = lane_; asm volatile("" : "+v"(lane)); const int l31 = lane & 31, hh = lane >> 5;
            LAS const unsigned char* Kimg = lds + buf * 32768; LAS const unsigned char* Vimg = Kimg + 16384;
            f32x16 S[2];
#pragma unroll
            for (int s2 = 0; s2 < 2; ++s2) { S[s2] = zero16();
#pragma unroll
                for (int ks = 0; ks < 4; ++ks) { const bf16x8 a = *(const LAS bf16x8*)(Kimg + off_b(32 * s2 + l31, 8 * c + 2 * ks + hh)); S[s2] = mfma32(a, qf[ks], S[s2]); } }
            const bool far = (pqmin - pkmx[buf]) >= 128;
            const bool needmask = (k0 + 63 > q0w);
            float mnew, rsum = 0.f;
            if (far && !needmask) {
                const float cb = lut[128];
                float mx = S[0][0];
#pragma unroll
                for (int s2 = 0; s2 < 2; ++s2)
#pragma unroll
                    for (int i = 0; i < 16; ++i) mx = fmaxf(mx, S[s2][i]);
                mx = fmaxf(mx, shx(mx, 32, lane));
                mnew = fmaxf(mrun, mx * sc2 + cb);
                const float off = cb - mnew;
#pragma unroll
                for (int s2 = 0; s2 < 2; ++s2)
#pragma unroll
                    for (int i = 0; i < 16; ++i) { const float pe = __builtin_amdgcn_exp2f(S[s2][i] * sc2 + off); S[s2][i] = pe; rsum += pe; }
            } else {
                if (far) { const float cb = lut[128];
#pragma unroll
                    for (int s2 = 0; s2 < 2; ++s2)
#pragma unroll
                        for (int i = 0; i < 16; ++i) S[s2][i] = S[s2][i] * sc2 + cb;
                } else {
#pragma unroll
                    for (int s2 = 0; s2 < 2; ++s2)
#pragma unroll
                        for (int i = 0; i < 16; ++i) { const int kk = 32 * s2 + 8 * (i >> 2) + 4 * hh + (i & 3); int rel = pq - posk[buf * 64 + kk]; rel = rel < 0 ? 0 : (rel > 128 ? 128 : rel);
                            S[s2][i] = S[s2][i] * sc2 + lut[rel]; }
                }
                if (needmask) {
#pragma unroll
                    for (int s2 = 0; s2 < 2; ++s2)
#pragma unroll
                        for (int i = 0; i < 16; ++i) { const int kk = k0 + 32 * s2 + 8 * (i >> 2) + 4 * hh + (i & 3); if (kk > qrow) S[s2][i] = -1e30f; }
                }
                float mx = S[0][0];
#pragma unroll
                for (int s2 = 0; s2 < 2; ++s2)
#pragma unroll
                    for (int i = 0; i < 16; ++i) mx = fmaxf(mx, S[s2][i]);
                mx = fmaxf(mx, shx(mx, 32, lane));
                mnew = fmaxf(mrun, mx);
#pragma unroll
                for (int s2 = 0; s2 < 2; ++s2)
#pragma unroll
                    for (int i = 0; i < 16; ++i) { const float pe = __builtin_amdgcn_exp2f(S[s2][i] - mnew); S[s2][i] = pe; rsum += pe; }
            }
            const float alpha = __builtin_amdgcn_exp2f(mrun - mnew);
            rsum += shx(rsum, 32, lane);
            lrun = lrun * alpha + rsum; mrun = mnew;
            if (__builtin_amdgcn_ballot_w64(alpha != 1.0f) != 0ull) {
#pragma unroll
                for (int d = 0; d < 4; ++d)
#pragma unroll
                    for (int i = 0; i < 16; ++i) O[d][i] *= alpha;
            }
#pragma unroll
            for (int s2 = 0; s2 < 2; ++s2)
#pragma unroll
                for (int sp = 0; sp < 2; ++sp) {
                    const bf16x8 pf = pack8(S[s2][8 * sp + 0], S[s2][8 * sp + 1], S[s2][8 * sp + 2], S[s2][8 * sp + 3], S[s2][8 * sp + 4], S[s2][8 * sp + 5], S[s2][8 * sp + 6], S[s2][8 * sp + 7]);
                    const unsigned rbase = 32 * s2 + 16 * sp + 4 * hh;
#pragma unroll
                    for (int d = 0; d < 4; ++d) { const bf16x8 va = cat8(tr_read(Vimg, lane, rbase, d), tr_read(Vimg, lane, rbase + 8, d)); O[d] = mfma32(va, pf, O[d]); }
                }
        }
        if (kt + 1 < nt) ATT_STORE(buf ^ 1, kt + 1);
        __syncthreads();
    }
#undef ATT_LOAD
#undef ATT_STORE
    LAS float* X = (LAS float*)lds;
    const float inv_l = 1.0f / lrun;
    if (c == 1) {
#pragma unroll
        for (int d = 0; d < 4; ++d)
#pragma unroll
            for (int i = 0; i < 16; ++i) X[(rb * 64 + d * 16 + i) * 64 + lane] = O[d][i] * inv_l;
    }
    __syncthreads();
    if (c == 0) {
        const float lam = tabf[TB_LAM + layer];
        const float lam_init = 0.8f - 0.6f * __expf(-0.3f * (float)layer);
        float ss = 0.f;
#pragma unroll
        for (int d = 0; d < 4; ++d)
#pragma unroll
            for (int i = 0; i < 16; ++i) { const float v = O[d][i] * inv_l - lam * X[(rb * 64 + d * 16 + i) * 64 + lane]; O[d][i] = v; ss += v * v; }
        ss += shx(ss, 32, lane);
        const float rs = rsqrtf(ss * (1.0f / 128.0f) + 1e-5f) * (1.0f - lam_init);
        bf16_t* Ob = (bf16_t*)(P.ws + WS_XB) + tok * DM + h * 128;
        const float* ng = P.dnorm_g + layer * 128;
#pragma unroll
        for (int d = 0; d < 4; ++d)
#pragma unroll
            for (int g4 = 0; g4 < 4; ++g4) { const int e0 = 32 * d + 8 * g4 + 4 * hh; const f32x4 gg = *(const f32x4*)(ng + e0);
                u32x2 w; w.x = cvt_pk_bf16(O[d][4 * g4] * rs * gg[0], O[d][4 * g4 + 1] * rs * gg[1]); w.y = cvt_pk_bf16(O[d][4 * g4 + 2] * rs * gg[2], O[d][4 * g4 + 3] * rs * gg[3]);
                *(u32x2*)(Ob + e0) = w; }
    }
    __syncthreads();
}

__device__ void gla_stream(const Params& P, int layer, int type, int b, int h, int sl, LAS unsigned char* lds) {
    const int tid = opaque_tid(), wid = __builtin_amdgcn_readfirstlane(tid >> 6), lane = tid & 63;
    const bf16_t* Hm = (const bf16_t*)(P.ws + WS_H);
    bf16_t* Ob = (bf16_t*)(P.ws + WS_XB);
    float* stat = (float*)(P.ws + WS_STAT);
    const int qcol = (type ? 4608 : 1536) + h * 128, kcol = (type ? 5120 : 2048) + h * 128, vcol = (type ? 5632 : 2560) + h * 128 + 32 * sl,
              ocol = (type ? 1536 : 512) + h * 128 + 32 * sl;
    const float gam = 1.0f - exp2f(-5.0f - (float)h);
    LAS float* FF = (LAS float*)lds; LAS unsigned* QK = (LAS unsigned*)lds + 2048; LAS float* VF = FF + 4096; LAS float* OP = FF + 4608;
    const int e_l = tid & 15, kg = tid >> 4;
    const int stok = tid >> 5, sc4 = (tid & 31) * 4;
    const int vtok = (tid >> 4) & 15, vc2 = (tid & 15) * 2;
    float S0[4] = {0.f, 0.f, 0.f, 0.f}, S1[4] = {0.f, 0.f, 0.f, 0.f};
    u32x2 pq2, pk2; unsigned pv1 = 0u;
    const bf16_t* gbase = Hm + ((size_t)b * SEQ + stok) * INC + sc4;
    const bf16_t* vbase = Hm + ((size_t)b * SEQ + vtok) * INC + vcol + vc2;
#define GLS_LOAD(bt) do { const bf16_t* gp = gbase + (size_t)(bt) * 16 * INC; pq2 = *(const u32x2*)(gp + qcol); pk2 = *(const u32x2*)(gp + kcol); \
        if (tid < 256) pv1 = *(const unsigned*)(vbase + (size_t)(bt) * 16 * INC); } while (0)
    GLS_LOAD(0);
    __syncthreads();
    for (int bt = 0; bt < 512; ++bt) {
        const size_t T0 = (size_t)b * SEQ + (size_t)bt * 16;
        { const int o = stok * 128 + sc4;
          if (type) { const float l0 = bf_lo(pk2.x), l1 = bf_hi(pk2.x), l2 = bf_lo(pk2.y), l3 = bf_hi(pk2.y);
              *(LAS f32x4*)(FF + o) = (f32x4){__expf(l0), __expf(l1), __expf(l2), __expf(l3)};
              const unsigned k01 = cvt_pk_bf16(1.0f - __expf(l0), 1.0f - __expf(l1)), k23 = cvt_pk_bf16(1.0f - __expf(l2), 1.0f - __expf(l3));
              *(LAS u32x4*)(QK + o) = (u32x4){(pq2.x & 0xffffu) | (k01 << 16), (pq2.x >> 16) | (k01 & 0xffff0000u), (pq2.y & 0xffffu) | (k23 << 16), (pq2.y >> 16) | (k23 & 0xffff0000u)}; }
          else {
              *(LAS u32x4*)(QK + o) = (u32x4){(pq2.x & 0xffffu) | (pk2.x << 16), (pq2.x >> 16) | (pk2.x & 0xffff0000u), (pq2.y & 0xffffu) | (pk2.y << 16), (pq2.y >> 16) | (pk2.y & 0xffff0000u)}; }
          if (tid < 256) { VF[vtok * 32 + vc2] = bf_lo(pv1); VF[vtok * 32 + vc2 + 1] = bf_hi(pv1); } }
        if (bt + 1 < 512) GLS_LOAD(bt + 1);
        __syncthreads();
        float accs[32];
#pragma unroll
        for (int tt = 0; tt < 16; ++tt) {
            const float v0 = VF[tt * 32 + e_l], v1 = VF[tt * 32 + 16 + e_l];
            f32x4 f4 = (f32x4){gam, gam, gam, gam}; if (type) f4 = *(const LAS f32x4*)(FF + tt * 128 + 4 * kg);
            const u32x4 qk = *(const LAS u32x4*)(QK + tt * 128 + 4 * kg);
            const unsigned qw[4] = {qk.x, qk.y, qk.z, qk.w};
            float a0 = 0.f, a1 = 0.f;
#pragma unroll
            for (int j = 0; j < 4; ++j) { const float q = bf_lo(qw[j]), c = bf_hi(qw[j]);
                S0[j] = f4[j] * S0[j] + c * v0; S1[j] = f4[j] * S1[j] + c * v1; a0 += q * S0[j]; a1 += q * S1[j]; }
            accs[2 * tt] = a0; accs[2 * tt + 1] = a1;
        }
        { const bool b0 = (lane & 16) != 0, b1 = (lane & 32) != 0;
          float r16[16];
#pragma unroll
          for (int i = 0; i < 16; ++i) r16[i] = swapadd16(accs[i], accs[16 + i]);
          float r8[8];
#pragma unroll
          for (int i = 0; i < 8; ++i) r8[i] = swapadd32(r16[i], r16[8 + i]);
          const int vb = (b0 ? 16 : 0) + (b1 ? 8 : 0);
#pragma unroll
          for (int i = 0; i < 8; ++i) { const int vi = vb + i; OP[((vi >> 1) * 8 + wid) * 32 + (vi & 1) * 16 + e_l] = r8[i]; } }
        __syncthreads();
        { const int tt = tid >> 5, e32 = tid & 31; const size_t tok = T0 + tt;
            float o = 0.f;
#pragma unroll
            for (int w = 0; w < 8; ++w) o += OP[(tt * 8 + w) * 32 + e32];
            Ob[tok * DM + ocol + e32] = (bf16_t)(cvt_pk_bf16(o, 0.f) & 0xffffu);
            float s1 = o, s2 = o * o;
#pragma unroll
            for (int of = 16; of >= 1; of >>= 1) { s1 += shx(s1, of, lane); s2 += shx(s2, of, lane); }
            if (e32 == 0) *(f32x4*)(stat + ((((size_t)type * MTOK + tok) * 4 + h) * 8 + 2 * sl) * 2) = (f32x4){s1, s2, 0.f, 0.f}; }
    }
#undef GLS_LOAD
    __syncthreads();
}

__device__ void gla_post_phase(const Params& P, int layer) {
    bf16_t* Ob = (bf16_t*)(P.ws + WS_XB); const bf16_t* Hm = (const bf16_t*)(P.ws + WS_H); const float* stat = (const float*)(P.ws + WS_STAT);
    const float* ng = P.hg_norm_g + layer * 512;
    const int tid = opaque_tid(); const int lane = tid & 63, gw = opaque_bid() * 8 + (tid >> 6), nw = gridDim.x * 8;
    const int hd = lane >> 4;
    for (int tok = gw; tok < MTOK; tok += nw) {
        { const float* sp = stat + (((size_t)tok) * 4 + hd) * 16; float s1 = 0.f, s2 = 0.f;
#pragma unroll
          for (int q = 0; q < 4; ++q) { const f32x4 a = *(const f32x4*)(sp + 4 * q); s1 += a[0] + a[2]; s2 += a[1] + a[3]; }
          const float mu = s1 * (1.0f / 128.0f), var = fmaxf(s2 * (1.0f / 128.0f) - mu * mu, 0.f), rs = rsqrtf(var + 1e-5f);
          u32x4* p = (u32x4*)(Ob + (size_t)tok * DM + 512 + lane * 8); const u32x4 w = *p; const u32x4 g = *(const u32x4*)(Hm + (size_t)tok * INC + 3072 + lane * 8);
          const unsigned ww[4] = {w.x, w.y, w.z, w.w}, gg[4] = {g.x, g.y, g.z, g.w}; unsigned oo[4];
#pragma unroll
          for (int j = 0; j < 4; ++j) oo[j] = cvt_pk_bf16((bf_lo(ww[j]) - mu) * rs * silu_f(bf_lo(gg[j])), (bf_hi(ww[j]) - mu) * rs * silu_f(bf_hi(gg[j])));
          *p = (u32x4){oo[0], oo[1], oo[2], oo[3]}; }
        { const float* sp = stat + (((size_t)MTOK + tok) * 4) * 16; float s2 = 0.f;
#pragma unroll
          for (int q = 0; q < 16; ++q) { const f32x4 a = *(const f32x4*)(sp + 4 * q); s2 += a[1] + a[3]; }
          const float rs = rsqrtf(s2 * (1.0f / 512.0f) + 1e-5f);
          u32x4* p = (u32x4*)(Ob + (size_t)tok * DM + 1536 + lane * 8); const u32x4 w = *p; const u32x4 g = *(const u32x4*)(Hm + (size_t)tok * INC + 6144 + lane * 8);
          const f32x4 n0 = *(const f32x4*)(ng + lane * 8), n1 = *(const f32x4*)(ng + lane * 8 + 4);
          const unsigned ww[4] = {w.x, w.y, w.z, w.w}, gg[4] = {g.x, g.y, g.z, g.w}; const float nn[8] = {n0[0], n0[1], n0[2], n0[3], n1[0], n1[1], n1[2], n1[3]}; unsigned oo[4];
#pragma unroll
          for (int j = 0; j < 4; ++j) oo[j] = cvt_pk_bf16(bf_lo(ww[j]) * rs * nn[2 * j] * silu_f(bf_lo(gg[j])), bf_hi(ww[j]) * rs * nn[2 * j + 1] * silu_f(bf_hi(gg[j])));
          *p = (u32x4){oo[0], oo[1], oo[2], oo[3]}; }
    }
}

__device__ void gmlp_unit(const Params& P, int layer, int b, int chunk, LAS unsigned char* lds) {
    constexpr unsigned VIMG = 0, WIMG = 32768, MU = 65536, RS = 66048;
    const int tid = opaque_tid(), wid = __builtin_amdgcn_readfirstlane(tid >> 6), lane = tid & 63, l31 = lane & 31, hh = lane >> 5;
    const bf16_t* Hm = (const bf16_t*)(P.ws + WS_H);
    bf16_t* Ob = (bf16_t*)(P.ws + WS_XB);
    const size_t T0 = (size_t)b * SEQ + chunk * 128;
    __syncthreads();
    for (int i = 0; i < 16; ++i) { const int t = wid * 16 + i; const u32x4 w = *(const u32x4*)(Hm + (T0 + t) * INC + 4096 + lane * 8);
        const float v[8] = {bf_lo(w.x), bf_hi(w.x), bf_lo(w.y), bf_hi(w.y), bf_lo(w.z), bf_hi(w.z), bf_lo(w.w), bf_hi(w.w)};
        float s = 0.f;
#pragma unroll
        for (int j = 0; j < 8; ++j) s += v[j];
#pragma unroll
        for (int o = 32; o >= 1; o >>= 1) s += shx(s, o, lane);
        const float mu = s * (1.0f / 512.0f); float q = 0.f;
#pragma unroll
        for (int j = 0; j < 8; ++j) { const float d = v[j] - mu; q += d * d; }
#pragma unroll
        for (int o = 32; o >= 1; o >>= 1) q += shx(q, o, lane);
        if (lane == 0) { ((LAS float*)(lds + MU))[t] = mu; ((LAS float*)(lds + RS))[t] = rsqrtf(q * (1.0f / 512.0f) + 1e-5f); } }
    __syncthreads();
    const int tb = wid & 3, ct0 = 2 * (wid >> 2);
    for (int g = 0; g < 4; ++g) {
        const float* lg = P.g_ln_g + layer * 512 + g * 128; const float* lb = P.g_ln_b + layer * 512 + g * 128;
        const float* Wg = P.g_ws + ((size_t)(layer * 4 + g)) * 128 * 128;
#pragma unroll
        for (int i = 0; i < 4; ++i) { const int n = tid + 512 * i, s = n >> 4, ch = n & 15;
            const u32x4 w = *(const u32x4*)(Hm + (T0 + s) * INC + 4096 + g * 128 + ch * 8);
            const float mu = ((LAS float*)(lds + MU))[s], rs = ((LAS float*)(lds + RS))[s];
            const f32x4 g0 = *(const f32x4*)(lg + ch * 8), g1 = *(const f32x4*)(lg + ch * 8 + 4), b0 = *(const f32x4*)(lb + ch * 8), b1 = *(const f32x4*)(lb + ch * 8 + 4);
            const float v[8] = {bf_lo(w.x), bf_hi(w.x), bf_lo(w.y), bf_hi(w.y), bf_lo(w.z), bf_hi(w.z), bf_lo(w.w), bf_hi(w.w)};
            float y[8];
#pragma unroll
            for (int j = 0; j < 8; ++j) y[j] = (v[j] - mu) * rs * (j < 4 ? g0[j] : g1[j - 4]) + (j < 4 ? b0[j] : b1[j - 4]);
            *(LAS bf16x8*)(lds + VIMG + off_b(s, ch)) = pack8(y[0], y[1], y[2], y[3], y[4], y[5], y[6], y[7]);
            const f32x4 w0 = *(const f32x4*)(Wg + s * 128 + ch * 8), w1 = *(const f32x4*)(Wg + s * 128 + ch * 8 + 4);
            float ww[8];
#pragma unroll
            for (int j = 0; j < 8; ++j) ww[j] = (ch * 8 + j <= s) ? (j < 4 ? w0[j] : w1[j - 4]) : 0.f;
            *(LAS bf16x8*)(lds + WIMG + off_b(s, ch)) = pack8(ww[0], ww[1], ww[2], ww[3], ww[4], ww[5], ww[6], ww[7]); }
        __syncthreads();
        f32x16 acc[2]; acc[0] = zero16(); acc[1] = zero16();
        for (int ks = 0; ks < 2 * (tb + 1); ++ks) {
            const bf16x8 bw = *(const LAS bf16x8*)(lds + WIMG + off_b(32 * tb + l31, 2 * ks + hh));
#pragma unroll
            for (int e = 0; e < 2; ++e) { const bf16x8 av = cat8(tr_read(lds + VIMG, lane, 16 * ks + 8 * hh, ct0 + e), tr_read(lds + VIMG, lane, 16 * ks + 8 * hh + 4, ct0 + e)); acc[e] = mfma32(av, bw, acc[e]); }
        }
        { const int t = 32 * tb + l31; const size_t tok = T0 + t; const float bs = P.g_bs[(layer * 4 + g) * 128 + t];
#pragma unroll
          for (int e = 0; e < 2; ++e)
#pragma unroll
              for (int g4 = 0; g4 < 4; ++g4) { const int c0 = 32 * (ct0 + e) + 8 * g4 + 4 * hh;
                  const u32x2 uw = *(const u32x2*)(Hm + tok * INC + 3584 + g * 128 + c0);
                  u32x2 w; w.x = cvt_pk_bf16(bf_lo(uw.x) * (acc[e][4 * g4] + bs), bf_hi(uw.x) * (acc[e][4 * g4 + 1] + bs)); w.y = cvt_pk_bf16(bf_lo(uw.y) * (acc[e][4 * g4 + 2] + bs), bf_hi(uw.y) * (acc[e][4 * g4 + 3] + bs));
                  *(u32x2*)(Ob + tok * DM + 1024 + g * 128 + c0) = w; } }
        __syncthreads();
    }
}

__device__ void mixer_phase(const Params& P, int layer, LAS unsigned char* lds) {
    unsigned* qc = (unsigned*)(P.ws + WS_TAB) + TB_Q + layer;
    LAS unsigned* slot = (LAS unsigned*)(lds + LDS_BYTES - 16);
    for (;;) {
        __syncthreads();
        if (threadIdx.x == 0) *slot = atomicAdd(qc, 1u);
        __syncthreads();
        const int item = (int)*slot;
        if (item >= 128 + 512 + 256) break;
        if (item < 128) { const int st = item >> 2; gla_stream(P, layer, 1 - (st >> 4), (st >> 2) & 3, st & 3, item & 3, lds); }
        else if (item < 640) { const int a = item - 128, bh = a >> 5, pr = a & 31;
            for (int u2 = 0; u2 < 2; ++u2) attn_unit(P, layer, bh >> 2, bh & 3, u2 ? pr : 63 - pr, lds); }
        else { const int c = item - 640; gmlp_unit(P, layer, c >> 6, c & 63, lds); }
    }
}

__device__ void dnorm_phase(const Params& P) {
    bf16_t* Ob = (bf16_t*)(P.ws + WS_XB); const float* ssq = (const float*)(P.ws + WS_SSQ);
    const int tid = opaque_tid(); const int lane = tid & 63, gw = opaque_bid() * 8 + (tid >> 6), nw = gridDim.x * 8;
    for (int tok = gw; tok < MTOK; tok += nw) {
        const f32x4 s = *(const f32x4*)(ssq + (size_t)tok * 4);
        const float rs = rsqrtf((s[0] + s[1] + s[2] + s[3]) * (1.0f / 512.0f) + 1e-5f);
        u32x4* p = (u32x4*)(Ob + (size_t)tok * DM + 1536 + lane * 8);
        const u32x4 w = *p; u32x4 o;
        o.x = cvt_pk_bf16(bf_lo(w.x) * rs, bf_hi(w.x) * rs); o.y = cvt_pk_bf16(bf_lo(w.y) * rs, bf_hi(w.y) * rs);
        o.z = cvt_pk_bf16(bf_lo(w.z) * rs, bf_hi(w.z) * rs); o.w = cvt_pk_bf16(bf_lo(w.w) * rs, bf_hi(w.w) * rs);
        *p = o;
#ifdef ZG
        { unsigned z0 = 0u; asm volatile("" : "+v"(z0)); *(u32x4*)(Ob + (size_t)tok * DM + ZG * 512 + lane * 8) = (u32x4){z0, z0, z0, z0}; }
#endif
    }
}


__device__ void diag_phase(const Params& P) {
    const bf16_t* Hm = (const bf16_t*)(P.ws + WS_H); const bf16_t* Ob = (const bf16_t*)(P.ws + WS_XB);
    unsigned* flag = (unsigned*)(P.ws + WS_TAB) + 4000;
    const float* cs = (const float*)(P.ws + WS_CS);
    unsigned f = 0;
    const size_t gt = (size_t)opaque_bid() * 512 + opaque_tid(), gn = (size_t)gridDim.x * 512;
    for (size_t i = gt; i < (size_t)MTOK * 2048; i += gn) { const size_t tok = i >> 11; const int c = (int)(i & 2047);
        const unsigned short v = Hm[tok * INC + 1536 + c]; if ((v & 0x7f80) == 0x7f80) f |= (c < 1024) ? 1u : 2u; }
    for (size_t i = gt; i < (size_t)MTOK * 512; i += gn) { const size_t tok = i >> 9; const int c = (int)(i & 511);
        const unsigned short v = Ob[tok * DM + 512 + c]; if ((v & 0x7f80) == 0x7f80) f |= 4u; }
    for (size_t i = gt; i < (size_t)MTOK * 128; i += gn) { if (!(fabsf(cs[i]) < 1e30f)) f |= 8u; }
    if (f) atomicOr(flag, f);
}


__device__ __forceinline__ void grid_barrier(unsigned* ctr, unsigned nbar) {
    asm volatile("s_waitcnt vmcnt(0)" ::: "memory");
    __syncthreads();
    if (threadIdx.x == 0) {
        __builtin_amdgcn_fence(__ATOMIC_RELEASE, "agent");
        asm volatile("s_waitcnt vmcnt(0)" ::: "memory");
        const unsigned gsz = gridDim.x >> 3;
        unsigned* gc = ctr + (blockIdx.x & 7u) * 32u; unsigned* glob = ctr + 8u * 32u;
        const unsigned old = __hip_atomic_fetch_add(gc, 1u, __ATOMIC_RELAXED, __HIP_MEMORY_SCOPE_AGENT);
        if (old + 1u == nbar * gsz) __hip_atomic_fetch_add(glob, 1u, __ATOMIC_RELAXED, __HIP_MEMORY_SCOPE_AGENT);
        while (__hip_atomic_load(glob, __ATOMIC_RELAXED, __HIP_MEMORY_SCOPE_AGENT) < nbar * 8u) __builtin_amdgcn_s_sleep(1);
        __builtin_amdgcn_fence(__ATOMIC_ACQUIRE, "agent");
        asm volatile("s_waitcnt vmcnt(0)" ::: "memory");
    }
    __syncthreads();
}

template <class Epi> __device__ __forceinline__ void run_gemm(LAS unsigned char* lds, const bf16_t* A, const bf16_t* Bt, int N, int K, const Epi& E) {
    pg8::Gemm g; g.A = A; g.Bt = Bt; g.M = MTOK; g.N = N; g.K = K;
    pg8::StaticOrder S; S.init(MTOK, N, (int)gridDim.x, opaque_bid());
    pg8::gemm_phase<Epi>(lds, g, S, E);
}

typedef const __attribute__((address_space(4))) Params* KParamsPtr;
__global__ __launch_bounds__(512, 2) void fwd_megakernel(const Params Pin) {
    extern __shared__ __attribute__((aligned(16))) unsigned char shm[];
    LAS unsigned char* lds = (LAS unsigned char*)shm;
    cg::grid_group grid = cg::this_grid();
    const KParamsPtr kp = (KParamsPtr)__builtin_amdgcn_kernarg_segment_ptr();
    unsigned nbar = 0u;
    for (int ph = Pin.ph_lo; ph < Pin.ph_hi; ++ph) {
        if (Pin.ph_lo < 0) grid.sync();
        if (ph > Pin.ph_lo) { nbar += 1u; grid_barrier((unsigned*)(Pin.ws + WS_TAB) + 8000, nbar); }
        KParamsPtr kq = kp; asm volatile("" : "+s"(kq));
        const Params& P = *(const Params*)kq;
        unsigned char* ws = P.ws;
        float* X = P.out;
        bf16_t* Xb = (bf16_t*)(ws + WS_XB);
        bf16_t* Hb = (bf16_t*)(ws + WS_H);
        if (ph == 0) { prep_phase(P, lds); continue; }
        const int L = (ph - 1) / 13, s = (ph - 1) % 13;
        { const int lnk = (s == 2) ? 0 : (s == 7) ? 1 : (s == 10) ? 2 : (s == 12) ? 3 : -1;
          if (lnk >= 0) { ln_phase(X, P.ln_g + (L * 4 + lnk) * DM, P.ln_b + (L * 4 + lnk) * DM, Xb, lnk == 0 || (lnk == 3 && L == DEPTH - 1)); continue; } }
        switch (s) {
        case 0: { EpiSwiGLU E; E.H = Hb; run_gemm(lds, Xb, (const bf16_t*)(ws + WS_W1IN + L * SZ_W1IN), 2 * DFF, DM, E); } break;
        case 1: { EpiRes E; E.res = (L == 0) ? P.x : nullptr; E.resb = Xb; E.out = X; E.scale = 0.5f; run_gemm(lds, Hb, (const bf16_t*)(ws + WS_W1OUT + L * SZ_W1OUT), DM, DFF, E); } break;
        case 3: { EpiMixIn E; E.Hm = Hb; E.cs = (const f32x2*)(ws + WS_CS); E.loglb = (const float*)(ws + WS_TAB) + TB_LOGLB + L * 512;
                  run_gemm(lds, Xb, (const bf16_t*)(ws + WS_WMI + L * SZ_WMI), INC, DM, E); } break;
        case 4: mixer_phase(P, L, lds); break;
        case 5: gla_post_phase(P, L); break;
        case 6: { EpiRes E; E.res = X; E.resb = nullptr; E.out = X; E.scale = 1.0f; run_gemm(lds, Xb, (const bf16_t*)(ws + WS_WMO + L * SZ_WMO), DM, DM, E); } break;
        case 8: { EpiSwiGLU E; E.H = Hb; run_gemm(lds, Xb, (const bf16_t*)(ws + WS_W2IN + L * SZ_W1IN), 2 * DFF, DM, E); } break;
        case 9: { EpiRes E; E.res = nullptr; E.resb = Xb; E.out = X; E.scale = 0.5f; run_gemm(lds, Hb, (const bf16_t*)(ws + WS_W2OUT + L * SZ_W1OUT), DM, DFF, E); } break;
        case 11: { EpiPE E1; E1.pe = (float*)(ws + WS_H); run_gemm(lds, (const bf16_t*)(ws + WS_PB) + (size_t)L * MTOK * PLE, (const bf16_t*)(ws + WS_WE + L * SZ_WE), DM, PLE, E1);
                   EpiGate E2; E2.X = X; E2.pe = (const float*)(ws + WS_H); E2.xb = Xb; run_gemm(lds, Xb, (const bf16_t*)(ws + WS_WG + L * SZ_WG), DM, DM, E2); } break;
        }
    }
}

extern "C" void kernel_launch(void* const* d_in, const int* in_sizes, int n_in, void* d_out, int out_size, void* d_ws, size_t ws_size, hipStream_t stream) {
    static int grid = 0;
    if (grid == 0) {
        if (n_in != 22 || out_size != MTOK * DM || ws_size < WS_END) { fprintf(stderr, "kernel_launch: unexpected shapes (n_in %d out %d ws %zu need %zu)\n", n_in, out_size, ws_size, (size_t)WS_END); grid = -1; return; }
        int dev = 0, cus = 0, per_cu = 0;
        (void)hipGetDevice(&dev); (void)hipDeviceGetAttribute(&cus, hipDeviceAttributeMultiprocessorCount, dev);
        if (hipFuncSetAttribute((const void*)fwd_megakernel, hipFuncAttributeMaxDynamicSharedMemorySize, LDS_BYTES) != hipSuccess) { fprintf(stderr, "kernel_launch: hipFuncSetAttribute failed\n"); grid = -1; return; }
        if (hipOccupancyMaxActiveBlocksPerMultiprocessor(&per_cu, (const void*)fwd_megakernel, 512, LDS_BYTES) != hipSuccess || per_cu < 1) { fprintf(stderr, "kernel_launch: occupancy query says %d\n", per_cu); per_cu = 1; }
        (void)hipGetLastError();
        grid = cus & ~7;
    }
    if (grid < 0) return;
    Params p; memset(&p, 0, sizeof(p));
    p.x = (const float*)d_in[0]; p.p = (const float*)d_in[1]; p.pos = (const int*)d_in[2];
    p.ffn1_in = (const float*)d_in[3]; p.ffn1_out = (const float*)d_in[4]; p.mix_in = (const float*)d_in[5]; p.mix_out = (const float*)d_in[6];
    p.rel_bias = (const float*)d_in[7]; p.dlam = (const float*)d_in[8]; p.dnorm_g = (const float*)d_in[9]; p.g_ln_g = (const float*)d_in[10]; p.g_ln_b = (const float*)d_in[11];
    p.g_ws = (const float*)d_in[12]; p.g_bs = (const float*)d_in[13]; p.lb_logits = (const float*)d_in[14]; p.hg_norm_g = (const float*)d_in[15];
    p.ffn2_in = (const float*)d_in[16]; p.ffn2_out = (const float*)d_in[17]; p.ple_gate = (const float*)d_in[18]; p.ple_proj = (const float*)d_in[19];
    p.ln_g = (const float*)d_in[20]; p.ln_b = (const float*)d_in[21];
    p.out = (float*)d_out; p.ws = (unsigned char*)d_ws;
    p.ph_lo = 0; p.ph_hi = NPH;
    for (int i = 0; i < 64; ++i) p.inv[i] = pow(10000.0, -(double)i / 63.0);
    (void)hipMemsetAsync((unsigned char*)d_ws + WS_TAB + 32000, 0, 9 * 128, stream);
    void* args[] = {&p};
    hipError_t e = hipLaunchCooperativeKernel((const void*)fwd_megakernel, dim3(grid), dim3(512), args, LDS_BYTES, stream);
    if (e != hipSuccess) fprintf(stderr, "kernel_launch: cooperative launch failed: %s (grid %d)\n", hipGetErrorString(e), grid);
}
```

```cpp
#include <hip/hip_runtime.h>
#include <hip/hip_cooperative_groups.h>
#include <math.h>
#include <stdio.h>
#include <string.h>
namespace cg = cooperative_groups;

#define LAS __attribute__((address_space(3)))
typedef unsigned short bf16_t;
typedef short bf16x8 __attribute__((ext_vector_type(8)));
typedef short s16x4 __attribute__((ext_vector_type(4)));
typedef float f32x2 __attribute__((ext_vector_type(2)));
typedef float f32x4 __attribute__((ext_vector_type(4)));
typedef float f32x16 __attribute__((ext_vector_type(16)));
typedef unsigned u32x2 __attribute__((ext_vector_type(2)));
typedef unsigned u32x4 __attribute__((ext_vector_type(4)));

constexpr int MTOK = 32768, SEQ = 8192, DM = 2048, DFF = 5632, INC = 6656, PLE = 256, DEPTH = 2;
constexpr float ALPHA = 1.41421356237f;
constexpr float LOG2E = 1.44269504089f;
constexpr int LDS_BYTES = 147456;
constexpr int NPH = 1 + 13 * DEPTH;

constexpr size_t SZ_W1IN = (size_t)2 * DFF * DM * 2, SZ_W1OUT = (size_t)DM * DFF * 2, SZ_WMI = (size_t)INC * DM * 2, SZ_WMO = (size_t)DM * DM * 2,
                 SZ_WG = (size_t)DM * DM * 2, SZ_WE = (size_t)DM * PLE * 2;
constexpr size_t WS_W1IN = 0, WS_W1OUT = WS_W1IN + DEPTH * SZ_W1IN, WS_WMI = WS_W1OUT + DEPTH * SZ_W1OUT, WS_WMO = WS_WMI + DEPTH * SZ_WMI,
                 WS_W2IN = WS_WMO + DEPTH * SZ_WMO, WS_W2OUT = WS_W2IN + DEPTH * SZ_W1IN, WS_WG = WS_W2OUT + DEPTH * SZ_W1OUT, WS_WE = WS_WG + DEPTH * SZ_WG,
                 WS_H = WS_WE + DEPTH * SZ_WE, WS_XB = WS_H + (size_t)MTOK * INC * 2, WS_PB = WS_XB + (size_t)MTOK * DM * 2,
                 WS_CS = WS_PB + (size_t)DEPTH * MTOK * PLE * 2, WS_SSQ = WS_CS + (size_t)MTOK * 64 * 8, WS_TAB = WS_SSQ + (size_t)MTOK * 4 * 4,
                 WS_STAT = WS_TAB + 65536, WS_END = WS_STAT + (size_t)2 * MTOK * 4 * 8 * 2 * 4;
constexpr int TB_LOGLB = 0  , TB_LUT = 1024  , TB_LAM = 1600  , TB_PMAX = 1664  , TB_Q = 2304  ;

struct Params {
    const float* x; const float* p; const int* pos;
    const float *ffn1_in, *ffn1_out, *mix_in, *mix_out, *rel_bias, *dlam, *dnorm_g, *g_ln_g, *g_ln_b, *g_ws, *g_bs, *lb_logits, *hg_norm_g,
        *ffn2_in, *ffn2_out, *ple_gate, *ple_proj, *ln_g, *ln_b;
    float* out; unsigned char* ws;
    int ph_lo, ph_hi;
    double inv[64];
};

__device__ __forceinline__ unsigned cvt_pk_bf16(float lo, float hi) { unsigned r; asm("v_cvt_pk_bf16_f32 %0, %1, %2" : "=v"(r) : "v"(lo), "v"(hi)); return r; }
__device__ __forceinline__ float bf_lo(unsigned w) { return __uint_as_float(w << 16); }
__device__ __forceinline__ float bf_hi(unsigned w) { return __uint_as_float(w & 0xffff0000u); }
__device__ __forceinline__ unsigned off_b(unsigned row, unsigned ch) { return 256u * row + 16u * (ch ^ (((row & 3u) << 2) | ((row >> 2) & 3u))); }
__device__ __forceinline__ s16x4 tr_read(LAS const unsigned char* img, unsigned lane, unsigned rowbase, unsigned c) {
    const unsigned blk = (lane >> 4) & 1u, qq = (lane & 15u) >> 2, p = lane & 3u;
    return __builtin_amdgcn_ds_read_tr16_b64_v4i16((LAS s16x4*)(img + off_b(rowbase + qq, 4u * c + 2u * blk + (p >> 1)) + 8u * (p & 1u)));
}
__device__ __forceinline__ bf16x8 cat8(s16x4 a, s16x4 b) { bf16x8 r; r[0] = a[0]; r[1] = a[1]; r[2] = a[2]; r[3] = a[3]; r[4] = b[0]; r[5] = b[1]; r[6] = b[2]; r[7] = b[3]; return r; }
__device__ __forceinline__ bf16x8 pack8(float a0, float a1, float a2, float a3, float a4, float a5, float a6, float a7) {
    u32x4 w; w.x = cvt_pk_bf16(a0, a1); w.y = cvt_pk_bf16(a2, a3); w.z = cvt_pk_bf16(a4, a5); w.w = cvt_pk_bf16(a6, a7);
    return __builtin_bit_cast(bf16x8, w);
}
__device__ __forceinline__ f32x16 mfma32(bf16x8 a, bf16x8 b, f32x16 c) { return __builtin_amdgcn_mfma_f32_32x32x16_bf16(a, b, c, 0, 0, 0); }
__device__ __forceinline__ float silu_f(float v) { return v * __builtin_amdgcn_rcpf(1.0f + __expf(-v)); }
__device__ __forceinline__ float shx(float v, int off, int lane) { return __int_as_float(__builtin_amdgcn_ds_bpermute((lane ^ off) << 2, __float_as_int(v))); }
__device__ __forceinline__ int shxi(int v, int off, int lane) { return __builtin_amdgcn_ds_bpermute((lane ^ off) << 2, v); }
__device__ __forceinline__ float swapadd16(float a, float b) { auto r = __builtin_amdgcn_permlane16_swap(__float_as_uint(a), __float_as_uint(b), false, false); return __uint_as_float(r[0]) + __uint_as_float(r[1]); }
__device__ __forceinline__ float swapadd32(float a, float b) { auto r = __builtin_amdgcn_permlane32_swap(__float_as_uint(a), __float_as_uint(b), false, false); return __uint_as_float(r[0]) + __uint_as_float(r[1]); }
__device__ __forceinline__ int opaque_tid() { int t = threadIdx.x; asm volatile("" : "+v"(t)); return t; }
__device__ __forceinline__ int opaque_bid() { int t = blockIdx.x; asm volatile("" : "+s"(t)); return t; }
__device__ __forceinline__ f32x16 zero16() { f32x16 z; for (int i = 0; i < 16; ++i) z[i] = 0.f; return z; }

namespace pg8 {
constexpr int BM = 256, BK = 64, HALF = 128, HTB = HALF * BK * 2, STAGE_BYTES = 8 * HTB, NXCD = 8, WGM = 8;
__device__ __forceinline__ int lds_byte(int r, int c) { const int st = (r >> 4) * 2 + (c >> 5), rr = r & 15, cc = c & 31, ob = rr * 64 + cc * 2; return st * 1024 + (ob ^ (((ob >> 9) & 1) << 5)); }
__device__ __forceinline__ void stage_rc(int b, int& R, int& C) { const int st = b / 1024, sb = b % 1024, swz = sb ^ (((sb >> 9) & 1) << 5); R = (st >> 1) * 16 + swz / 64; C = (st & 1) * 32 + (swz % 64) / 2; }
__device__ __forceinline__ int perm32(int rho) { const int n = rho >> 4, i = rho & 15; return 8 * (i >> 2) + 4 * n + (i & 3); }
struct Unit { int pm, pn; };
struct Gemm { const bf16_t* A; const bf16_t* Bt; int M, N, K; };
struct StaticOrder {
    int nM, nN, nwg, G, c;
    __device__ void init(int M, int N, int G_, int c_) { nM = M / BM; nN = N / BM; nwg = nM * nN; G = G_; c = c_; }
    __device__ bool next(int i, Unit& u) const {
        const long L = (long)i * G + c; if (L >= nwg) return false;
        int wgid = (int)L; { const int q = nwg / NXCD, r = nwg % NXCD, xcd = wgid % NXCD, off = wgid / NXCD; wgid = (xcd < r ? xcd * (q + 1) : r * (q + 1) + (xcd - r) * q) + off; }
        const int nig = WGM * nN, gid = wgid / nig, fm = gid * WGM, gsz = (nM - fm) < WGM ? (nM - fm) : WGM;
        u.pm = fm + ((wgid % nig) % gsz); u.pn = (wgid % nig) / gsz; return true;
    }
};
template <class Epi>
__device__ __forceinline__ void gemm_phase(LAS unsigned char* lds, const Gemm g, const StaticOrder& S, const Epi& E) {
    const int tid = opaque_tid(), wid = __builtin_amdgcn_readfirstlane(tid >> 6), lane = tid & 63, wr = wid >> 2, wc = wid & 3, fr = lane & 15, fq = lane >> 4;
    const int K = g.K, nt = K / BK;
    unsigned voffA[2], voffB[2];
#pragma unroll
    for (int i = 0; i < 2; ++i) { int R, C; stage_rc(tid * 16 + i * 8192, R, C); const int Rb = Epi::PERM ? ((R & ~31) + perm32(R & 31)) : R;
        voffA[i] = (unsigned)(R * K + C) * 2u; voffB[i] = (unsigned)(Rb * K + C) * 2u; }
    const size_t kstep = (size_t)(BK * 2), hstep = (size_t)HALF * K * 2, tstep = 2 * hstep;
    const unsigned ldsw = (unsigned)wid * 1024u;
    const int aoff = lds_byte(wr * 64 + fr, fq * 8), boff = lds_byte(wc * 32 + fr, fq * 8);
#define PG8_SA(b, h) (((b) * 2 + (h)) * HTB)
#define PG8_SB(b, h) ((4 + (b) * 2 + (h)) * HTB)
#define PG8_STAGE(bufoff, gbase, voff) do { _Pragma("unroll") for (int _i = 0; _i < 2; ++_i) \
        __builtin_amdgcn_global_load_lds((const unsigned*)((const char*)(gbase) + (voff)[_i]), (LAS unsigned*)(lds + (bufoff) + ldsw + _i * 8192), 16, 0, 0); } while (0)
#define PG8_LDA(dst, b, h) do { _Pragma("unroll") for (int m = 0; m < 4; ++m) _Pragma("unroll") for (int k = 0; k < 2; ++k) dst[m][k] = *(const LAS bf16x8*)(lds + PG8_SA(b, h) + aoff + m * 2048 + k * 1024); } while (0)
#define PG8_LDB(dst, b, h) do { _Pragma("unroll") for (int n = 0; n < 2; ++n) _Pragma("unroll") for (int k = 0; k < 2; ++k) dst[n][k] = *(const LAS bf16x8*)(lds + PG8_SB(b, h) + boff + n * 2048 + k * 1024); } while (0)
#define PG8_MMA(ai, bj, At, Bt) do { __builtin_amdgcn_s_setprio(1); _Pragma("unroll") for (int m = 0; m < 4; ++m) _Pragma("unroll") for (int n = 0; n < 2; ++n) _Pragma("unroll") for (int k = 0; k < 2; ++k) \
        acc[ai][bj][m][n] = __builtin_amdgcn_mfma_f32_16x16x32_bf16(Bt[n][k], At[m][k], acc[ai][bj][m][n], 0, 0, 0); __builtin_amdgcn_s_setprio(0); } while (0)
#define PG8_WAIT_V(n) asm volatile("s_waitcnt vmcnt(" #n ")" ::: "memory")
#define PG8_WAIT_L(n) asm volatile("s_waitcnt lgkmcnt(" #n ")" ::: "memory")
#define PG8_BAR __builtin_amdgcn_s_barrier()
#define PG8_SCHED __builtin_amdgcn_sched_barrier(0)
    Unit cur, nxt; int ui = 0;
    if (!S.next(0, cur)) return;
    f32x4 acc[2][2][4][2];
#pragma unroll
    for (int a = 0; a < 2; ++a)
#pragma unroll
        for (int b = 0; b < 2; ++b)
#pragma unroll
            for (int m = 0; m < 4; ++m)
#pragma unroll
                for (int n = 0; n < 2; ++n) acc[a][b][m][n] = (f32x4){0.f, 0.f, 0.f, 0.f};
    bf16x8 At[4][2], B0[2][2], B1[2][2];
    const char* cA = (const char*)g.A + (size_t)cur.pm * tstep; const char* cB = (const char*)g.Bt + (size_t)cur.pn * tstep;
    PG8_STAGE(PG8_SB(0, 0), cB, voffB); PG8_STAGE(PG8_SA(0, 0), cA, voffA); PG8_STAGE(PG8_SB(0, 1), cB + hstep, voffB); PG8_STAGE(PG8_SA(0, 1), cA + hstep, voffA);
    if (wr == 1) PG8_BAR;
    PG8_WAIT_V(4); PG8_BAR;
    PG8_STAGE(PG8_SB(1, 0), cB + kstep, voffB); PG8_STAGE(PG8_SA(1, 0), cA + kstep, voffA); PG8_STAGE(PG8_SB(1, 1), cB + hstep + kstep, voffB);
    PG8_WAIT_V(6); PG8_BAR;
    for (;;) {
        const bool has_next = S.next(ui + 1, nxt);
        const char* nA = has_next ? (const char*)g.A + (size_t)nxt.pm * tstep : cA; const char* nB = has_next ? (const char*)g.Bt + (size_t)nxt.pn * tstep : cB;
        for (int t = 0; t < nt; t += 2) {
            const bool last = (t == nt - 2);
            const char* a1 = cA + (size_t)(t + 1) * kstep;
            const char* a2 = last ? nA : cA + (size_t)(t + 2) * kstep; const char* b2 = last ? nB : cB + (size_t)(t + 2) * kstep;
            const char* a3 = a2 + kstep; const char* b3 = b2 + kstep;
            PG8_LDB(B0, 0, 0); PG8_SCHED; PG8_LDA(At, 0, 0); PG8_STAGE(PG8_SA(1, 1), a1 + hstep, voffA);
            PG8_WAIT_L(8); PG8_BAR; PG8_WAIT_L(0); PG8_MMA(0, 0, At, B0); PG8_BAR; PG8_SCHED;
            PG8_LDB(B1, 0, 1); PG8_STAGE(PG8_SB(0, 0), b2, voffB);
            PG8_BAR; PG8_WAIT_L(0); PG8_MMA(0, 1, At, B1); PG8_BAR;
            PG8_LDA(At, 0, 1); PG8_STAGE(PG8_SA(0, 0), a2, voffA);
            PG8_BAR; PG8_WAIT_L(0); PG8_MMA(1, 0, At, B0); PG8_BAR; PG8_SCHED;
            PG8_STAGE(PG8_SB(0, 1), b2 + hstep, voffB);
            PG8_WAIT_V(6); PG8_BAR; PG8_MMA(1, 1, At, B1); PG8_BAR;
            PG8_LDB(B0, 1, 0); PG8_SCHED; PG8_LDA(At, 1, 0); PG8_STAGE(PG8_SA(0, 1), a2 + hstep, voffA);
            PG8_WAIT_L(8); PG8_BAR; PG8_WAIT_L(0); PG8_MMA(0, 0, At, B0); PG8_BAR; PG8_SCHED;
            PG8_LDB(B1, 1, 1); PG8_STAGE(PG8_SB(1, 0), b3, voffB);
            PG8_BAR; PG8_WAIT_L(0); PG8_MMA(0, 1, At, B1); PG8_BAR;
            PG8_LDA(At, 1, 1); PG8_STAGE(PG8_SA(1, 0), a3, voffA);
            PG8_BAR; PG8_WAIT_L(0); PG8_MMA(1, 0, At, B0); PG8_BAR; PG8_SCHED;
            PG8_STAGE(PG8_SB(1, 1), b3 + hstep, voffB);
            PG8_WAIT_V(6); PG8_BAR; PG8_MMA(1, 1, At, B1); PG8_BAR;
        }
        E(acc, cur, wr, wc, fr, fq);
        if (!has_next) break;
#pragma unroll
        for (int a = 0; a < 2; ++a)
#pragma unroll
            for (int b = 0; b < 2; ++b)
#pragma unroll
                for (int m = 0; m < 4; ++m)
#pragma unroll
                    for (int n = 0; n < 2; ++n) acc[a][b][m][n] = (f32x4){0.f, 0.f, 0.f, 0.f};
        cur = nxt; cA = nA; cB = nB; ++ui;
    }
    PG8_WAIT_V(0);
    if (wr == 0) PG8_BAR;
    PG8_BAR;
#undef PG8_SA
#undef PG8_SB
#undef PG8_STAGE
#undef PG8_LDA
#undef PG8_LDB
#undef PG8_MMA
#undef PG8_WAIT_V
#undef PG8_WAIT_L
#undef PG8_BAR
#undef PG8_SCHED
}
}
using pg8::Unit; using pg8::BM; using pg8::HALF;
typedef f32x4 Acc[2][2][4][2];

__device__ __forceinline__ float gelu_f(float v) {
    const float av = fabsf(v), t = __builtin_amdgcn_rcpf(av * 0.2316418882f + 1.0f);
    float q = t * 0.5307027145f + (-0.7265760135f); q = q * t + 0.7107068705f; q = q * t + (-0.142248368f); q = q * t + 0.127414796f; q = q * t;
    const float e = __builtin_amdgcn_exp2f((v * v) * (-0.72134752044f));
    const float m = v * (q * e);
    return v < 0.f ? m : v - m;
}

struct EpiSwiGLU {
    static constexpr bool PERM = true;
    bf16_t* H;
    __device__ __forceinline__ void operator()(const Acc& acc, const Unit& u, int wr, int wc, int fr, int fq) const {
        const int row0 = u.pm * BM + wr * 64 + fr, col0 = u.pn * 128 + wc * 32 + 8 * fq;
#pragma unroll
        for (int ai = 0; ai < 2; ++ai)
#pragma unroll
            for (int m = 0; m < 4; ++m) {
                float h[8];
#pragma unroll
                for (int n = 0; n < 2; ++n)
#pragma unroll
                    for (int j = 0; j < 4; ++j) h[4 * n + j] = silu_f(acc[ai][0][m][n][j]) * acc[ai][1][m][n][j];
                u32x4 w; w.x = cvt_pk_bf16(h[0], h[1]); w.y = cvt_pk_bf16(h[2], h[3]); w.z = cvt_pk_bf16(h[4], h[5]); w.w = cvt_pk_bf16(h[6], h[7]);
                *(u32x4*)(H + (size_t)(row0 + ai * HALF + m * 16) * DFF + col0) = w;
            }
    }
};
struct EpiRes {
    static constexpr bool PERM = false;
    const float* res; const bf16_t* resb; float* out; float scale;
    __device__ __forceinline__ void operator()(const Acc& acc, const Unit& u, int wr, int wc, int fr, int fq) const {
        const int row0 = u.pm * BM + wr * 64 + fr, col0 = u.pn * BM + wc * 32 + 4 * fq;
#pragma unroll
        for (int ai = 0; ai < 2; ++ai)
#pragma unroll
            for (int m = 0; m < 4; ++m) { const size_t ro = (size_t)(row0 + ai * HALF + m * 16) * DM + col0;
#pragma unroll
                for (int bj = 0; bj < 2; ++bj)
#pragma unroll
                    for (int n = 0; n < 2; ++n) { f32x4 r;
                        if (res) r = *(const f32x4*)(res + ro + bj * HALF + n * 16);
                        else { const u32x2 w = *(const u32x2*)(resb + ro + bj * HALF + n * 16); r = (f32x4){bf_lo(w.x), bf_hi(w.x), bf_lo(w.y), bf_hi(w.y)}; }
                        *(f32x4*)(out + ro + bj * HALF + n * 16) = r * ALPHA + acc[ai][bj][m][n] * scale; } }
    }
};
struct EpiPE {
    static constexpr bool PERM = false;
    float* pe;
    __device__ __forceinline__ void operator()(const Acc& acc, const Unit& u, int wr, int wc, int fr, int fq) const {
        const int row0 = u.pm * BM + wr * 64 + fr, col0 = u.pn * BM + wc * 32 + 4 * fq;
#pragma unroll
        for (int ai = 0; ai < 2; ++ai)
#pragma unroll
            for (int m = 0; m < 4; ++m) { const size_t ro = (size_t)(row0 + ai * HALF + m * 16) * DM + col0;
#pragma unroll
                for (int bj = 0; bj < 2; ++bj)
#pragma unroll
                    for (int n = 0; n < 2; ++n) *(f32x4*)(pe + ro + bj * HALF + n * 16) = acc[ai][bj][m][n]; }
    }
};
struct EpiGate {
    static constexpr bool PERM = false;
    float* X; const float* pe; const bf16_t* xb;
    __device__ __forceinline__ void operator()(const Acc& acc, const Unit& u, int wr, int wc, int fr, int fq) const {
        const int row0 = u.pm * BM + wr * 64 + fr, col0 = u.pn * BM + wc * 32 + 4 * fq;
#pragma unroll
        for (int ai = 0; ai < 2; ++ai)
#pragma unroll
            for (int m = 0; m < 4; ++m) { const size_t ro = (size_t)(row0 + ai * HALF + m * 16) * DM + col0;
#pragma unroll
                for (int bj = 0; bj < 2; ++bj)
#pragma unroll
                    for (int n = 0; n < 2; ++n) { const u32x2 w = *(const u32x2*)(xb + ro + bj * HALF + n * 16); const f32x4 r = (f32x4){bf_lo(w.x), bf_hi(w.x), bf_lo(w.y), bf_hi(w.y)}; const f32x4 pv = *(const f32x4*)(pe + ro + bj * HALF + n * 16);
                        f32x4 o;
#pragma unroll
                        for (int j = 0; j < 4; ++j) o[j] = r[j] * ALPHA + pv[j] * __builtin_amdgcn_rcpf(1.0f + __expf(-acc[ai][bj][m][n][j]));
                        *(f32x4*)(X + ro + bj * HALF + n * 16) = o; } }
    }
};
struct EpiMixIn {
    static constexpr bool PERM = true;
    bf16_t* Hm; const f32x2* cs; const float* loglb;
    __device__ __forceinline__ void operator()(const Acc& acc, const Unit& u, int wr, int wc, int fr, int fq) const {
        const int row0 = u.pm * BM + wr * 64 + fr;
        const int pn = u.pn;
        const int mode = (pn == 6 || pn == 7) ? 1 : (pn == 8 || pn == 9) ? 2 : (pn >= 14 && pn <= 17) ? 3 : (pn == 20 || pn == 21) ? 4 : 0;
#pragma unroll
        for (int ai = 0; ai < 2; ++ai)
#pragma unroll
            for (int m = 0; m < 4; ++m) {
                const int row = row0 + ai * HALF + m * 16;
#pragma unroll
                for (int bj = 0; bj < 2; ++bj) {
                    const int col = pn * BM + bj * HALF + wc * 32 + 8 * fq;
                    float v[8];
#pragma unroll
                    for (int n = 0; n < 2; ++n)
#pragma unroll
                        for (int j = 0; j < 4; ++j) v[4 * n + j] = acc[ai][bj][m][n][j];
                    if (mode == 1 || mode == 2) {
                        const int i0 = (col & 127) >> 1;
                        const f32x4 c01 = *(const f32x4*)(cs + (size_t)row * 64 + i0), c23 = *(const f32x4*)(cs + (size_t)row * 64 + i0 + 2);
                        const float sc = (mode == 2) ? 0.08838834764831845f : 1.0f;
                        const float cc[4] = {c01[0], c01[2], c23[0], c23[2]}, ss[4] = {c01[1], c01[3], c23[1], c23[3]};
#pragma unroll
                        for (int q = 0; q < 4; ++q) { const float x1 = v[2 * q], x2 = v[2 * q + 1]; v[2 * q] = (x1 * cc[q] - x2 * ss[q]) * sc; v[2 * q + 1] = (x1 * ss[q] + x2 * cc[q]) * sc; }
                    } else if (mode == 3) {
#pragma unroll
                        for (int q = 0; q < 8; ++q) v[q] = gelu_f(v[q]);
                    } else if (mode == 4) {
                        const int k0 = col - 5120;
                        const f32x4 l0 = *(const f32x4*)(loglb + k0), l1 = *(const f32x4*)(loglb + k0 + 4);
#pragma unroll
                        for (int q = 0; q < 8; ++q) { const float z = v[q], llb = q < 4 ? l0[q] : l1[q - 4];
                            const float az = fabsf(z), sp = __logf(1.0f + __expf(-az));
                            const float lsp = fminf(z, 0.f) - sp, lsn = fminf(-z, 0.f) - sp;
                            const float a = lsp, b = llb + lsn, mx = fmaxf(a, b), mn = fminf(a, b);
                            v[q] = mx + __logf(1.0f + __expf(mn - mx)); }
                    }
                    u32x4 w; w.x = cvt_pk_bf16(v[0], v[1]); w.y = cvt_pk_bf16(v[2], v[3]); w.z = cvt_pk_bf16(v[4], v[5]); w.w = cvt_pk_bf16(v[6], v[7]);
                    *(u32x4*)(Hm + (size_t)row * INC + col) = w;
                }
            }
    }
};

__device__ void conv_wT(const float* __restrict__ src, bf16_t* __restrict__ dst, int K, int N, int swiglu, LAS unsigned char* lds) {
    const int tid = opaque_tid(), bid = opaque_bid(), tilesN = N / 64, tilesK = K / 64, total = tilesN * tilesK;
    LAS bf16_t* t16 = (LAS bf16_t*)lds;
    for (int tile = bid; tile < total; tile += gridDim.x) {
        const int tn = tile % tilesN, tk = tile / tilesN;
        const int r = tid >> 4, c4 = (tid & 15) * 4;
#pragma unroll
        for (int p = 0; p < 2; ++p) {
            const f32x4 v = *(const f32x4*)(src + (size_t)(tk * 64 + r + 32 * p) * N + tn * 64 + c4);
#pragma unroll
            for (int j = 0; j < 4; ++j) t16[(c4 + j) * 72 + r + 32 * p] = (bf16_t)(cvt_pk_bf16(v[j], 0.f) & 0xffffu);
        }
        __syncthreads();
        const int n = tid >> 3, k8 = (tid & 7) * 8;
        const u32x4 w = *(const LAS u32x4*)(lds + n * 144 + k8 * 2);
        int nsrc = tn * 64 + n, ndst = nsrc;
        if (swiglu) { const int bj = nsrc >= DFF ? 1 : 0, hid = nsrc - DFF * bj; ndst = 256 * (hid >> 7) + 128 * bj + (hid & 127); }
        *(u32x4*)(dst + (size_t)ndst * K + tk * 64 + k8) = w;
        __syncthreads();
    }
}
__device__ void conv_flat(const float* __restrict__ src, bf16_t* __restrict__ dst, size_t n) {
    const size_t stride = (size_t)gridDim.x * 512 * 8;
    for (size_t i = ((size_t)opaque_bid() * 512 + opaque_tid()) * 8; i < n; i += stride) {
        const f32x4 a = *(const f32x4*)(src + i), b = *(const f32x4*)(src + i + 4);
        u32x4 w; w.x = cvt_pk_bf16(a[0], a[1]); w.y = cvt_pk_bf16(a[2], a[3]); w.z = cvt_pk_bf16(b[0], b[1]); w.w = cvt_pk_bf16(b[2], b[3]);
        *(u32x4*)(dst + i) = w;
    }
}
__device__ void prep_phase(const Params& P, LAS unsigned char* lds) {
    unsigned char* ws = P.ws;
    const int tid = opaque_tid(), bid = opaque_bid();
    float* tabf = (float*)(ws + WS_TAB); int* tabi = (int*)(ws + WS_TAB);
    if (bid == 0) {
        { const float l0 = P.lb_logits[tid], l1 = P.lb_logits[512 + tid]; const float s1 = 1.0f / (1.0f + expf(l0 - l1));
          tabf[TB_LOGLB + tid] = logf(1e-30f); tabf[TB_LOGLB + 512 + tid] = logf(fmaxf(s1, 1e-30f)); }
        for (int i2 = tid; i2 < 4 * 129; i2 += 512) { const int h = i2 / 129, n = i2 % 129; int bk;
            if (n < 16) bk = n; else { bk = 16 + (int)(logf((float)n / 16.0f) / 2.0794415416798357f * 16.0f); bk = bk > 31 ? 31 : bk; }
            tabf[TB_LUT + h * 132 + n] = P.rel_bias[bk * 4 + h] * LOG2E; }
        if (tid < DEPTH) { float s1 = 0.f, s2 = 0.f; const float* dl = P.dlam + tid * 256;
            for (int j = 0; j < 64; ++j) { s1 += dl[j] * dl[64 + j]; s2 += dl[128 + j] * dl[192 + j]; }
            const float lam_init = 0.8f - 0.6f * expf(-0.3f * (float)tid);
            tabf[TB_LAM + tid] = expf(s1) - expf(s2) + lam_init; }
        if (tid < 2) ((unsigned*)tabi)[TB_Q + tid] = 0u;
    }
    { f32x2* cs = (f32x2*)(ws + WS_CS);
      for (size_t i = (size_t)bid * 512 + tid; i < (size_t)MTOK * 64; i += (size_t)gridDim.x * 512) {
          const int tok = (int)(i >> 6), fi = (int)(i & 63);
          const double ang = (double)P.pos[tok] * P.inv[fi];
          const double rev = ang * 0.15915494309189535; const float fr = (float)(rev - rint(rev));
          cs[i] = (f32x2){__builtin_amdgcn_cosf(fr), __builtin_amdgcn_sinf(fr)};
      } }
    conv_flat(P.x, (bf16_t*)(ws + WS_XB), (size_t)MTOK * DM);
    conv_flat(P.p, (bf16_t*)(ws + WS_PB), (size_t)DEPTH * MTOK * PLE);
    for (int L = 0; L < DEPTH; ++L) {
        conv_wT(P.ffn1_in + (size_t)L * DM * 2 * DFF, (bf16_t*)(ws + WS_W1IN + L * SZ_W1IN), DM, 2 * DFF, 1, lds);
        conv_wT(P.ffn1_out + (size_t)L * DFF * DM, (bf16_t*)(ws + WS_W1OUT + L * SZ_W1OUT), DFF, DM, 0, lds);
        conv_wT(P.mix_in + (size_t)L * DM * INC, (bf16_t*)(ws + WS_WMI + L * SZ_WMI), DM, INC, 0, lds);
        conv_wT(P.mix_out + (size_t)L * DM * DM, (bf16_t*)(ws + WS_WMO + L * SZ_WMO), DM, DM, 0, lds);
        conv_wT(P.ffn2_in + (size_t)L * DM * 2 * DFF, (bf16_t*)(ws + WS_W2IN + L * SZ_W1IN), DM, 2 * DFF, 1, lds);
        conv_wT(P.ffn2_out + (size_t)L * DFF * DM, (bf16_t*)(ws + WS_W2OUT + L * SZ_W1OUT), DFF, DM, 0, lds);
        conv_wT(P.ple_gate + (size_t)L * DM * DM, (bf16_t*)(ws + WS_WG + L * SZ_WG), DM, DM, 0, lds);
        conv_wT(P.ple_proj + (size_t)L * PLE * DM, (bf16_t*)(ws + WS_WE + L * SZ_WE), PLE, DM, 0, lds);
    }
}

__device__ void ln_phase(float* X, const float* __restrict__ g, const float* __restrict__ b, bf16_t* Xb, bool write_x) {
    const int tid = opaque_tid(); const int lane = tid & 63, gw = opaque_bid() * 8 + (tid >> 6), nw = gridDim.x * 8;
    for (int row = gw; row + nw < MTOK; row += 2 * nw) {
        float* xr0 = X + (size_t)row * DM; float* xr1 = X + (size_t)(row + nw) * DM;
        bf16_t* xb0 = Xb + (size_t)row * DM; bf16_t* xb1 = Xb + (size_t)(row + nw) * DM;
        f32x4 v0[8], v1[8]; float s0 = 0.f, s1 = 0.f;
#pragma unroll
        for (int i = 0; i < 8; ++i) { v0[i] = *(const f32x4*)(xr0 + (i * 64 + lane) * 4); v1[i] = *(const f32x4*)(xr1 + (i * 64 + lane) * 4); }
#pragma unroll
        for (int i = 0; i < 8; ++i) { s0 += v0[i][0] + v0[i][1] + v0[i][2] + v0[i][3]; s1 += v1[i][0] + v1[i][1] + v1[i][2] + v1[i][3]; }
#pragma unroll
        for (int o = 32; o >= 1; o >>= 1) { s0 += shx(s0, o, lane); s1 += shx(s1, o, lane); }
        const float mu0 = s0 * (1.0f / DM), mu1 = s1 * (1.0f / DM); float q0 = 0.f, q1 = 0.f;
#pragma unroll
        for (int i = 0; i < 8; ++i)
#pragma unroll
            for (int j = 0; j < 4; ++j) { const float d0 = v0[i][j] - mu0, d1 = v1[i][j] - mu1; q0 += d0 * d0; q1 += d1 * d1; }
#pragma unroll
        for (int o = 32; o >= 1; o >>= 1) { q0 += shx(q0, o, lane); q1 += shx(q1, o, lane); }
        const float rs0 = rsqrtf(q0 * (1.0f / DM) + 1e-5f), rs1 = rsqrtf(q1 * (1.0f / DM) + 1e-5f);
#pragma unroll
        for (int i = 0; i < 8; ++i) { const int c = (i * 64 + lane) * 4; const f32x4 gg = *(const f32x4*)(g + c), bb = *(const f32x4*)(b + c); f32x4 o0, o1;
#pragma unroll
            for (int j = 0; j < 4; ++j) { o0[j] = (v0[i][j] - mu0) * rs0 * gg[j] + bb[j]; o1[j] = (v1[i][j] - mu1) * rs1 * gg[j] + bb[j]; }
            if (write_x) { *(f32x4*)(xr0 + c) = o0; *(f32x4*)(xr1 + c) = o1; }
            u32x2 w; w.x = cvt_pk_bf16(o0[0], o0[1]); w.y = cvt_pk_bf16(o0[2], o0[3]); *(u32x2*)(xb0 + c) = w;
            u32x2 w1; w1.x = cvt_pk_bf16(o1[0], o1[1]); w1.y = cvt_pk_bf16(o1[2], o1[3]); *(u32x2*)(xb1 + c) = w1; }
    }
}

__device__ void attn_unit(const Params& P, int layer, int b, int h, int qblk, LAS unsigned char* lds) {
    const int tid = opaque_tid(), wid = __builtin_amdgcn_readfirstlane(tid >> 6), lane_ = tid & 63, lane = lane_, l31 = lane & 31, hh = lane >> 5;
    const int c = wid & 1, rb = wid >> 1;
    const bf16_t* Hm = (const bf16_t*)(P.ws + WS_H);
    const float* tabf = (const float*)(P.ws + WS_TAB); const int* tabi = (const int*)(P.ws + WS_TAB);
    LAS float* lut = (LAS float*)(lds + 66048); LAS int* posk = (LAS int*)(lds + 65536); LAS int* pkmx = (LAS int*)(lds + 66576);
    const int q0w = qblk * 128 + rb * 32, qrow = q0w + l31;
    const size_t tok = (size_t)b * SEQ + qrow;
    bf16x8 qf[4];
    { const bf16_t* qp = Hm + tok * INC + h * 128 + c * 64 + 8 * hh;
#pragma unroll
      for (int ks = 0; ks < 4; ++ks) qf[ks] = *(const bf16x8*)(qp + 16 * ks); }
    const int pq = P.pos[b * SEQ + qrow];
    int pqmin = pq;
#pragma unroll
    for (int o = 16; o >= 1; o >>= 1) { const int t = shxi(pqmin, o, lane); pqmin = t < pqmin ? t : pqmin; }
    pqmin = __builtin_amdgcn_readfirstlane(pqmin);
    f32x16 O[4];
#pragma unroll
    for (int d = 0; d < 4; ++d) O[d] = zero16();
    float mrun = -1e30f, lrun = 0.f;
    const int nt = 2 * qblk + 2;
    const float sc2 = 0.125f * LOG2E;
    const int srow = (tid >> 4), sch = tid & 15;
    const bf16_t* gK = Hm + ((size_t)b * SEQ) * INC + 512 + h * 128 + sch * 8;
    const bf16_t* gV = gK + 512;
    u32x4 st[4];
    __syncthreads();
    if (tid < 129) lut[tid] = tabf[TB_LUT + h * 132 + tid];
#define ATT_LOAD(kt) do { const size_t r0 = (size_t)((kt) * 64 + srow) * INC; st[0] = *(const u32x4*)(gK + r0); st[1] = *(const u32x4*)(gK + r0 + (size_t)32 * INC); \
        st[2] = *(const u32x4*)(gV + r0); st[3] = *(const u32x4*)(gV + r0 + (size_t)32 * INC); } while (0)
#define ATT_STORE(buf, kt) do { LAS unsigned char* kb = lds + (buf) * 32768; *(LAS u32x4*)(kb + off_b(srow, sch)) = st[0]; *(LAS u32x4*)(kb + off_b(srow + 32, sch)) = st[1]; \
        *(LAS u32x4*)(kb + 16384 + off_b(srow, sch)) = st[2]; *(LAS u32x4*)(kb + 16384 + off_b(srow + 32, sch)) = st[3]; \
        if (tid < 64) { int pv_ = P.pos[b * SEQ + (kt) * 64 + tid]; posk[(buf) * 64 + tid] = pv_; _Pragma("unroll") for (int o_ = 32; o_ >= 1; o_ >>= 1) { const int t_ = shxi(pv_, o_, lane_); pv_ = t_ > pv_ ? t_ : pv_; } if (tid == 0) pkmx[buf] = pv_; } } while (0)
    ATT_LOAD(0); ATT_STORE(0, 0);
    __syncthreads();
    for (int kt = 0; kt < nt; ++kt) {
        const int buf = kt & 1, k0 = kt * 64;
        if (kt + 1 < nt) ATT_LOAD(kt + 1);
        if (k0 <= q0w + 31) {
            int lane = lane_; asm volatile("" : "+v"(lane)); const int l31 = lane & 31, hh = lane >> 5;
            LAS const unsigned char* Kimg = lds + buf * 32768; LAS const unsigned char* Vimg = Kimg + 16384;
            f32x16 S[2];
#pragma unroll
            for (int s2 = 0; s2 < 2; ++s2) { S[s2] = zero16();
#pragma unroll
                for (int ks = 0; ks < 4; ++ks) { const bf16x8 a = *(const LAS bf16x8*)(Kimg + off_b(32 * s2 + l31, 8 * c + 2 * ks + hh)); S[s2] = mfma32(a, qf[ks], S[s2]); } }
            const bool far = (pqmin - pkmx[buf]) >= 128;
            const bool needmask = (k0 + 63 > q0w);
            float mnew, rsum = 0.f;
            if (far && !needmask) {
                const float cb = lut[128];
                float mx = S[0][0];
#pragma unroll
                for (int s2 = 0; s2 < 2; ++s2)
#pragma unroll
                    for (int i = 0; i < 16; ++i) mx = fmaxf(mx, S[s2][i]);
                mx = fmaxf(mx, shx(mx, 32, lane));
                mnew = fmaxf(mrun, mx * sc2 + cb);
                const float off = cb - mnew;
#pragma unroll
                for (int s2 = 0; s2 < 2; ++s2)
#pragma unroll
                    for (int i = 0; i < 16; ++i) { const float pe = __builtin_amdgcn_exp2f(S[s2][i] * sc2 + off); S[s2][i] = pe; rsum += pe; }
            } else {
                if (far) { const float cb = lut[128];
#pragma unroll
                    for (int s2 = 0; s2 < 2; ++s2)
#pragma unroll
                        for (int i = 0; i < 16; ++i) S[s2][i] = S[s2][i] * sc2 + cb;
                } else {
#pragma unroll
                    for (int s2 = 0; s2 < 2; ++s2)
#pragma unroll
                        for (int i = 0; i < 16; ++i) { const int kk = 32 * s2 + 8 * (i >> 2) + 4 * hh + (i & 3); int rel = pq - posk[buf * 64 + kk]; rel = rel < 0 ? 0 : (rel > 128 ? 128 : rel);
                            S[s2][i] = S[s2][i] * sc2 + lut[rel]; }
                }
                if (needmask) {
#pragma unroll
                    for (int s2 = 0; s2 < 2; ++s2)
#pragma unroll
                        for (int i = 0; i < 16; ++i) { const int kk = k0 + 32 * s2 + 8 * (i >> 2) + 4 * hh + (i & 3); if (kk > qrow) S[s2][i] = -1e30f; }
                }
                float mx = S[0][0];
#pragma unroll
                for (int s2 = 0; s2 < 2; ++s2)
#pragma unroll
                    for (int i = 0; i < 16; ++i) mx = fmaxf(mx, S[s2][i]);
                mx = fmaxf(mx, shx(mx, 32, lane));
                mnew = fmaxf(mrun, mx);
#pragma unroll
                for (int s2 = 0; s2 < 2; ++s2)
#pragma unroll
                    for (int i = 0; i < 16; ++i) { const float pe = __builtin_amdgcn_exp2f(S[s2][i] - mnew); S[s2][i] = pe; rsum += pe; }
            }
            const float alpha = __builtin_amdgcn_exp2f(mrun - mnew);
            rsum += shx(rsum, 32, lane);
            lrun = lrun * alpha + rsum; mrun = mnew;
            if (__builtin_amdgcn_ballot_w64(alpha != 1.0f) != 0ull) {
#pragma unroll
                for (int d = 0; d < 4; ++d)
#pragma unroll
                    for (int i = 0; i < 16; ++i) O[d][i] *= alpha;
            }
#pragma unroll
            for (int s2 = 0; s2 < 2; ++s2)
#pragma unroll
                for (int sp = 0; sp < 2; ++sp) {
                    const bf16x8 pf = pack8(S[s2][8 * sp + 0], S[s2][8 * sp + 1], S[s2][8 * sp + 2], S[s2][8 * sp + 3], S[s2][8 * sp + 4], S[s2][8 * sp + 5], S[s2][8 * sp + 6], S[s2][8 * sp + 7]);
                    const unsigned rbase = 32 * s2 + 16 * sp + 4 * hh;
#pragma unroll
                    for (int d = 0; d < 4; ++d) { const bf16x8 va = cat8(tr_read(Vimg, lane, rbase, d), tr_read(Vimg, lane, rbase + 8, d)); O[d] = mfma32(va, pf, O[d]); }
                }
        }
        if (kt + 1 < nt) ATT_STORE(buf ^ 1, kt + 1);
        __syncthreads();
    }
#undef ATT_LOAD
#undef ATT_STORE
    LAS float* X = (LAS float*)lds;
    const float inv_l = 1.0f / lrun;
    if (c == 1) {
#pragma unroll
        for (int d = 0; d < 4; ++d)
#pragma unroll
            for (int i = 0; i < 16; ++i) X[(rb * 64 + d * 16 + i) * 64 + lane] = O[d][i] * inv_l;
    }
    __syncthreads();
    if (c == 0) {
        const float lam = tabf[TB_LAM + layer];
        const float lam_init = 0.8f - 0.6f * __expf(-0.3f * (float)layer);
        float ss = 0.f;
#pragma unroll
        for (int d = 0; d < 4; ++d)
#pragma unroll
            for (int i = 0; i < 16; ++i) { const float v = O[d][i] * inv_l - lam * X[(rb * 64 + d * 16 + i) * 64 + lane]; O[d][i] = v; ss += v * v; }
        ss += shx(ss, 32, lane);
        const float rs = rsqrtf(ss * (1.0f / 128.0f) + 1e-5f) * (1.0f - lam_init);
        bf16_t* Ob = (bf16_t*)(P.ws + WS_XB) + tok * DM + h * 128;
        const float* ng = P.dnorm_g + layer * 128;
#pragma unroll
        for (int d = 0; d < 4; ++d)
#pragma unroll
            for (int g4 = 0; g4 < 4; ++g4) { const int e0 = 32 * d + 8 * g4 + 4 * hh; const f32x4 gg = *(const f32x4*)(ng + e0);
                u32x2 w; w.x = cvt_pk_bf16(O[d][4 * g4] * rs * gg[0], O[d][4 * g4 + 1] * rs * gg[1]); w.y = cvt_pk_bf16(O[d][4 * g4 + 2] * rs * gg[2], O[d][4 * g4 + 3] * rs * gg[3]);
                *(u32x2*)(Ob + e0) = w; }
    }
    __syncthreads();
}

__device__ void gla_stream(const Params& P, int layer, int type, int b, int h, int sl, LAS unsigned char* lds) {
    const int tid = opaque_tid(), wid = __builtin_amdgcn_readfirstlane(tid >> 6), lane = tid & 63;
    const bf16_t* Hm = (const bf16_t*)(P.ws + WS_H);
    bf16_t* Ob = (bf16_t*)(P.ws + WS_XB);
    float* stat = (float*)(P.ws + WS_STAT);
    const int qcol = (type ? 4608 : 1536) + h * 128, kcol = (type ? 5120 : 2048) + h * 128, vcol = (type ? 5632 : 2560) + h * 128 + 32 * sl,
              ocol = (type ? 1536 : 512) + h * 128 + 32 * sl;
    const float gam = 1.0f - exp2f(-5.0f - (float)h);
    LAS float* FF = (LAS float*)lds; LAS unsigned* QK = (LAS unsigned*)lds + 2048; LAS float* VF = FF + 4096; LAS float* OP = FF + 4608;
    const int e_l = tid & 15, kg = tid >> 4;
    const int stok = tid >> 5, sc4 = (tid & 31) * 4;
    const int vtok = (tid >> 4) & 15, vc2 = (tid & 15) * 2;
    float S0[4] = {0.f, 0.f, 0.f, 0.f}, S1[4] = {0.f, 0.f, 0.f, 0.f};
    u32x2 pq2, pk2; unsigned pv1 = 0u;
    const bf16_t* gbase = Hm + ((size_t)b * SEQ + stok) * INC + sc4;
    const bf16_t* vbase = Hm + ((size_t)b * SEQ + vtok) * INC + vcol + vc2;
#define GLS_LOAD(bt) do { const bf16_t* gp = gbase + (size_t)(bt) * 16 * INC; pq2 = *(const u32x2*)(gp + qcol); pk2 = *(const u32x2*)(gp + kcol); \
        if (tid < 256) pv1 = *(const unsigned*)(vbase + (size_t)(bt) * 16 * INC); } while (0)
    GLS_LOAD(0);
    __syncthreads();
    for (int bt = 0; bt < 512; ++bt) {
        const size_t T0 = (size_t)b * SEQ + (size_t)bt * 16;
        { const int o = stok * 128 + sc4;
          if (type) { const float l0 = bf_lo(pk2.x), l1 = bf_hi(pk2.x), l2 = bf_lo(pk2.y), l3 = bf_hi(pk2.y);
              *(LAS f32x4*)(FF + o) = (f32x4){__expf(l0), __expf(l1), __expf(l2), __expf(l3)};
              const unsigned k01 = cvt_pk_bf16(1.0f - __expf(l0), 1.0f - __expf(l1)), k23 = cvt_pk_bf16(1.0f - __expf(l2), 1.0f - __expf(l3));
              *(LAS u32x4*)(QK + o) = (u32x4){(pq2.x & 0xffffu) | (k01 << 16), (pq2.x >> 16) | (k01 & 0xffff0000u), (pq2.y & 0xffffu) | (k23 << 16), (pq2.y >> 16) | (k23 & 0xffff0000u)}; }
          else {
              *(LAS u32x4*)(QK + o) = (u32x4){(pq2.x & 0xffffu) | (pk2.x << 16), (pq2.x >> 16) | (pk2.x & 0xffff0000u), (pq2.y & 0xffffu) | (pk2.y << 16), (pq2.y >> 16) | (pk2.y & 0xffff0000u)}; }
          if (tid < 256) { VF[vtok * 32 + vc2] = bf_lo(pv1); VF[vtok * 32 + vc2 + 1] = bf_hi(pv1); } }
        if (bt + 1 < 512) GLS_LOAD(bt + 1);
        __syncthreads();
        float accs[32];
#pragma unroll
        for (int tt = 0; tt < 16; ++tt) {
            const float v0 = VF[tt * 32 + e_l], v1 = VF[tt * 32 + 16 + e_l];
            f32x4 f4 = (f32x4){gam, gam, gam, gam}; if (type) f4 = *(const LAS f32x4*)(FF + tt * 128 + 4 * kg);
            const u32x4 qk = *(const LAS u32x4*)(QK + tt * 128 + 4 * kg);
            const unsigned qw[4] = {qk.x, qk.y, qk.z, qk.w};
            float a0 = 0.f, a1 = 0.f;
#pragma unroll
            for (int j = 0; j < 4; ++j) { const float q = bf_lo(qw[j]), c = bf_hi(qw[j]);
                S0[j] = f4[j] * S0[j] + c * v0; S1[j] = f4[j] * S1[j] + c * v1; a0 += q * S0[j]; a1 += q * S1[j]; }
            accs[2 * tt] = a0; accs[2 * tt + 1] = a1;
        }
        { const bool b0 = (lane & 16) != 0, b1 = (lane & 32) != 0;
          float r16[16];
#pragma unroll
          for (int i = 0; i < 16; ++i) r16[i] = swapadd16(accs[i], accs[16 + i]);
          float r8[8];
#pragma unroll
          for (int i = 0; i < 8; ++i) r8[i] = swapadd32(r16[i], r16[8 + i]);
          const int vb = (b0 ? 16 : 0) + (b1 ? 8 : 0);
#pragma unroll
          for (int i = 0; i < 8; ++i) { const int vi = vb + i; OP[((vi >> 1) * 8 + wid) * 32 + (vi & 1) * 16 + e_l] = r8[i]; } }
        __syncthreads();
        { const int tt = tid >> 5, e32 = tid & 31; const size_t tok = T0 + tt;
            float o = 0.f;
#pragma unroll
            for (int w = 0; w < 8; ++w) o += OP[(tt * 8 + w) * 32 + e32];
            Ob[tok * DM + ocol + e32] = (bf16_t)(cvt_pk_bf16(o, 0.f) & 0xffffu);
            float s1 = o, s2 = o * o;
#pragma unroll
            for (int of = 16; of >= 1; of >>= 1) { s1 += shx(s1, of, lane); s2 += shx(s2, of, lane); }
            if (e32 == 0) *(f32x4*)(stat + ((((size_t)type * MTOK + tok) * 4 + h) * 8 + 2 * sl) * 2) = (f32x4){s1, s2, 0.f, 0.f}; }
    }
#undef GLS_LOAD
    __syncthreads();
}

__device__ void gla_post_phase(const Params& P, int layer) {
    bf16_t* Ob = (bf16_t*)(P.ws + WS_XB); const bf16_t* Hm = (const bf16_t*)(P.ws + WS_H); const float* stat = (const float*)(P.ws + WS_STAT);
    const float* ng = P.hg_norm_g + layer * 512;
    const int tid = opaque_tid(); const int lane = tid & 63, gw = opaque_bid() * 8 + (tid >> 6), nw = gridDim.x * 8;
    const int hd = lane >> 4;
    for (int tok = gw; tok < MTOK; tok += nw) {
        { const float* sp = stat + (((size_t)tok) * 4 + hd) * 16; float s1 = 0.f, s2 = 0.f;
#pragma unroll
          for (int q = 0; q < 4; ++q) { const f32x4 a = *(const f32x4*)(sp + 4 * q); s1 += a[0] + a[2]; s2 += a[1] + a[3]; }
          const float mu = s1 * (1.0f / 128.0f), var = fmaxf(s2 * (1.0f / 128.0f) - mu * mu, 0.f), rs = rsqrtf(var + 1e-5f);
          u32x4* p = (u32x4*)(Ob + (size_t)tok * DM + 512 + lane * 8); const u32x4 w = *p; const u32x4 g = *(const u32x4*)(Hm + (size_t)tok * INC + 3072 + lane * 8);
          const unsigned ww[4] = {w.x, w.y, w.z, w.w}, gg[4] = {g.x, g.y, g.z, g.w}; unsigned oo[4];
#pragma unroll
          for (int j = 0; j < 4; ++j) oo[j] = cvt_pk_bf16((bf_lo(ww[j]) - mu) * rs * silu_f(bf_lo(gg[j])), (bf_hi(ww[j]) - mu) * rs * silu_f(bf_hi(gg[j])));
          *p = (u32x4){oo[0], oo[1], oo[2], oo[3]}; }
        { const float* sp = stat + (((size_t)MTOK + tok) * 4) * 16; float s2 = 0.f;
#pragma unroll
          for (int q = 0; q < 16; ++q) { const f32x4 a = *(const f32x4*)(sp + 4 * q); s2 += a[1] + a[3]; }
          const float rs = rsqrtf(s2 * (1.0f / 512.0f) + 1e-5f);
          u32x4* p = (u32x4*)(Ob + (size_t)tok * DM + 1536 + lane * 8); const u32x4 w = *p; const u32x4 g = *(const u32x4*)(Hm + (size_t)tok * INC + 6144 + lane * 8);
          const f32x4 n0 = *(const f32x4*)(ng + lane * 8), n1 = *(const f32x4*)(ng + lane * 8 + 4);
          const unsigned ww[4] = {w.x, w.y, w.z, w.w}, gg[4] = {g.x, g.y, g.z, g.w}; const float nn[8] = {n0[0], n0[1], n0[2], n0[3], n1[0], n1[1], n1[2], n1[3]}; unsigned oo[4];
#pragma unroll
          for (int j = 0; j < 4; ++j) oo[j] = cvt_pk_bf16(bf_lo(ww[j]) * rs * nn[2 * j] * silu_f(bf_lo(gg[j])), bf_hi(ww[j]) * rs * nn[2 * j + 1] * silu_f(bf_hi(gg[j])));
          *p = (u32x4){oo[0], oo[1], oo[2], oo[3]}; }
    }
}

__device__ void gmlp_unit(const Params& P, int layer, int b, int chunk, LAS unsigned char* lds) {
    constexpr unsigned VIMG = 0, WIMG = 32768, MU = 65536, RS = 66048;
    const int tid = opaque_tid(), wid = __builtin_amdgcn_readfirstlane(tid >> 6), lane = tid & 63, l31 = lane & 31, hh = lane >> 5;
    const bf16_t* Hm = (const bf16_t*)(P.ws + WS_H);
    bf16_t* Ob = (bf16_t*)(P.ws + WS_XB);
    const size_t T0 = (size_t)b * SEQ + chunk * 128;
    __syncthreads();
    for (int i = 0; i < 16; ++i) { const int t = wid * 16 + i; const u32x4 w = *(const u32x4*)(Hm + (T0 + t) * INC + 4096 + lane * 8);
        const float v[8] = {bf_lo(w.x), bf_hi(w.x), bf_lo(w.y), bf_hi(w.y), bf_lo(w.z), bf_hi(w.z), bf_lo(w.w), bf_hi(w.w)};
        float s = 0.f;
#pragma unroll
        for (int j = 0; j < 8; ++j) s += v[j];
#pragma unroll
        for (int o = 32; o >= 1; o >>= 1) s += shx(s, o, lane);
        const float mu = s * (1.0f / 512.0f); float q = 0.f;
#pragma unroll
        for (int j = 0; j < 8; ++j) { const float d = v[j] - mu; q += d * d; }
#pragma unroll
        for (int o = 32; o >= 1; o >>= 1) q += shx(q, o, lane);
        if (lane == 0) { ((LAS float*)(lds + MU))[t] = mu; ((LAS float*)(lds + RS))[t] = rsqrtf(q * (1.0f / 512.0f) + 1e-5f); } }
    __syncthreads();
    const int tb = wid & 3, ct0 = 2 * (wid >> 2);
    for (int g = 0; g < 4; ++g) {
        const float* lg = P.g_ln_g + layer * 512 + g * 128; const float* lb = P.g_ln_b + layer * 512 + g * 128;
        const float* Wg = P.g_ws + ((size_t)(layer * 4 + g)) * 128 * 128;
#pragma unroll
        for (int i = 0; i < 4; ++i) { const int n = tid + 512 * i, s = n >> 4, ch = n & 15;
            const u32x4 w = *(const u32x4*)(Hm + (T0 + s) * INC + 4096 + g * 128 + ch * 8);
            const float mu = ((LAS float*)(lds + MU))[s], rs = ((LAS float*)(lds + RS))[s];
            const f32x4 g0 = *(const f32x4*)(lg + ch * 8), g1 = *(const f32x4*)(lg + ch * 8 + 4), b0 = *(const f32x4*)(lb + ch * 8), b1 = *(const f32x4*)(lb + ch * 8 + 4);
            const float v[8] = {bf_lo(w.x), bf_hi(w.x), bf_lo(w.y), bf_hi(w.y), bf_lo(w.z), bf_hi(w.z), bf_lo(w.w), bf_hi(w.w)};
            float y[8];
#pragma unroll
            for (int j = 0; j < 8; ++j) y[j] = (v[j] - mu) * rs * (j < 4 ? g0[j] : g1[j - 4]) + (j < 4 ? b0[j] : b1[j - 4]);
            *(LAS bf16x8*)(lds + VIMG + off_b(s, ch)) = pack8(y[0], y[1], y[2], y[3], y[4], y[5], y[6], y[7]);
            const f32x4 w0 = *(const f32x4*)(Wg + s * 128 + ch * 8), w1 = *(const f32x4*)(Wg + s * 128 + ch * 8 + 4);
            float ww[8];
#pragma unroll
            for (int j = 0; j < 8; ++j) ww[j] = (ch * 8 + j <= s) ? (j < 4 ? w0[j] : w1[j - 4]) : 0.f;
            *(LAS bf16x8*)(lds + WIMG + off_b(s, ch)) = pack8(ww[0], ww[1], ww[2], ww[3], ww[4], ww[5], ww[6], ww[7]); }
        __syncthreads();
        f32x16 acc[2]; acc[0] = zero16(); acc[1] = zero16();
        for (int ks = 0; ks < 2 * (tb + 1); ++ks) {
            const bf16x8 bw = *(const LAS bf16x8*)(lds + WIMG + off_b(32 * tb + l31, 2 * ks + hh));
#pragma unroll
            for (int e = 0; e < 2; ++e) { const bf16x8 av = cat8(tr_read(lds + VIMG, lane, 16 * ks + 8 * hh, ct0 + e), tr_read(lds + VIMG, lane, 16 * ks + 8 * hh + 4, ct0 + e)); acc[e] = mfma32(av, bw, acc[e]); }
        }
        { const int t = 32 * tb + l31; const size_t tok = T0 + t; const float bs = P.g_bs[(layer * 4 + g) * 128 + t];
#pragma unroll
          for (int e = 0; e < 2; ++e)
#pragma unroll
              for (int g4 = 0; g4 < 4; ++g4) { const int c0 = 32 * (ct0 + e) + 8 * g4 + 4 * hh;
                  const u32x2 uw = *(const u32x2*)(Hm + tok * INC + 3584 + g * 128 + c0);
                  u32x2 w; w.x = cvt_pk_bf16(bf_lo(uw.x) * (acc[e][4 * g4] + bs), bf_hi(uw.x) * (acc[e][4 * g4 + 1] + bs)); w.y = cvt_pk_bf16(bf_lo(uw.y) * (acc[e][4 * g4 + 2] + bs), bf_hi(uw.y) * (acc[e][4 * g4 + 3] + bs));
                  *(u32x2*)(Ob + tok * DM + 1024 + g * 128 + c0) = w; } }
        __syncthreads();
    }
}

__device__ void mixer_phase(const Params& P, int layer, LAS unsigned char* lds) {
    unsigned* qc = (unsigned*)(P.ws + WS_TAB) + TB_Q + layer;
    LAS unsigned* slot = (LAS unsigned*)(lds + LDS_BYTES - 16);
    for (;;) {
        __syncthreads();
        if (threadIdx.x == 0) *slot = atomicAdd(qc, 1u);
        __syncthreads();
        const int item = (int)*slot;
        if (item >= 128 + 512 + 256) break;
        if (item < 128) { const int st = item >> 2; gla_stream(P, layer, 1 - (st >> 4), (st >> 2) & 3, st & 3, item & 3, lds); }
        else if (item < 640) { const int a = item - 128, bh = a >> 5, pr = a & 31;
            for (int u2 = 0; u2 < 2; ++u2) attn_unit(P, layer, bh >> 2, bh & 3, u2 ? pr : 63 - pr, lds); }
        else { const int c = item - 640; gmlp_unit(P, layer, c >> 6, c & 63, lds); }
    }
}

__device__ __forceinline__ void grid_barrier(unsigned* ctr, unsigned nbar) {
    asm volatile("s_waitcnt vmcnt(0)" ::: "memory");
    __syncthreads();
    if (threadIdx.x == 0) {
        __builtin_amdgcn_fence(__ATOMIC_RELEASE, "agent");
        asm volatile("s_waitcnt vmcnt(0)" ::: "memory");
        const unsigned gsz = gridDim.x >> 3;
        unsigned* gc = ctr + (blockIdx.x & 7u) * 32u; unsigned* glob = ctr + 8u * 32u;
        const unsigned old = __hip_atomic_fetch_add(gc, 1u, __ATOMIC_RELAXED, __HIP_MEMORY_SCOPE_AGENT);
        if (old + 1u == nbar * gsz) __hip_atomic_fetch_add(glob, 1u, __ATOMIC_RELAXED, __HIP_MEMORY_SCOPE_AGENT);
        while (__hip_atomic_load(glob, __ATOMIC_RELAXED, __HIP_MEMORY_SCOPE_AGENT) < nbar * 8u) __builtin_amdgcn_s_sleep(1);
        __builtin_amdgcn_fence(__ATOMIC_ACQUIRE, "agent");
        asm volatile("s_waitcnt vmcnt(0)" ::: "memory");
    }
    __syncthreads();
}

template <class Epi> __device__ __forceinline__ void run_gemm(LAS unsigned char* lds, const bf16_t* A, const bf16_t* Bt, int N, int K, const Epi& E) {
    pg8::Gemm g; g.A = A; g.Bt = Bt; g.M = MTOK; g.N = N; g.K = K;
    pg8::StaticOrder S; S.init(MTOK, N, (int)gridDim.x, opaque_bid());
    pg8::gemm_phase<Epi>(lds, g, S, E);
}

typedef const __attribute__((address_space(4))) Params* KParamsPtr;
__global__ __launch_bounds__(512, 2) void fwd_megakernel(const Params Pin) {
    extern __shared__ __attribute__((aligned(16))) unsigned char shm[];
    LAS unsigned char* lds = (LAS unsigned char*)shm;
    cg::grid_group grid = cg::this_grid();
    const KParamsPtr kp = (KParamsPtr)__builtin_amdgcn_kernarg_segment_ptr();
    unsigned nbar = 0u;
    for (int ph = Pin.ph_lo; ph < Pin.ph_hi; ++ph) {
        if (Pin.ph_lo < 0) grid.sync();
        if (ph > Pin.ph_lo) { nbar += 1u; grid_barrier((unsigned*)(Pin.ws + WS_TAB) + 8000, nbar); }
        KParamsPtr kq = kp; asm volatile("" : "+s"(kq));
        const Params& P = *(const Params*)kq;
        unsigned char* ws = P.ws;
        float* X = P.out;
        bf16_t* Xb = (bf16_t*)(ws + WS_XB);
        bf16_t* Hb = (bf16_t*)(ws + WS_H);
        if (ph == 0) { prep_phase(P, lds); continue; }
        const int L = (ph - 1) / 13, s = (ph - 1) % 13;
        { const int lnk = (s == 2) ? 0 : (s == 7) ? 1 : (s == 10) ? 2 : (s == 12) ? 3 : -1;
          if (lnk >= 0) { ln_phase(X, P.ln_g + (L * 4 + lnk) * DM, P.ln_b + (L * 4 + lnk) * DM, Xb, lnk == 0 || (lnk == 3 && L == DEPTH - 1)); continue; } }
        switch (s) {
        case 0: { EpiSwiGLU E; E.H = Hb; run_gemm(lds, Xb, (const bf16_t*)(ws + WS_W1IN + L * SZ_W1IN), 2 * DFF, DM, E); } break;
        case 1: { EpiRes E; E.res = (L == 0) ? P.x : nullptr; E.resb = Xb; E.out = X; E.scale = 0.5f; run_gemm(lds, Hb, (const bf16_t*)(ws + WS_W1OUT + L * SZ_W1OUT), DM, DFF, E); } break;
        case 3: { EpiMixIn E; E.Hm = Hb; E.cs = (const f32x2*)(ws + WS_CS); E.loglb = (const float*)(ws + WS_TAB) + TB_LOGLB + L * 512;
                  run_gemm(lds, Xb, (const bf16_t*)(ws + WS_WMI + L * SZ_WMI), INC, DM, E); } break;
        case 4: mixer_phase(P, L, lds); break;
        case 5: gla_post_phase(P, L); break;
        case 6: { EpiRes E; E.res = X; E.resb = nullptr; E.out = X; E.scale = 1.0f; run_gemm(lds, Xb, (const bf16_t*)(ws + WS_WMO + L * SZ_WMO), DM, DM, E); } break;
        case 8: { EpiSwiGLU E; E.H = Hb; run_gemm(lds, Xb, (const bf16_t*)(ws + WS_W2IN + L * SZ_W1IN), 2 * DFF, DM, E); } break;
        case 9: { EpiRes E; E.res = nullptr; E.resb = Xb; E.out = X; E.scale = 0.5f; run_gemm(lds, Hb, (const bf16_t*)(ws + WS_W2OUT + L * SZ_W1OUT), DM, DFF, E); } break;
        case 11: { EpiPE E1; E1.pe = (float*)(ws + WS_H); run_gemm(lds, (const bf16_t*)(ws + WS_PB) + (size_t)L * MTOK * PLE, (const bf16_t*)(ws + WS_WE + L * SZ_WE), DM, PLE, E1);
                   EpiGate E2; E2.X = X; E2.pe = (const float*)(ws + WS_H); E2.xb = Xb; run_gemm(lds, Xb, (const bf16_t*)(ws + WS_WG + L * SZ_WG), DM, DM, E2); } break;
        }
    }
}

extern "C" void kernel_launch(void* const* d_in, const int* in_sizes, int n_in, void* d_out, int out_size, void* d_ws, size_t ws_size, hipStream_t stream) {
    static int grid = 0;
    if (grid == 0) {
        if (n_in != 22 || out_size != MTOK * DM || ws_size < WS_END) { fprintf(stderr, "kernel_launch: unexpected shapes (n_in %d out %d ws %zu need %zu)\n", n_in, out_size, ws_size, (size_t)WS_END); grid = -1; return; }
        int dev = 0, cus = 0, per_cu = 0;
        (void)hipGetDevice(&dev); (void)hipDeviceGetAttribute(&cus, hipDeviceAttributeMultiprocessorCount, dev);
        if (hipFuncSetAttribute((const void*)fwd_megakernel, hipFuncAttributeMaxDynamicSharedMemorySize, LDS_BYTES) != hipSuccess) { fprintf(stderr, "kernel_launch: hipFuncSetAttribute failed\n"); grid = -1; return; }
        if (hipOccupancyMaxActiveBlocksPerMultiprocessor(&per_cu, (const void*)fwd_megakernel, 512, LDS_BYTES) != hipSuccess || per_cu < 1) { fprintf(stderr, "kernel_launch: occupancy query says %d\n", per_cu); per_cu = 1; }
        (void)hipGetLastError();
        grid = cus & ~7;
    }
    if (grid < 0) return;
    Params p; memset(&p, 0, sizeof(p));
    p.x = (const float*)d_in[0]; p.p = (const float*)d_in[1]; p.pos = (const int*)d_in[2];
    p.ffn1_in = (const float*)d_in[3]; p.ffn1_out = (const float*)d_in[4]; p.mix_in = (const float*)d_in[5]; p.mix_out = (const float*)d_in[6];
    p.rel_bias = (const float*)d_in[7]; p.dlam = (const float*)d_in[8]; p.dnorm_g = (const float*)d_in[9]; p.g_ln_g = (const float*)d_in[10]; p.g_ln_b = (const float*)d_in[11];
    p.g_ws = (const float*)d_in[12]; p.g_bs = (const float*)d_in[13]; p.lb_logits = (const float*)d_in[14]; p.hg_norm_g = (const float*)d_in[15];
    p.ffn2_in = (const float*)d_in[16]; p.ffn2_out = (const float*)d_in[17]; p.ple_gate = (const float*)d_in[18]; p.ple_proj = (const float*)d_in[19];
    p.ln_g = (const float*)d_in[20]; p.ln_b = (const float*)d_in[21];
    p.out = (float*)d_out; p.ws = (unsigned char*)d_ws;
    p.ph_lo = 0; p.ph_hi = NPH;
    for (int i = 0; i < 64; ++i) p.inv[i] = pow(10000.0, -(double)i / 63.0);
    (void)hipMemsetAsync((unsigned char*)d_ws + WS_TAB + 32000, 0, 9 * 128, stream);
    void* args[] = {&p};
    hipError_t e = hipLaunchCooperativeKernel((const void*)fwd_megakernel, dim3(grid), dim3(512), args, LDS_BYTES, stream);
    if (e != hipSuccess) fprintf(stderr, "kernel_launch: cooperative launch failed: %s (grid %d)\n", hipGetErrorString(e), grid);
}
```

```cpp
#include <hip/hip_runtime.h>
#include <hip/hip_cooperative_groups.h>
#include <math.h>
#include <stdio.h>
#include <string.h>
namespace cg = cooperative_groups;

#define LAS __attribute__((address_space(3)))
typedef unsigned short bf16_t;
typedef short bf16x8 __attribute__((ext_vector_type(8)));
typedef short s16x4 __attribute__((ext_vector_type(4)));
typedef float f32x2 __attribute__((ext_vector_type(2)));
typedef float f32x4 __attribute__((ext_vector_type(4)));
typedef float f32x16 __attribute__((ext_vector_type(16)));
typedef unsigned u32x2 __attribute__((ext_vector_type(2)));
typedef unsigned u32x4 __attribute__((ext_vector_type(4)));

constexpr int MTOK = 32768, SEQ = 8192, DM = 2048, DFF = 5632, INC = 6656, PLE = 256, DEPTH = 2;
constexpr float ALPHA = 1.41421356237f;
constexpr float LOG2E = 1.44269504089f;
constexpr int LDS_BYTES = 147456;
constexpr int NPH = 1 + 13 * DEPTH;

constexpr size_t SZ_W1IN = (size_t)2 * DFF * DM * 2, SZ_W1OUT = (size_t)DM * DFF * 2, SZ_WMI = (size_t)INC * DM * 2, SZ_WMO = (size_t)DM * DM * 2,
                 SZ_WG = (size_t)DM * DM * 2, SZ_WE = (size_t)DM * PLE * 2;
constexpr size_t WS_W1IN = 0, WS_W1OUT = WS_W1IN + DEPTH * SZ_W1IN, WS_WMI = WS_W1OUT + DEPTH * SZ_W1OUT, WS_WMO = WS_WMI + DEPTH * SZ_WMI,
                 WS_W2IN = WS_WMO + DEPTH * SZ_WMO, WS_W2OUT = WS_W2IN + DEPTH * SZ_W1IN, WS_WG = WS_W2OUT + DEPTH * SZ_W1OUT, WS_WE = WS_WG + DEPTH * SZ_WG,
                 WS_H = WS_WE + DEPTH * SZ_WE, WS_XB = WS_H + (size_t)MTOK * INC * 2, WS_PB = WS_XB + (size_t)MTOK * DM * 2,
                 WS_CS = WS_PB + (size_t)DEPTH * MTOK * PLE * 2, WS_SSQ = WS_CS + (size_t)MTOK * 64 * 8, WS_TAB = WS_SSQ + (size_t)MTOK * 4 * 4,
                 WS_STAT = WS_TAB + 65536, WS_END = WS_STAT + (size_t)2 * MTOK * 4 * 8 * 2 * 4;
constexpr int TB_LOGLB = 0  , TB_LUT = 1024  , TB_LAM = 1600  , TB_PMAX = 1664  , TB_Q = 2304  ;

struct Params {
    const float* x; const float* p; const int* pos;
    const float *ffn1_in, *ffn1_out, *mix_in, *mix_out, *rel_bias, *dlam, *dnorm_g, *g_ln_g, *g_ln_b, *g_ws, *g_bs, *lb_logits, *hg_norm_g,
        *ffn2_in, *ffn2_out, *ple_gate, *ple_proj, *ln_g, *ln_b;
    float* out; unsigned char* ws;
    int ph_lo, ph_hi;
    double inv[64];
};

__device__ __forceinline__ unsigned cvt_pk_bf16(float lo, float hi) { unsigned r; asm("v_cvt_pk_bf16_f32 %0, %1, %2" : "=v"(r) : "v"(lo), "v"(hi)); return r; }
__device__ __forceinline__ float bf_lo(unsigned w) { return __uint_as_float(w << 16); }
__device__ __forceinline__ float bf_hi(unsigned w) { return __uint_as_float(w & 0xffff0000u); }
__device__ __forceinline__ unsigned off_b(unsigned row, unsigned ch) { return 256u * row + 16u * (ch ^ (((row & 3u) << 2) | ((row >> 2) & 3u))); }
__device__ __forceinline__ s16x4 tr_read(LAS const unsigned char* img, unsigned lane, unsigned rowbase, unsigned c) {
    const unsigned blk = (lane >> 4) & 1u, qq = (lane & 15u) >> 2, p = lane & 3u;
    return __builtin_amdgcn_ds_read_tr16_b64_v4i16((LAS s16x4*)(img + off_b(rowbase + qq, 4u * c + 2u * blk + (p >> 1)) + 8u * (p & 1u)));
}
__device__ __forceinline__ bf16x8 cat8(s16x4 a, s16x4 b) { bf16x8 r; r[0] = a[0]; r[1] = a[1]; r[2] = a[2]; r[3] = a[3]; r[4] = b[0]; r[5] = b[1]; r[6] = b[2]; r[7] = b[3]; return r; }
__device__ __forceinline__ bf16x8 pack8(float a0, float a1, float a2, float a3, float a4, float a5, float a6, float a7) {
    u32x4 w; w.x = cvt_pk_bf16(a0, a1); w.y = cvt_pk_bf16(a2, a3); w.z = cvt_pk_bf16(a4, a5); w.w = cvt_pk_bf16(a6, a7);
    return __builtin_bit_cast(bf16x8, w);
}
__device__ __forceinline__ f32x16 mfma32(bf16x8 a, bf16x8 b, f32x16 c) { return __builtin_amdgcn_mfma_f32_32x32x16_bf16(a, b, c, 0, 0, 0); }
__device__ __forceinline__ float silu_f(float v) { return v * __builtin_amdgcn_rcpf(1.0f + __expf(-v)); }
__device__ __forceinline__ float shx(float v, int off, int lane) { return __int_as_float(__builtin_amdgcn_ds_bpermute((lane ^ off) << 2, __float_as_int(v))); }
__device__ __forceinline__ int shxi(int v, int off, int lane) { return __builtin_amdgcn_ds_bpermute((lane ^ off) << 2, v); }
__device__ __forceinline__ float swapadd16(float a, float b) { auto r = __builtin_amdgcn_permlane16_swap(__float_as_uint(a), __float_as_uint(b), false, false); return __uint_as_float(r[0]) + __uint_as_float(r[1]); }
__device__ __forceinline__ float swapadd32(float a, float b) { auto r = __builtin_amdgcn_permlane32_swap(__float_as_uint(a), __float_as_uint(b), false, false); return __uint_as_float(r[0]) + __uint_as_float(r[1]); }
__device__ __forceinline__ int opaque_tid() { int t = threadIdx.x; asm volatile("" : "+v"(t)); return t; }
__device__ __forceinline__ int opaque_bid() { int t = blockIdx.x; asm volatile("" : "+s"(t)); return t; }
__device__ __forceinline__ f32x16 zero16() { f32x16 z; for (int i = 0; i < 16; ++i) z[i] = 0.f; return z; }

namespace pg8 {
constexpr int BM = 256, BK = 64, HALF = 128, HTB = HALF * BK * 2, STAGE_BYTES = 8 * HTB, NXCD = 8, WGM = 4;
__device__ __forceinline__ int lds_byte(int r, int c) { const int st = (r >> 4) * 2 + (c >> 5), rr = r & 15, cc = c & 31, ob = rr * 64 + cc * 2; return st * 1024 + (ob ^ (((ob >> 9) & 1) << 5)); }
__device__ __forceinline__ void stage_rc(int b, int& R, int& C) { const int st = b / 1024, sb = b % 1024, swz = sb ^ (((sb >> 9) & 1) << 5); R = (st >> 1) * 16 + swz / 64; C = (st & 1) * 32 + (swz % 64) / 2; }
__device__ __forceinline__ int perm32(int rho) { const int n = rho >> 4, i = rho & 15; return 8 * (i >> 2) + 4 * n + (i & 3); }
struct Unit { int pm, pn; };
struct Gemm { const bf16_t* A; const bf16_t* Bt; int M, N, K; };
struct StaticOrder {
    int nM, nN, nwg, G, c;
    __device__ void init(int M, int N, int G_, int c_) { nM = M / BM; nN = N / BM; nwg = nM * nN; G = G_; c = c_; }
    __device__ bool next(int i, Unit& u) const {
        const long L = (long)i * G + c; if (L >= nwg) return false;
        int wgid = (int)L; { const int q = nwg / NXCD, r = nwg % NXCD, xcd = wgid % NXCD, off = wgid / NXCD; wgid = (xcd < r ? xcd * (q + 1) : r * (q + 1) + (xcd - r) * q) + off; }
        const int nig = WGM * nN, gid = wgid / nig, fm = gid * WGM, gsz = (nM - fm) < WGM ? (nM - fm) : WGM;
        u.pm = fm + ((wgid % nig) % gsz); u.pn = (wgid % nig) / gsz; return true;
    }
};
template <class Epi>
__device__ __forceinline__ void gemm_phase(LAS unsigned char* lds, const Gemm g, const StaticOrder& S, const Epi& E) {
    const int tid = opaque_tid(), wid = __builtin_amdgcn_readfirstlane(tid >> 6), lane = tid & 63, wr = wid >> 2, wc = wid & 3, fr = lane & 15, fq = lane >> 4;
    const int K = g.K, nt = K / BK;
    unsigned voffA[2], voffB[2];
#pragma unroll
    for (int i = 0; i < 2; ++i) { int R, C; stage_rc(tid * 16 + i * 8192, R, C); const int Rb = Epi::PERM ? ((R & ~31) + perm32(R & 31)) : R;
        voffA[i] = (unsigned)(R * K + C) * 2u; voffB[i] = (unsigned)(Rb * K + C) * 2u; }
    const size_t kstep = (size_t)(BK * 2), hstep = (size_t)HALF * K * 2, tstep = 2 * hstep;
    const unsigned ldsw = (unsigned)wid * 1024u;
    const int aoff = lds_byte(wr * 64 + fr, fq * 8), boff = lds_byte(wc * 32 + fr, fq * 8);
#define PG8_SA(b, h) (((b) * 2 + (h)) * HTB)
#define PG8_SB(b, h) ((4 + (b) * 2 + (h)) * HTB)
#define PG8_STAGE(bufoff, gbase, voff) do { _Pragma("unroll") for (int _i = 0; _i < 2; ++_i) \
        __builtin_amdgcn_global_load_lds((const unsigned*)((const char*)(gbase) + (voff)[_i]), (LAS unsigned*)(lds + (bufoff) + ldsw + _i * 8192), 16, 0, 0); } while (0)
#define PG8_LDA(dst, b, h) do { _Pragma("unroll") for (int m = 0; m < 4; ++m) _Pragma("unroll") for (int k = 0; k < 2; ++k) dst[m][k] = *(const LAS bf16x8*)(lds + PG8_SA(b, h) + aoff + m * 2048 + k * 1024); } while (0)
#define PG8_LDB(dst, b, h) do { _Pragma("unroll") for (int n = 0; n < 2; ++n) _Pragma("unroll") for (int k = 0; k < 2; ++k) dst[n][k] = *(const LAS bf16x8*)(lds + PG8_SB(b, h) + boff + n * 2048 + k * 1024); } while (0)
#define PG8_MMA(ai, bj, At, Bt) do { __builtin_amdgcn_s_setprio(1); _Pragma("unroll") for (int m = 0; m < 4; ++m) _Pragma("unroll") for (int n = 0; n < 2; ++n) _Pragma("unroll") for (int k = 0; k < 2; ++k) \
        acc[ai][bj][m][n] = __builtin_amdgcn_mfma_f32_16x16x32_bf16(Bt[n][k], At[m][k], acc[ai][bj][m][n], 0, 0, 0); __builtin_amdgcn_s_setprio(0); } while (0)
#define PG8_WAIT_V(n) asm volatile("s_waitcnt vmcnt(" #n ")" ::: "memory")
#define PG8_WAIT_L(n) asm volatile("s_waitcnt lgkmcnt(" #n ")" ::: "memory")
#define PG8_BAR __builtin_amdgcn_s_barrier()
#define PG8_SCHED __builtin_amdgcn_sched_barrier(0)
    Unit cur, nxt; int ui = 0;
    if (!S.next(0, cur)) return;
    f32x4 acc[2][2][4][2];
#pragma unroll
    for (int a = 0; a < 2; ++a)
#pragma unroll
        for (int b = 0; b < 2; ++b)
#pragma unroll
            for (int m = 0; m < 4; ++m)
#pragma unroll
                for (int n = 0; n < 2; ++n) acc[a][b][m][n] = (f32x4){0.f, 0.f, 0.f, 0.f};
    bf16x8 At[4][2], B0[2][2], B1[2][2];
    const char* cA = (const char*)g.A + (size_t)cur.pm * tstep; const char* cB = (const char*)g.Bt + (size_t)cur.pn * tstep;
    PG8_STAGE(PG8_SB(0, 0), cB, voffB); PG8_STAGE(PG8_SA(0, 0), cA, voffA); PG8_STAGE(PG8_SB(0, 1), cB + hstep, voffB); PG8_STAGE(PG8_SA(0, 1), cA + hstep, voffA);
    if (wr == 1) PG8_BAR;
    PG8_WAIT_V(4); PG8_BAR;
    PG8_STAGE(PG8_SB(1, 0), cB + kstep, voffB); PG8_STAGE(PG8_SA(1, 0), cA + kstep, voffA); PG8_STAGE(PG8_SB(1, 1), cB + hstep + kstep, voffB);
    PG8_WAIT_V(6); PG8_BAR;
    for (;;) {
        const bool has_next = S.next(ui + 1, nxt);
        const char* nA = has_next ? (const char*)g.A + (size_t)nxt.pm * tstep : cA; const char* nB = has_next ? (const char*)g.Bt + (size_t)nxt.pn * tstep : cB;
        for (int t = 0; t < nt; t += 2) {
            const bool last = (t == nt - 2);
            const char* a1 = cA + (size_t)(t + 1) * kstep;
            const char* a2 = last ? nA : cA + (size_t)(t + 2) * kstep; const char* b2 = last ? nB : cB + (size_t)(t + 2) * kstep;
            const char* a3 = a2 + kstep; const char* b3 = b2 + kstep;
            PG8_LDB(B0, 0, 0); PG8_SCHED; PG8_LDA(At, 0, 0); PG8_STAGE(PG8_SA(1, 1), a1 + hstep, voffA);
            PG8_WAIT_L(8); PG8_BAR; PG8_WAIT_L(0); PG8_MMA(0, 0, At, B0); PG8_BAR; PG8_SCHED;
            PG8_LDB(B1, 0, 1); PG8_STAGE(PG8_SB(0, 0), b2, voffB);
            PG8_BAR; PG8_WAIT_L(0); PG8_MMA(0, 1, At, B1); PG8_BAR;
            PG8_LDA(At, 0, 1); PG8_STAGE(PG8_SA(0, 0), a2, voffA);
            PG8_BAR; PG8_WAIT_L(0); PG8_MMA(1, 0, At, B0); PG8_BAR; PG8_SCHED;
            PG8_STAGE(PG8_SB(0, 1), b2 + hstep, voffB);
            PG8_WAIT_V(6); PG8_BAR; PG8_MMA(1, 1, At, B1); PG8_BAR;
            PG8_LDB(B0, 1, 0); PG8_SCHED; PG8_LDA(At, 1, 0); PG8_STAGE(PG8_SA(0, 1), a2 + hstep, voffA);
            PG8_WAIT_L(8); PG8_BAR; PG8_WAIT_L(0); PG8_MMA(0, 0, At, B0); PG8_BAR; PG8_SCHED;
            PG8_LDB(B1, 1, 1); PG8_STAGE(PG8_SB(1, 0), b3, voffB);
            PG8_BAR; PG8_WAIT_L(0); PG8_MMA(0, 1, At, B1); PG8_BAR;
            PG8_LDA(At, 1, 1); PG8_STAGE(PG8_SA(1, 0), a3, voffA);
            PG8_BAR; PG8_WAIT_L(0); PG8_MMA(1, 0, At, B0); PG8_BAR; PG8_SCHED;
            PG8_STAGE(PG8_SB(1, 1), b3 + hstep, voffB);
            PG8_WAIT_V(6); PG8_BAR; PG8_MMA(1, 1, At, B1); PG8_BAR;
        }
        E(acc, cur, wr, wc, fr, fq);
        if (!has_next) break;
#pragma unroll
        for (int a = 0; a < 2; ++a)
#pragma unroll
            for (int b = 0; b < 2; ++b)
#pragma unroll
                for (int m = 0; m < 4; ++m)
#pragma unroll
                    for (int n = 0; n < 2; ++n) acc[a][b][m][n] = (f32x4){0.f, 0.f, 0.f, 0.f};
        cur = nxt; cA = nA; cB = nB; ++ui;
    }
    PG8_WAIT_V(0);
    if (wr == 0) PG8_BAR;
    PG8_BAR;
#undef PG8_SA
#undef PG8_SB
#undef PG8_STAGE
#undef PG8_LDA
#undef PG8_LDB
#undef PG8_MMA
#undef PG8_WAIT_V
#undef PG8_WAIT_L
#undef PG8_BAR
#undef PG8_SCHED
}
}
using pg8::Unit; using pg8::BM; using pg8::HALF;
typedef f32x4 Acc[2][2][4][2];

__device__ __forceinline__ float gelu_f(float v) {
    const float av = fabsf(v), t = __builtin_amdgcn_rcpf(av * 0.2316418882f + 1.0f);
    float q = t * 0.5307027145f + (-0.7265760135f); q = q * t + 0.7107068705f; q = q * t + (-0.142248368f); q = q * t + 0.127414796f; q = q * t;
    const float e = __builtin_amdgcn_exp2f((v * v) * (-0.72134752044f));
    const float m = v * (q * e);
    return v < 0.f ? m : v - m;
}

struct EpiSwiGLU {
    static constexpr bool PERM = true;
    bf16_t* H;
    __device__ __forceinline__ void operator()(const Acc& acc, const Unit& u, int wr, int wc, int fr, int fq) const {
        const int row0 = u.pm * BM + wr * 64 + fr, col0 = u.pn * 128 + wc * 32 + 8 * fq;
#pragma unroll
        for (int ai = 0; ai < 2; ++ai)
#pragma unroll
            for (int m = 0; m < 4; ++m) {
                float h[8];
#pragma unroll
                for (int n = 0; n < 2; ++n)
#pragma unroll
                    for (int j = 0; j < 4; ++j) h[4 * n + j] = silu_f(acc[ai][0][m][n][j]) * acc[ai][1][m][n][j];
                u32x4 w; w.x = cvt_pk_bf16(h[0], h[1]); w.y = cvt_pk_bf16(h[2], h[3]); w.z = cvt_pk_bf16(h[4], h[5]); w.w = cvt_pk_bf16(h[6], h[7]);
                *(u32x4*)(H + (size_t)(row0 + ai * HALF + m * 16) * DFF + col0) = w;
            }
    }
};
struct EpiRes {
    static constexpr bool PERM = false;
    const float* res; const bf16_t* resb; float* out; float scale;
    __device__ __forceinline__ void operator()(const Acc& acc, const Unit& u, int wr, int wc, int fr, int fq) const {
        const int row0 = u.pm * BM + wr * 64 + fr, col0 = u.pn * BM + wc * 32 + 4 * fq;
#pragma unroll
        for (int ai = 0; ai < 2; ++ai)
#pragma unroll
            for (int m = 0; m < 4; ++m) { const size_t ro = (size_t)(row0 + ai * HALF + m * 16) * DM + col0;
#pragma unroll
                for (int bj = 0; bj < 2; ++bj)
#pragma unroll
                    for (int n = 0; n < 2; ++n) { f32x4 r;
                        if (res) r = *(const f32x4*)(res + ro + bj * HALF + n * 16);
                        else { const u32x2 w = *(const u32x2*)(resb + ro + bj * HALF + n * 16); r = (f32x4){bf_lo(w.x), bf_hi(w.x), bf_lo(w.y), bf_hi(w.y)}; }
                        *(f32x4*)(out + ro + bj * HALF + n * 16) = r * ALPHA + acc[ai][bj][m][n] * scale; } }
    }
};
struct EpiPE {
    static constexpr bool PERM = false;
    float* pe;
    __device__ __forceinline__ void operator()(const Acc& acc, const Unit& u, int wr, int wc, int fr, int fq) const {
        const int row0 = u.pm * BM + wr * 64 + fr, col0 = u.pn * BM + wc * 32 + 4 * fq;
#pragma unroll
        for (int ai = 0; ai < 2; ++ai)
#pragma unroll
            for (int m = 0; m < 4; ++m) { const size_t ro = (size_t)(row0 + ai * HALF + m * 16) * DM + col0;
#pragma unroll
                for (int bj = 0; bj < 2; ++bj)
#pragma unroll
                    for (int n = 0; n < 2; ++n) *(f32x4*)(pe + ro + bj * HALF + n * 16) = acc[ai][bj][m][n]; }
    }
};
struct EpiGate {
    static constexpr bool PERM = false;
    float* X; const float* pe; const bf16_t* xb;
    __device__ __forceinline__ void operator()(const Acc& acc, const Unit& u, int wr, int wc, int fr, int fq) const {
        const int row0 = u.pm * BM + wr * 64 + fr, col0 = u.pn * BM + wc * 32 + 4 * fq;
#pragma unroll
        for (int ai = 0; ai < 2; ++ai)
#pragma unroll
            for (int m = 0; m < 4; ++m) { const size_t ro = (size_t)(row0 + ai * HALF + m * 16) * DM + col0;
#pragma unroll
                for (int bj = 0; bj < 2; ++bj)
#pragma unroll
                    for (int n = 0; n < 2; ++n) { const u32x2 w = *(const u32x2*)(xb + ro + bj * HALF + n * 16); const f32x4 r = (f32x4){bf_lo(w.x), bf_hi(w.x), bf_lo(w.y), bf_hi(w.y)}; const f32x4 pv = *(const f32x4*)(pe + ro + bj * HALF + n * 16);
                        f32x4 o;
#pragma unroll
                        for (int j = 0; j < 4; ++j) o[j] = r[j] * ALPHA + pv[j] * __builtin_amdgcn_rcpf(1.0f + __expf(-acc[ai][bj][m][n][j]));
                        *(f32x4*)(X + ro + bj * HALF + n * 16) = o; } }
    }
};
struct EpiMixIn {
    static constexpr bool PERM = true;
    bf16_t* Hm; const f32x2* cs; const float* loglb;
    __device__ __forceinline__ void operator()(const Acc& acc, const Unit& u, int wr, int wc, int fr, int fq) const {
        const int row0 = u.pm * BM + wr * 64 + fr;
        const int pn = u.pn;
        const int mode = (pn == 6 || pn == 7) ? 1 : (pn == 8 || pn == 9) ? 2 : (pn >= 14 && pn <= 17) ? 3 : (pn == 20 || pn == 21) ? 4 : 0;
#pragma unroll
        for (int ai = 0; ai < 2; ++ai)
#pragma unroll
            for (int m = 0; m < 4; ++m) {
                const int row = row0 + ai * HALF + m * 16;
#pragma unroll
                for (int bj = 0; bj < 2; ++bj) {
                    const int col = pn * BM + bj * HALF + wc * 32 + 8 * fq;
                    float v[8];
#pragma unroll
                    for (int n = 0; n < 2; ++n)
#pragma unroll
                        for (int j = 0; j < 4; ++j) v[4 * n + j] = acc[ai][bj][m][n][j];
                    if (mode == 1 || mode == 2) {
                        const int i0 = (col & 127) >> 1;
                        const f32x4 c01 = *(const f32x4*)(cs + (size_t)row * 64 + i0), c23 = *(const f32x4*)(cs + (size_t)row * 64 + i0 + 2);
                        const float sc = (mode == 2) ? 0.08838834764831845f : 1.0f;
                        const float cc[4] = {c01[0], c01[2], c23[0], c23[2]}, ss[4] = {c01[1], c01[3], c23[1], c23[3]};
#pragma unroll
                        for (int q = 0; q < 4; ++q) { const float x1 = v[2 * q], x2 = v[2 * q + 1]; v[2 * q] = (x1 * cc[q] - x2 * ss[q]) * sc; v[2 * q + 1] = (x1 * ss[q] + x2 * cc[q]) * sc; }
                    } else if (mode == 3) {
#pragma unroll
                        for (int q = 0; q < 8; ++q) v[q] = gelu_f(v[q]);
                    } else if (mode == 4) {
                        const int k0 = col - 5120;
                        const f32x4 l0 = *(const f32x4*)(loglb + k0), l1 = *(const f32x4*)(loglb + k0 + 4);
#pragma unroll
                        for (int q = 0; q < 8; ++q) { const float z = v[q], llb = q < 4 ? l0[q] : l1[q - 4];
                            const float az = fabsf(z), sp = __logf(1.0f + __expf(-az));
                            const float lsp = fminf(z, 0.f) - sp, lsn = fminf(-z, 0.f) - sp;
                            const float a = lsp, b = llb + lsn, mx = fmaxf(a, b), mn = fminf(a, b);
                            v[q] = mx + __logf(1.0f + __expf(mn - mx)); }
                    }
                    u32x4 w; w.x = cvt_pk_bf16(v[0], v[1]); w.y = cvt_pk_bf16(v[2], v[3]); w.z = cvt_pk_bf16(v[4], v[5]); w.w = cvt_pk_bf16(v[6], v[7]);
                    *(u32x4*)(Hm + (size_t)row * INC + col) = w;
                }
            }
    }
};

__device__ void conv_wT(const float* __restrict__ src, bf16_t* __restrict__ dst, int K, int N, int swiglu, LAS unsigned char* lds) {
    const int tid = opaque_tid(), bid = opaque_bid(), tilesN = N / 64, tilesK = K / 64, total = tilesN * tilesK;
    LAS bf16_t* t16 = (LAS bf16_t*)lds;
    for (int tile = bid; tile < total; tile += gridDim.x) {
        const int tn = tile % tilesN, tk = tile / tilesN;
        const int r = tid >> 4, c4 = (tid & 15) * 4;
#pragma unroll
        for (int p = 0; p < 2; ++p) {
            const f32x4 v = *(const f32x4*)(src + (size_t)(tk * 64 + r + 32 * p) * N + tn * 64 + c4);
#pragma unroll
            for (int j = 0; j < 4; ++j) t16[(c4 + j) * 72 + r + 32 * p] = (bf16_t)(cvt_pk_bf16(v[j], 0.f) & 0xffffu);
        }
        __syncthreads();
        const int n = tid >> 3, k8 = (tid & 7) * 8;
        const u32x4 w = *(const LAS u32x4*)(lds + n * 144 + k8 * 2);
        int nsrc = tn * 64 + n, ndst = nsrc;
        if (swiglu) { const int bj = nsrc >= DFF ? 1 : 0, hid = nsrc - DFF * bj; ndst = 256 * (hid >> 7) + 128 * bj + (hid & 127); }
        *(u32x4*)(dst + (size_t)ndst * K + tk * 64 + k8) = w;
        __syncthreads();
    }
}
__device__ void conv_flat(const float* __restrict__ src, bf16_t* __restrict__ dst, size_t n) {
    const size_t stride = (size_t)gridDim.x * 512 * 8;
    for (size_t i = ((size_t)opaque_bid() * 512 + opaque_tid()) * 8; i < n; i += stride) {
        const f32x4 a = *(const f32x4*)(src + i), b = *(const f32x4*)(src + i + 4);
        u32x4 w; w.x = cvt_pk_bf16(a[0], a[1]); w.y = cvt_pk_bf16(a[2], a[3]); w.z = cvt_pk_bf16(b[0], b[1]); w.w = cvt_pk_bf16(b[2], b[3]);
        *(u32x4*)(dst + i) = w;
    }
}
__device__ void prep_phase(const Params& P, LAS unsigned char* lds) {
    unsigned char* ws = P.ws;
    const int tid = opaque_tid(), bid = opaque_bid();
    float* tabf = (float*)(ws + WS_TAB); int* tabi = (int*)(ws + WS_TAB);
    if (bid == 0) {
        { const float l0 = P.lb_logits[tid], l1 = P.lb_logits[512 + tid]; const float s1 = 1.0f / (1.0f + expf(l0 - l1));
          tabf[TB_LOGLB + tid] = logf(1e-30f); tabf[TB_LOGLB + 512 + tid] = logf(fmaxf(s1, 1e-30f)); }
        for (int i2 = tid; i2 < 4 * 129; i2 += 512) { const int h = i2 / 129, n = i2 % 129; int bk;
            if (n < 16) bk = n; else { bk = 16 + (int)(logf((float)n / 16.0f) / 2.0794415416798357f * 16.0f); bk = bk > 31 ? 31 : bk; }
            tabf[TB_LUT + h * 132 + n] = P.rel_bias[bk * 4 + h] * LOG2E; }
        if (tid < DEPTH) { float s1 = 0.f, s2 = 0.f; const float* dl = P.dlam + tid * 256;
            for (int j = 0; j < 64; ++j) { s1 += dl[j] * dl[64 + j]; s2 += dl[128 + j] * dl[192 + j]; }
            const float lam_init = 0.8f - 0.6f * expf(-0.3f * (float)tid);
            tabf[TB_LAM + tid] = expf(s1) - expf(s2) + lam_init; }
        if (tid < 2) ((unsigned*)tabi)[TB_Q + tid] = 0u;
    }
    { f32x2* cs = (f32x2*)(ws + WS_CS);
      for (size_t i = (size_t)bid * 512 + tid; i < (size_t)MTOK * 64; i += (size_t)gridDim.x * 512) {
          const int tok = (int)(i >> 6), fi = (int)(i & 63);
          const double ang = (double)P.pos[tok] * P.inv[fi];
          const double rev = ang * 0.15915494309189535; const float fr = (float)(rev - rint(rev));
          cs[i] = (f32x2){__builtin_amdgcn_cosf(fr), __builtin_amdgcn_sinf(fr)};
      } }
    conv_flat(P.x, (bf16_t*)(ws + WS_XB), (size_t)MTOK * DM);
    conv_flat(P.p, (bf16_t*)(ws + WS_PB), (size_t)DEPTH * MTOK * PLE);
    for (int L = 0; L < DEPTH; ++L) {
        conv_wT(P.ffn1_in + (size_t)L * DM * 2 * DFF, (bf16_t*)(ws + WS_W1IN + L * SZ_W1IN), DM, 2 * DFF, 1, lds);
        conv_wT(P.ffn1_out + (size_t)L * DFF * DM, (bf16_t*)(ws + WS_W1OUT + L * SZ_W1OUT), DFF, DM, 0, lds);
        conv_wT(P.mix_in + (size_t)L * DM * INC, (bf16_t*)(ws + WS_WMI + L * SZ_WMI), DM, INC, 0, lds);
        conv_wT(P.mix_out + (size_t)L * DM * DM, (bf16_t*)(ws + WS_WMO + L * SZ_WMO), DM, DM, 0, lds);
        conv_wT(P.ffn2_in + (size_t)L * DM * 2 * DFF, (bf16_t*)(ws + WS_W2IN + L * SZ_W1IN), DM, 2 * DFF, 1, lds);
        conv_wT(P.ffn2_out + (size_t)L * DFF * DM, (bf16_t*)(ws + WS_W2OUT + L * SZ_W1OUT), DFF, DM, 0, lds);
        conv_wT(P.ple_gate + (size_t)L * DM * DM, (bf16_t*)(ws + WS_WG + L * SZ_WG), DM, DM, 0, lds);
        conv_wT(P.ple_proj + (size_t)L * PLE * DM, (bf16_t*)(ws + WS_WE + L * SZ_WE), PLE, DM, 0, lds);
    }
}

__device__ void ln_phase(float* X, const float* __restrict__ g, const float* __restrict__ b, bf16_t* Xb, bool write_x) {
    const int tid = opaque_tid(); const int lane = tid & 63, gw = opaque_bid() * 8 + (tid >> 6), nw = gridDim.x * 8;
    for (int row = gw; row + nw < MTOK; row += 2 * nw) {
        float* xr0 = X + (size_t)row * DM; float* xr1 = X + (size_t)(row + nw) * DM;
        bf16_t* xb0 = Xb + (size_t)row * DM; bf16_t* xb1 = Xb + (size_t)(row + nw) * DM;
        f32x4 v0[8], v1[8]; float s0 = 0.f, s1 = 0.f;
#pragma unroll
        for (int i = 0; i < 8; ++i) { v0[i] = *(const f32x4*)(xr0 + (i * 64 + lane) * 4); v1[i] = *(const f32x4*)(xr1 + (i * 64 + lane) * 4); }
#pragma unroll
        for (int i = 0; i < 8; ++i) { s0 += v0[i][0] + v0[i][1] + v0[i][2] + v0[i][3]; s1 += v1[i][0] + v1[i][1] + v1[i][2] + v1[i][3]; }
#pragma unroll
        for (int o = 32; o >= 1; o >>= 1) { s0 += shx(s0, o, lane); s1 += shx(s1, o, lane); }
        const float mu0 = s0 * (1.0f / DM), mu1 = s1 * (1.0f / DM); float q0 = 0.f, q1 = 0.f;
#pragma unroll
        for (int i = 0; i < 8; ++i)
#pragma unroll
            for (int j = 0; j < 4; ++j) { const float d0 = v0[i][j] - mu0, d1 = v1[i][j] - mu1; q0 += d0 * d0; q1 += d1 * d1; }
#pragma unroll
        for (int o = 32; o >= 1; o >>= 1) { q0 += shx(q0, o, lane); q1 += shx(q1, o, lane); }
        const float rs0 = rsqrtf(q0 * (1.0f / DM) + 1e-5f), rs1 = rsqrtf(q1 * (1.0f / DM) + 1e-5f);
#pragma unroll
        for (int i = 0; i < 8; ++i) { const int c = (i * 64 + lane) * 4; const f32x4 gg = *(const f32x4*)(g + c), bb = *(const f32x4*)(b + c); f32x4 o0, o1;
#pragma unroll
            for (int j = 0; j < 4; ++j) { o0[j] = (v0[i][j] - mu0) * rs0 * gg[j] + bb[j]; o1[j] = (v1[i][j] - mu1) * rs1 * gg[j] + bb[j]; }
            if (write_x) { *(f32x4*)(xr0 + c) = o0; *(f32x4*)(xr1 + c) = o1; }
            u32x2 w; w.x = cvt_pk_bf16(o0[0], o0[1]); w.y = cvt_pk_bf16(o0[2], o0[3]); *(u32x2*)(xb0 + c) = w;
            u32x2 w1; w1.x = cvt_pk_bf16(o1[0], o1[1]); w1.y = cvt_pk_bf16(o1[2], o1[3]); *(u32x2*)(xb1 + c) = w1; }
    }
}

__device__ void attn_unit(const Params& P, int layer, int b, int h, int qblk, LAS unsigned char* lds) {
    const int tid = opaque_tid(), wid = __builtin_amdgcn_readfirstlane(tid >> 6), lane_ = tid & 63, lane = lane_, l31 = lane & 31, hh = lane >> 5;
    const int c = wid & 1, rb = wid >> 1;
    const bf16_t* Hm = (const bf16_t*)(P.ws + WS_H);
    const float* tabf = (const float*)(P.ws + WS_TAB); const int* tabi = (const int*)(P.ws + WS_TAB);
    LAS float* lut = (LAS float*)(lds + 66048); LAS int* posk = (LAS int*)(lds + 65536); LAS int* pkmx = (LAS int*)(lds + 66576);
    const int q0w = qblk * 128 + rb * 32, qrow = q0w + l31;
    const size_t tok = (size_t)b * SEQ + qrow;
    bf16x8 qf[4];
    { const bf16_t* qp = Hm + tok * INC + h * 128 + c * 64 + 8 * hh;
#pragma unroll
      for (int ks = 0; ks < 4; ++ks) qf[ks] = *(const bf16x8*)(qp + 16 * ks); }
    const int pq = P.pos[b * SEQ + qrow];
    int pqmin = pq;
#pragma unroll
    for (int o = 16; o >= 1; o >>= 1) { const int t = shxi(pqmin, o, lane); pqmin = t < pqmin ? t : pqmin; }
    pqmin = __builtin_amdgcn_readfirstlane(pqmin);
    f32x16 O[4];
#pragma unroll
    for (int d = 0; d < 4; ++d) O[d] = zero16();
    float mrun = -1e30f, lrun = 0.f;
    const int nt = 2 * qblk + 2;
    const float sc2 = 0.125f * LOG2E;
    const int srow = (tid >> 4), sch = tid & 15;
    const bf16_t* gK = Hm + ((size_t)b * SEQ) * INC + 512 + h * 128 + sch * 8;
    const bf16_t* gV = gK + 512;
    u32x4 st[4];
    __syncthreads();
    if (tid < 129) lut[tid] = tabf[TB_LUT + h * 132 + tid];
#define ATT_LOAD(kt) do { const size_t r0 = (size_t)((kt) * 64 + srow) * INC; st[0] = *(const u32x4*)(gK + r0); st[1] = *(const u32x4*)(gK + r0 + (size_t)32 * INC); \
        st[2] = *(const u32x4*)(gV + r0); st[3] = *(const u32x4*)(gV + r0 + (size_t)32 * INC); } while (0)
#define ATT_STORE(buf, kt) do { LAS unsigned char* kb = lds + (buf) * 32768; *(LAS u32x4*)(kb + off_b(srow, sch)) = st[0]; *(LAS u32x4*)(kb + off_b(srow + 32, sch)) = st[1]; \
        *(LAS u32x4*)(kb + 16384 + off_b(srow, sch)) = st[2]; *(LAS u32x4*)(kb + 16384 + off_b(srow + 32, sch)) = st[3]; \
        if (tid < 64) { int pv_ = P.pos[b * SEQ + (kt) * 64 + tid]; posk[(buf) * 64 + tid] = pv_; _Pragma("unroll") for (int o_ = 32; o_ >= 1; o_ >>= 1) { const int t_ = shxi(pv_, o_, lane_); pv_ = t_ > pv_ ? t_ : pv_; } if (tid == 0) pkmx[buf] = pv_; } } while (0)
    ATT_LOAD(0); ATT_STORE(0, 0);
    __syncthreads();
    for (int kt = 0; kt < nt; ++kt) {
        const int buf = kt & 1, k0 = kt * 64;
        if (kt + 1 < nt) ATT_LOAD(kt + 1);
        if (k0 <= q0w + 31) {
            int lane = lane_; asm volatile("" : "+v"(lane)); const int l31 = lane & 31, hh = lane >> 5;
            LAS const unsigned char* Kimg = lds + buf * 32768; LAS const unsigned char* Vimg = Kimg + 16384;
            f32x16 S[2];
#pragma unroll
            for (int s2 = 0; s2 < 2; ++s2) { S[s2] = zero16();
#pragma unroll
                for (int ks = 0; ks < 4; ++ks) { const bf16x8 a = *(const LAS bf16x8*)(Kimg + off_b(32 * s2 + l31, 8 * c + 2 * ks + hh)); S[s2] = mfma32(a, qf[ks], S[s2]); } }
            const bool far = (pqmin - pkmx[buf]) >= 128;
            const bool needmask = (k0 + 63 > q0w);
            float mnew, rsum = 0.f;
            if (far && !needmask) {
                const float cb = lut[128];
                float mx = S[0][0];
#pragma unroll
                for (int s2 = 0; s2 < 2; ++s2)
#pragma unroll
                    for (int i = 0; i < 16; ++i) mx = fmaxf(mx, S[s2][i]);
                mx = fmaxf(mx, shx(mx, 32, lane));
                mnew = fmaxf(mrun, mx * sc2 + cb);
                const float off = cb - mnew;
#pragma unroll
                for (int s2 = 0; s2 < 2; ++s2)
#pragma unroll
                    for (int i = 0; i < 16; ++i) { const float pe = __builtin_amdgcn_exp2f(S[s2][i] * sc2 + off); S[s2][i] = pe; rsum += pe; }
            } else {
                if (far) { const float cb = lut[128];
#pragma unroll
                    for (int s2 = 0; s2 < 2; ++s2)
#pragma unroll
                        for (int i = 0; i < 16; ++i) S[s2][i] = S[s2][i] * sc2 + cb;
                } else {
#pragma unroll
                    for (int s2 = 0; s2 < 2; ++s2)
#pragma unroll
                        for (int i = 0; i < 16; ++i) { const int kk = 32 * s2 + 8 * (i >> 2) + 4 * hh + (i & 3); int rel = pq - posk[buf * 64 + kk]; rel = rel < 0 ? 0 : (rel > 128 ? 128 : rel);
                            S[s2][i] = S[s2][i] * sc2 + lut[rel]; }
                }
                if (needmask) {
#pragma unroll
                    for (int s2 = 0; s2 < 2; ++s2)
#pragma unroll
                        for (int i = 0; i < 16; ++i) { const int kk = k0 + 32 * s2 + 8 * (i >> 2) + 4 * hh + (i & 3); if (kk > qrow) S[s2][i] = -1e30f; }
                }
                float mx = S[0][0];
#pragma unroll
                for (int s2 = 0; s2 < 2; ++s2)
#pragma unroll
                    for (int i = 0; i < 16; ++i) mx = fmaxf(mx, S[s2][i]);
                mx = fmaxf(mx, shx(mx, 32, lane));
                mnew = fmaxf(mrun, mx);
#pragma unroll
                for (int s2 = 0; s2 < 2; ++s2)
#pragma unroll
                    for (int i = 0; i < 16; ++i) { const float pe = __builtin_amdgcn_exp2f(S[s2][i] - mnew); S[s2][i] = pe; rsum += pe; }
            }
            const float alpha = __builtin_amdgcn_exp2f(mrun - mnew);
            rsum += shx(rsum, 32, lane);
            lrun = lrun * alpha + rsum; mrun = mnew;
            if (__builtin_amdgcn_ballot_w64(alpha != 1.0f) != 0ull) {
#pragma unroll
                for (int d = 0; d < 4; ++d)
#pragma unroll
                    for (int i = 0; i < 16; ++i) O[d][i] *= alpha;
            }
#pragma unroll
            for (int s2 = 0; s2 < 2; ++s2)
#pragma unroll
                for (int sp = 0; sp < 2; ++sp) {
                    const bf16x8 pf = pack8(S[s2][8 * sp + 0], S[s2][8 * sp + 1], S[s2][8 * sp + 2], S[s2][8 * sp + 3], S[s2][8 * sp + 4], S[s2][8 * sp + 5], S[s2][8 * sp + 6], S[s2][8 * sp + 7]);
                    const unsigned rbase = 32 * s2 + 16 * sp + 4 * hh;
#pragma unroll
                    for (int d = 0; d < 4; ++d) { const bf16x8 va = cat8(tr_read(Vimg, lane, rbase, d), tr_read(Vimg, lane, rbase + 8, d)); O[d] = mfma32(va, pf, O[d]); }
                }
        }
        if (kt + 1 < nt) ATT_STORE(buf ^ 1, kt + 1);
        __syncthreads();
    }
#undef ATT_LOAD
#undef ATT_STORE
    LAS float* X = (LAS float*)lds;
    const float inv_l = 1.0f / lrun;
    if (c == 1) {
#pragma unroll
        for (int d = 0; d < 4; ++d)
#pragma unroll
            for (int i = 0; i < 16; ++i) X[(rb * 64 + d * 16 + i) * 64 + lane] = O[d][i] * inv_l;
    }
    __syncthreads();
    if (c == 0) {
        const float lam = tabf[TB_LAM + layer];
        const float lam_init = 0.8f - 0.6f * __expf(-0.3f * (float)layer);
        float ss = 0.f;
#pragma unroll
        for (int d = 0; d < 4; ++d)
#pragma unroll
            for (int i = 0; i < 16; ++i) { const float v = O[d][i] * inv_l - lam * X[(rb * 64 + d * 16 + i) * 64 + lane]; O[d][i] = v; ss += v * v; }
        ss += shx(ss, 32, lane);
        const float rs = rsqrtf(ss * (1.0f / 128.0f) + 1e-5f) * (1.0f - lam_init);
        bf16_t* Ob = (bf16_t*)(P.ws + WS_XB) + tok * DM + h * 128;
        const float* ng = P.dnorm_g + layer * 128;
#pragma unroll
        for (int d = 0; d < 4; ++d)
#pragma unroll
            for (int g4 = 0; g4 < 4; ++g4) { const int e0 = 32 * d + 8 * g4 + 4 * hh; const f32x4 gg = *(const f32x4*)(ng + e0);
                u32x2 w; w.x = cvt_pk_bf16(O[d][4 * g4] * rs * gg[0], O[d][4 * g4 + 1] * rs * gg[1]); w.y = cvt_pk_bf16(O[d][4 * g4 + 2] * rs * gg[2], O[d][4 * g4 + 3] * rs * gg[3]);
                *(u32x2*)(Ob + e0) = w; }
    }
    __syncthreads();
}

__device__ void gla_stream(const Params& P, int layer, int type, int b, int h, int sl, LAS unsigned char* lds) {
    const int tid = opaque_tid(), wid = __builtin_amdgcn_readfirstlane(tid >> 6), lane = tid & 63;
    const bf16_t* Hm = (const bf16_t*)(P.ws + WS_H);
    bf16_t* Ob = (bf16_t*)(P.ws + WS_XB);
    float* stat = (float*)(P.ws + WS_STAT);
    const int qcol = (type ? 4608 : 1536) + h * 128, kcol = (type ? 5120 : 2048) + h * 128, vcol = (type ? 5632 : 2560) + h * 128 + 32 * sl,
              ocol = (type ? 1536 : 512) + h * 128 + 32 * sl;
    const float gam = 1.0f - exp2f(-5.0f - (float)h);
    LAS float* FF = (LAS float*)lds; LAS unsigned* QK = (LAS unsigned*)lds + 2048; LAS float* VF = FF + 4096; LAS float* OP = FF + 4608;
    const int e_l = tid & 15, kg = tid >> 4;
    const int stok = tid >> 5, sc4 = (tid & 31) * 4;
    const int vtok = (tid >> 4) & 15, vc2 = (tid & 15) * 2;
    float S0[4] = {0.f, 0.f, 0.f, 0.f}, S1[4] = {0.f, 0.f, 0.f, 0.f};
    u32x2 pq2, pk2; unsigned pv1 = 0u;
    const bf16_t* gbase = Hm + ((size_t)b * SEQ + stok) * INC + sc4;
    const bf16_t* vbase = Hm + ((size_t)b * SEQ + vtok) * INC + vcol + vc2;
#define GLS_LOAD(bt) do { const bf16_t* gp = gbase + (size_t)(bt) * 16 * INC; pq2 = *(const u32x2*)(gp + qcol); pk2 = *(const u32x2*)(gp + kcol); \
        if (tid < 256) pv1 = *(const unsigned*)(vbase + (size_t)(bt) * 16 * INC); } while (0)
    GLS_LOAD(0);
    __syncthreads();
    for (int bt = 0; bt < 512; ++bt) {
        const size_t T0 = (size_t)b * SEQ + (size_t)bt * 16;
        { const int o = stok * 128 + sc4;
          if (type) { const float l0 = bf_lo(pk2.x), l1 = bf_hi(pk2.x), l2 = bf_lo(pk2.y), l3 = bf_hi(pk2.y);
              *(LAS f32x4*)(FF + o) = (f32x4){__expf(l0), __expf(l1), __expf(l2), __expf(l3)};
              const unsigned k01 = cvt_pk_bf16(1.0f - __expf(l0), 1.0f - __expf(l1)), k23 = cvt_pk_bf16(1.0f - __expf(l2), 1.0f - __expf(l3));
              *(LAS u32x4*)(QK + o) = (u32x4){(pq2.x & 0xffffu) | (k01 << 16), (pq2.x >> 16) | (k01 & 0xffff0000u), (pq2.y & 0xffffu) | (k23 << 16), (pq2.y >> 16) | (k23 & 0xffff0000u)}; }
          else {
              *(LAS u32x4*)(QK + o) = (u32x4){(pq2.x & 0xffffu) | (pk2.x << 16), (pq2.x >> 16) | (pk2.x & 0xffff0000u), (pq2.y & 0xffffu) | (pk2.y << 16), (pq2.y >> 16) | (pk2.y & 0xffff0000u)}; }
          if (tid < 256) { VF[vtok * 32 + vc2] = bf_lo(pv1); VF[vtok * 32 + vc2 + 1] = bf_hi(pv1); } }
        if (bt + 1 < 512) GLS_LOAD(bt + 1);
        __syncthreads();
        float accs[32];
#pragma unroll
        for (int tt = 0; tt < 16; ++tt) {
            const float v0 = VF[tt * 32 + e_l], v1 = VF[tt * 32 + 16 + e_l];
            f32x4 f4 = (f32x4){gam, gam, gam, gam}; if (type) f4 = *(const LAS f32x4*)(FF + tt * 128 + 4 * kg);
            const u32x4 qk = *(const LAS u32x4*)(QK + tt * 128 + 4 * kg);
            const unsigned qw[4] = {qk.x, qk.y, qk.z, qk.w};
            float a0 = 0.f, a1 = 0.f;
#pragma unroll
            for (int j = 0; j < 4; ++j) { const float q = bf_lo(qw[j]), c = bf_hi(qw[j]);
                S0[j] = f4[j] * S0[j] + c * v0; S1[j] = f4[j] * S1[j] + c * v1; a0 += q * S0[j]; a1 += q * S1[j]; }
            accs[2 * tt] = a0; accs[2 * tt + 1] = a1;
        }
        { const bool b0 = (lane & 16) != 0, b1 = (lane & 32) != 0;
          float r16[16];
#pragma unroll
          for (int i = 0; i < 16; ++i) r16[i] = swapadd16(accs[i], accs[16 + i]);
          float r8[8];
#pragma unroll
          for (int i = 0; i < 8; ++i) r8[i] = swapadd32(r16[i], r16[8 + i]);
          const int vb = (b0 ? 16 : 0) + (b1 ? 8 : 0);
#pragma unroll
          for (int i = 0; i < 8; ++i) { const int vi = vb + i; OP[((vi >> 1) * 8 + wid) * 32 + (vi & 1) * 16 + e_l] = r8[i]; } }
        __syncthreads();
        { const int tt = tid >> 5, e32 = tid & 31; const size_t tok = T0 + tt;
            float o = 0.f;
#pragma unroll
            for (int w = 0; w < 8; ++w) o += OP[(tt * 8 + w) * 32 + e32];
            Ob[tok * DM + ocol + e32] = (bf16_t)(cvt_pk_bf16(o, 0.f) & 0xffffu);
            float s1 = o, s2 = o * o;
#pragma unroll
            for (int of = 16; of >= 1; of >>= 1) { s1 += shx(s1, of, lane); s2 += shx(s2, of, lane); }
            if (e32 == 0) *(f32x4*)(stat + ((((size_t)type * MTOK + tok) * 4 + h) * 8 + 2 * sl) * 2) = (f32x4){s1, s2, 0.f, 0.f}; }
    }
#undef GLS_LOAD
    __syncthreads();
}

__device__ void gla_post_phase(const Params& P, int layer) {
    bf16_t* Ob = (bf16_t*)(P.ws + WS_XB); const bf16_t* Hm = (const bf16_t*)(P.ws + WS_H); const float* stat = (const float*)(P.ws + WS_STAT);
    const float* ng = P.hg_norm_g + layer * 512;
    const int tid = opaque_tid(); const int lane = tid & 63, gw = opaque_bid() * 8 + (tid >> 6), nw = gridDim.x * 8;
    const int hd = lane >> 4;
    for (int tok = gw; tok < MTOK; tok += nw) {
        { const float* sp = stat + (((size_t)tok) * 4 + hd) * 16; float s1 = 0.f, s2 = 0.f;
#pragma unroll
          for (int q = 0; q < 4; ++q) { const f32x4 a = *(const f32x4*)(sp + 4 * q); s1 += a[0] + a[2]; s2 += a[1] + a[3]; }
          const float mu = s1 * (1.0f / 128.0f), var = fmaxf(s2 * (1.0f / 128.0f) - mu * mu, 0.f), rs = rsqrtf(var + 1e-5f);
          u32x4* p = (u32x4*)(Ob + (size_t)tok * DM + 512 + lane * 8); const u32x4 w = *p; const u32x4 g = *(const u32x4*)(Hm + (size_t)tok * INC + 3072 + lane * 8);
          const unsigned ww[4] = {w.x, w.y, w.z, w.w}, gg[4] = {g.x, g.y, g.z, g.w}; unsigned oo[4];
#pragma unroll
          for (int j = 0; j < 4; ++j) oo[j] = cvt_pk_bf16((bf_lo(ww[j]) - mu) * rs * silu_f(bf_lo(gg[j])), (bf_hi(ww[j]) - mu) * rs * silu_f(bf_hi(gg[j])));
          *p = (u32x4){oo[0], oo[1], oo[2], oo[3]}; }
        { const float* sp = stat + (((size_t)MTOK + tok) * 4) * 16; float s2 = 0.f;
#pragma unroll
          for (int q = 0; q < 16; ++q) { const f32x4 a = *(const f32x4*)(sp + 4 * q); s2 += a[1] + a[3]; }
          const float rs = rsqrtf(s2 * (1.0f / 512.0f) + 1e-5f);
          u32x4* p = (u32x4*)(Ob + (size_t)tok * DM + 1536 + lane * 8); const u32x4 w = *p; const u32x4 g = *(const u32x4*)(Hm + (size_t)tok * INC + 6144 + lane * 8);
          const f32x4 n0 = *(const f32x4*)(ng + lane * 8), n1 = *(const f32x4*)(ng + lane * 8 + 4);
          const unsigned ww[4] = {w.x, w.y, w.z, w.w}, gg[4] = {g.x, g.y, g.z, g.w}; const float nn[8] = {n0[0], n0[1], n0[2], n0[3], n1[0], n1[1], n1[2], n1[3]}; unsigned oo[4];
#pragma unroll
          for (int j = 0; j < 4; ++j) oo[j] = cvt_pk_bf16(bf_lo(ww[j]) * rs * nn[2 * j] * silu_f(bf_lo(gg[j])), bf_hi(ww[j]) * rs * nn[2 * j + 1] * silu_f(bf_hi(gg[j])));
          *p = (u32x4){oo[0], oo[1], oo[2], oo[3]}; }
    }
}

__device__ void gmlp_unit(const Params& P, int layer, int b, int chunk, LAS unsigned char* lds) {
    constexpr unsigned VIMG = 0, WIMG = 32768, MU = 65536, RS = 66048;
    const int tid = opaque_tid(), wid = __builtin_amdgcn_readfirstlane(tid >> 6), lane = tid & 63, l31 = lane & 31, hh = lane >> 5;
    const bf16_t* Hm = (const bf16_t*)(P.ws + WS_H);
    bf16_t* Ob = (bf16_t*)(P.ws + WS_XB);
    const size_t T0 = (size_t)b * SEQ + chunk * 128;
    __syncthreads();
    for (int i = 0; i < 16; ++i) { const int t = wid * 16 + i; const u32x4 w = *(const u32x4*)(Hm + (T0 + t) * INC + 4096 + lane * 8);
        const float v[8] = {bf_lo(w.x), bf_hi(w.x), bf_lo(w.y), bf_hi(w.y), bf_lo(w.z), bf_hi(w.z), bf_lo(w.w), bf_hi(w.w)};
        float s = 0.f;
#pragma unroll
        for (int j = 0; j < 8; ++j) s += v[j];
#pragma unroll
        for (int o = 32; o >= 1; o >>= 1) s += shx(s, o, lane);
        const float mu = s * (1.0f / 512.0f); float q = 0.f;
#pragma unroll
        for (int j = 0; j < 8; ++j) { const float d = v[j] - mu; q += d * d; }
#pragma unroll
        for (int o = 32; o >= 1; o >>= 1) q += shx(q, o, lane);
        if (lane == 0) { ((LAS float*)(lds + MU))[t] = mu; ((LAS float*)(lds + RS))[t] = rsqrtf(q * (1.0f / 512.0f) + 1e-5f); } }
    __syncthreads();
    const int tb = wid & 3, ct0 = 2 * (wid >> 2);
    for (int g = 0; g < 4; ++g) {
        const float* lg = P.g_ln_g + layer * 512 + g * 128; const float* lb = P.g_ln_b + layer * 512 + g * 128;
        const float* Wg = P.g_ws + ((size_t)(layer * 4 + g)) * 128 * 128;
#pragma unroll
        for (int i = 0; i < 4; ++i) { const int n = tid + 512 * i, s = n >> 4, ch = n & 15;
            const u32x4 w = *(const u32x4*)(Hm + (T0 + s) * INC + 4096 + g * 128 + ch * 8);
            const float mu = ((LAS float*)(lds + MU))[s], rs = ((LAS float*)(lds + RS))[s];
            const f32x4 g0 = *(const f32x4*)(lg + ch * 8), g1 = *(const f32x4*)(lg + ch * 8 + 4), b0 = *(const f32x4*)(lb + ch * 8), b1 = *(const f32x4*)(lb + ch * 8 + 4);
            const float v[8] = {bf_lo(w.x), bf_hi(w.x), bf_lo(w.y), bf_hi(w.y), bf_lo(w.z), bf_hi(w.z), bf_lo(w.w), bf_hi(w.w)};
            float y[8];
#pragma unroll
            for (int j = 0; j < 8; ++j) y[j] = (v[j] - mu) * rs * (j < 4 ? g0[j] : g1[j - 4]) + (j < 4 ? b0[j] : b1[j - 4]);
            *(LAS bf16x8*)(lds + VIMG + off_b(s, ch)) = pack8(y[0], y[1], y[2], y[3], y[4], y[5], y[6], y[7]);
            const f32x4 w0 = *(const f32x4*)(Wg + s * 128 + ch * 8), w1 = *(const f32x4*)(Wg + s * 128 + ch * 8 + 4);
            float ww[8];
#pragma unroll
            for (int j = 0; j < 8; ++j) ww[j] = (ch * 8 + j <= s) ? (j < 4 ? w0[j] : w1[j - 4]) : 0.f;
            *(LAS bf16x8*)(lds + WIMG + off_b(s, ch)) = pack8(ww[0], ww[1], ww[2], ww[3], ww[4], ww[5], ww[6], ww[7]); }
        __syncthreads();
        f32x16 acc[2]; acc[0] = zero16(); acc[1] = zero16();
        for (int ks = 0; ks < 2 * (tb + 1); ++ks) {
            const bf16x8 bw = *(const LAS bf16x8*)(lds + WIMG + off_b(32 * tb + l31, 2 * ks + hh));
#pragma unroll
            for (int e = 0; e < 2; ++e) { const bf16x8 av = cat8(tr_read(lds + VIMG, lane, 16 * ks + 8 * hh, ct0 + e), tr_read(lds + VIMG, lane, 16 * ks + 8 * hh + 4, ct0 + e)); acc[e] = mfma32(av, bw, acc[e]); }
        }
        { const int t = 32 * tb + l31; const size_t tok = T0 + t; const float bs = P.g_bs[(layer * 4 + g) * 128 + t];
#pragma unroll
          for (int e = 0; e < 2; ++e)
#pragma unroll
              for (int g4 = 0; g4 < 4; ++g4) { const int c0 = 32 * (ct0 + e) + 8 * g4 + 4 * hh;
                  const u32x2 uw = *(const u32x2*)(Hm + tok * INC + 3584 + g * 128 + c0);
                  u32x2 w; w.x = cvt_pk_bf16(bf_lo(uw.x) * (acc[e][4 * g4] + bs), bf_hi(uw.x) * (acc[e][4 * g4 + 1] + bs)); w.y = cvt_pk_bf16(bf_lo(uw.y) * (acc[e][4 * g4 + 2] + bs), bf_hi(uw.y) * (acc[e][4 * g4 + 3] + bs));
                  *(u32x2*)(Ob + tok * DM + 1024 + g * 128 + c0) = w; } }
        __syncthreads();
    }
}

__device__ void mixer_phase(const Params& P, int layer, LAS unsigned char* lds) {
    unsigned* qc = (unsigned*)(P.ws + WS_TAB) + TB_Q + layer;
    LAS unsigned* slot = (LAS unsigned*)(lds + LDS_BYTES - 16);
    for (;;) {
        __syncthreads();
        if (threadIdx.x == 0) *slot = atomicAdd(qc, 1u);
        __syncthreads();
        const int item = (int)*slot;
        if (item >= 128 + 512 + 256) break;
        if (item < 128) { const int st = item >> 2; gla_stream(P, layer, 1 - (st >> 4), (st >> 2) & 3, st & 3, item & 3, lds); }
        else if (item < 640) { const int a = item - 128, bh = a >> 5, pr = a & 31;
            for (int u2 = 0; u2 < 2; ++u2) attn_unit(P, layer, bh >> 2, bh & 3, u2 ? pr : 63 - pr, lds); }
        else { const int c = item - 640; gmlp_unit(P, layer, c >> 6, c & 63, lds); }
    }
}

__device__ __forceinline__ void grid_barrier(unsigned* ctr, unsigned nbar) {
    asm volatile("s_waitcnt vmcnt(0)" ::: "memory");
    __syncthreads();
    if (threadIdx.x == 0) {
        __builtin_amdgcn_fence(__ATOMIC_RELEASE, "agent");
        asm volatile("s_waitcnt vmcnt(0)" ::: "memory");
        const unsigned gsz = gridDim.x >> 3;
        unsigned* gc = ctr + (blockIdx.x & 7u) * 32u; unsigned* glob = ctr + 8u * 32u;
        const unsigned old = __hip_atomic_fetch_add(gc, 1u, __ATOMIC_RELAXED, __HIP_MEMORY_SCOPE_AGENT);
        if (old + 1u == nbar * gsz) __hip_atomic_fetch_add(glob, 1u, __ATOMIC_RELAXED, __HIP_MEMORY_SCOPE_AGENT);
        while (__hip_atomic_load(glob, __ATOMIC_RELAXED, __HIP_MEMORY_SCOPE_AGENT) < nbar * 8u) __builtin_amdgcn_s_sleep(1);
        __builtin_amdgcn_fence(__ATOMIC_ACQUIRE, "agent");
        asm volatile("s_waitcnt vmcnt(0)" ::: "memory");
    }
    __syncthreads();
}

template <class Epi> __device__ __forceinline__ void run_gemm(LAS unsigned char* lds, const bf16_t* A, const bf16_t* Bt, int N, int K, const Epi& E) {
    pg8::Gemm g; g.A = A; g.Bt = Bt; g.M = MTOK; g.N = N; g.K = K;
    pg8::StaticOrder S; S.init(MTOK, N, (int)gridDim.x, opaque_bid());
    pg8::gemm_phase<Epi>(lds, g, S, E);
}

typedef const __attribute__((address_space(4))) Params* KParamsPtr;
__global__ __launch_bounds__(512, 2) void fwd_megakernel(const Params Pin) {
    extern __shared__ __attribute__((aligned(16))) unsigned char shm[];
    LAS unsigned char* lds = (LAS unsigned char*)shm;
    cg::grid_group grid = cg::this_grid();
    const KParamsPtr kp = (KParamsPtr)__builtin_amdgcn_kernarg_segment_ptr();
    unsigned nbar = 0u;
    for (int ph = Pin.ph_lo; ph < Pin.ph_hi; ++ph) {
        if (Pin.ph_lo < 0) grid.sync();
        if (ph > Pin.ph_lo) { nbar += 1u; grid_barrier((unsigned*)(Pin.ws + WS_TAB) + 8000, nbar); }
        KParamsPtr kq = kp; asm volatile("" : "+s"(kq));
        const Params& P = *(const Params*)kq;
        unsigned char* ws = P.ws;
        float* X = P.out;
        bf16_t* Xb = (bf16_t*)(ws + WS_XB);
        bf16_t* Hb = (bf16_t*)(ws + WS_H);
        if (ph == 0) { prep_phase(P, lds); continue; }
        const int L = (ph - 1) / 13, s = (ph - 1) % 13;
        { const int lnk = (s == 2) ? 0 : (s == 7) ? 1 : (s == 10) ? 2 : (s == 12) ? 3 : -1;
          if (lnk >= 0) { ln_phase(X, P.ln_g + (L * 4 + lnk) * DM, P.ln_b + (L * 4 + lnk) * DM, Xb, lnk == 0 || (lnk == 3 && L == DEPTH - 1)); continue; } }
        switch (s) {
        case 0: { EpiSwiGLU E; E.H = Hb; run_gemm(lds, Xb, (const bf16_t*)(ws + WS_W1IN + L * SZ_W1IN), 2 * DFF, DM, E); } break;
        case 1: { EpiRes E; E.res = (L == 0) ? P.x : nullptr; E.resb = Xb; E.out = X; E.scale = 0.5f; run_gemm(lds, Hb, (const bf16_t*)(ws + WS_W1OUT + L * SZ_W1OUT), DM, DFF, E); } break;
        case 3: { EpiMixIn E; E.Hm = Hb; E.cs = (const f32x2*)(ws + WS_CS); E.loglb = (const float*)(ws + WS_TAB) + TB_LOGLB + L * 512;
                  run_gemm(lds, Xb, (const bf16_t*)(ws + WS_WMI + L * SZ_WMI), INC, DM, E); } break;
        case 4: mixer_phase(P, L, lds); break;
        case 5: gla_post_phase(P, L); break;
        case 6: { EpiRes E; E.res = X; E.resb = nullptr; E.out = X; E.scale = 1.0f; run_gemm(lds, Xb, (const bf16_t*)(ws + WS_WMO + L * SZ_WMO), DM, DM, E); } break;
        case 8: { EpiSwiGLU E; E.H = Hb; run_gemm(lds, Xb, (const bf16_t*)(ws + WS_W2IN + L * SZ_W1IN), 2 * DFF, DM, E); } break;
        case 9: { EpiRes E; E.res = nullptr; E.resb = Xb; E.out = X; E.scale = 0.5f; run_gemm(lds, Hb, (const bf16_t*)(ws + WS_W2OUT + L * SZ_W1OUT), DM, DFF, E); } break;
        case 11: { EpiPE E1; E1.pe = (float*)(ws + WS_H); run_gemm(lds, (const bf16_t*)(ws + WS_PB) + (size_t)L * MTOK * PLE, (const bf16_t*)(ws + WS_WE + L * SZ_WE), DM, PLE, E1);
                   EpiGate E2; E2.X = X; E2.pe = (const float*)(ws + WS_H); E2.xb = Xb; run_gemm(lds, Xb, (const bf16_t*)(ws + WS_WG + L * SZ_WG), DM, DM, E2); } break;
        }
    }
}

extern "C" void kernel_launch(void* const* d_in, const int* in_sizes, int n_in, void* d_out, int out_size, void* d_ws, size_t ws_size, hipStream_t stream) {
    static int grid = 0;
    if (grid == 0) {
        if (n_in != 22 || out_size != MTOK * DM || ws_size < WS_END) { fprintf(stderr, "kernel_launch: unexpected shapes (n_in %d out %d ws %zu need %zu)\n", n_in, out_size, ws_size, (size_t)WS_END); grid = -1; return; }
        int dev = 0, cus = 0, per_cu = 0;
        (void)hipGetDevice(&dev); (void)hipDeviceGetAttribute(&cus, hipDeviceAttributeMultiprocessorCount, dev);
        if (hipFuncSetAttribute((const void*)fwd_megakernel, hipFuncAttributeMaxDynamicSharedMemorySize, LDS_BYTES) != hipSuccess) { fprintf(stderr, "kernel_launch: hipFuncSetAttribute failed\n"); grid = -1; return; }
        if (hipOccupancyMaxActiveBlocksPerMultiprocessor(&per_cu, (const void*)fwd_megakernel, 512, LDS_BYTES) != hipSuccess || per_cu < 1) { fprintf(stderr, "kernel_launch: occupancy query says %d\n", per_cu); per_cu = 1; }
        (void)hipGetLastError();
        grid = cus & ~7;
    }
    if (grid < 0) return;
    Params p; memset(&p, 0, sizeof(p));
    p.x = (const float*)d_in[0]; p.p = (const float*)d_in[1]; p.pos = (const int*)d_in[2];
    p.ffn1_in = (const float*)d_in[3]; p.ffn1_out = (const float*)d_in[4]; p.mix_in = (const float*)d_in[5]; p.mix_out = (const float*)d_in[6];
    p.rel_bias = (const float*)d_in[7]; p.dlam = (const float*)d_in[8]; p.dnorm_g = (const float*)d_in[9]; p.g_ln_g = (const float*)d_in[10]; p.g_ln_b = (const float*)d_in[11];
    p.g_ws = (const float*)d_in[12]; p.g_bs = (const float*)d_in[13]; p.lb_logits = (const float*)d_in[14]; p.hg_norm_g = (const float*)d_in[15];
    p.ffn2_in = (const float*)d_in[16]; p.ffn2_out = (const float*)d_in[17]; p.ple_gate = (const float*)d_in[18]; p.ple_proj = (const float*)d_in[19];
    p.ln_g = (const float*)d_in[20]; p.ln_b = (const float*)d_in[21];
    p.out = (float*)d_out; p.ws = (unsigned char*)d_ws;
    p.ph_lo = 0; p.ph_hi = NPH;
    for (int i = 0; i < 64; ++i) p.inv[i] = pow(10000.0, -(double)i / 63.0);
    (void)hipMemsetAsync((unsigned char*)d_ws + WS_TAB + 32000, 0, 9 * 128, stream);
    void* args[] = {&p};
    hipError_t e = hipLaunchCooperativeKernel((const void*)fwd_megakernel, dim3(grid), dim3(512), args, LDS_BYTES, stream);
    if (e != hipSuccess) fprintf(stderr, "kernel_launch: cooperative launch failed: %s (grid %d)\n", hipGetErrorString(e), grid);
}
```

```cpp
#include <hip/hip_runtime.h>
#include <hip/hip_cooperative_groups.h>
#include <math.h>
#include <stdio.h>
#include <string.h>
namespace cg = cooperative_groups;

#define LAS __attribute__((address_space(3)))
typedef unsigned short bf16_t;
typedef short bf16x8 __attribute__((ext_vector_type(8)));
typedef short s16x4 __attribute__((ext_vector_type(4)));
typedef float f32x2 __attribute__((ext_vector_type(2)));
typedef float f32x4 __attribute__((ext_vector_type(4)));
typedef float f32x16 __attribute__((ext_vector_type(16)));
typedef unsigned u32x2 __attribute__((ext_vector_type(2)));
typedef unsigned u32x4 __attribute__((ext_vector_type(4)));

constexpr int MTOK = 32768, SEQ = 8192, DM = 2048, DFF = 5632, INC = 6656, PLE = 256, DEPTH = 2;
constexpr float ALPHA = 1.41421356237f;
constexpr float LOG2E = 1.44269504089f;
constexpr int LDS_BYTES = 147456;
constexpr int NPH = 1 + 13 * DEPTH;

constexpr size_t SZ_W1IN = (size_t)2 * DFF * DM * 2, SZ_W1OUT = (size_t)DM * DFF * 2, SZ_WMI = (size_t)INC * DM * 2, SZ_WMO = (size_t)DM * DM * 2,
                 SZ_WG = (size_t)DM * DM * 2, SZ_WE = (size_t)DM * PLE * 2;
constexpr size_t WS_W1IN = 0, WS_W1OUT = WS_W1IN + DEPTH * SZ_W1IN, WS_WMI = WS_W1OUT + DEPTH * SZ_W1OUT, WS_WMO = WS_WMI + DEPTH * SZ_WMI,
                 WS_W2IN = WS_WMO + DEPTH * SZ_WMO, WS_W2OUT = WS_W2IN + DEPTH * SZ_W1IN, WS_WG = WS_W2OUT + DEPTH * SZ_W1OUT, WS_WE = WS_WG + DEPTH * SZ_WG,
                 WS_H = WS_WE + DEPTH * SZ_WE, WS_XB = WS_H + (size_t)MTOK * INC * 2, WS_PB = WS_XB + (size_t)MTOK * DM * 2,
                 WS_CS = WS_PB + (size_t)DEPTH * MTOK * PLE * 2, WS_SSQ = WS_CS + (size_t)MTOK * 64 * 8, WS_TAB = WS_SSQ + (size_t)MTOK * 4 * 4,
                 WS_STAT = WS_TAB + 65536, WS_END = WS_STAT + (size_t)2 * MTOK * 4 * 8 * 2 * 4;
constexpr int TB_LOGLB = 0  , TB_LUT = 1024  , TB_LAM = 1600  , TB_PMAX = 1664  , TB_Q = 2304  ;

struct Params {
    const float* x; const float* p; const int* pos;
    const float *ffn1_in, *ffn1_out, *mix_in, *mix_out, *rel_bias, *dlam, *dnorm_g, *g_ln_g, *g_ln_b, *g_ws, *g_bs, *lb_logits, *hg_norm_g,
        *ffn2_in, *ffn2_out, *ple_gate, *ple_proj, *ln_g, *ln_b;
    float* out; unsigned char* ws;
    int ph_lo, ph_hi;
    double inv[64];
};

__device__ __forceinline__ unsigned cvt_pk_bf16(float lo, float hi) { unsigned r; asm("v_cvt_pk_bf16_f32 %0, %1, %2" : "=v"(r) : "v"(lo), "v"(hi)); return r; }
__device__ __forceinline__ float bf_lo(unsigned w) { return __uint_as_float(w << 16); }
__device__ __forceinline__ float bf_hi(unsigned w) { return __uint_as_float(w & 0xffff0000u); }
__device__ __forceinline__ unsigned off_b(unsigned row, unsigned ch) { return 256u * row + 16u * (ch ^ (((row & 3u) << 2) | ((row >> 2) & 3u))); }
__device__ __forceinline__ s16x4 tr_read(LAS const unsigned char* img, unsigned lane, unsigned rowbase, unsigned c) {
    const unsigned blk = (lane >> 4) & 1u, qq = (lane & 15u) >> 2, p = lane & 3u;
    return __builtin_amdgcn_ds_read_tr16_b64_v4i16((LAS s16x4*)(img + off_b(rowbase + qq, 4u * c + 2u * blk + (p >> 1)) + 8u * (p & 1u)));
}
__device__ __forceinline__ bf16x8 cat8(s16x4 a, s16x4 b) { bf16x8 r; r[0] = a[0]; r[1] = a[1]; r[2] = a[2]; r[3] = a[3]; r[4] = b[0]; r[5] = b[1]; r[6] = b[2]; r[7] = b[3]; return r; }
__device__ __forceinline__ bf16x8 pack8(float a0, float a1, float a2, float a3, float a4, float a5, float a6, float a7) {
    u32x4 w; w.x = cvt_pk_bf16(a0, a1); w.y = cvt_pk_bf16(a2, a3); w.z = cvt_pk_bf16(a4, a5); w.w = cvt_pk_bf16(a6, a7);
    return __builtin_bit_cast(bf16x8, w);
}
__device__ __forceinline__ f32x16 mfma32(bf16x8 a, bf16x8 b, f32x16 c) { return __builtin_amdgcn_mfma_f32_32x32x16_bf16(a, b, c, 0, 0, 0); }
__device__ __forceinline__ float silu_f(float v) { return v * __builtin_amdgcn_rcpf(1.0f + __expf(-v)); }
__device__ __forceinline__ float shx(float v, int off, int lane) { return __int_as_float(__builtin_amdgcn_ds_bpermute((lane ^ off) << 2, __float_as_int(v))); }
__device__ __forceinline__ int shxi(int v, int off, int lane) { return __builtin_amdgcn_ds_bpermute((lane ^ off) << 2, v); }
__device__ __forceinline__ float swapadd16(float a, float b) { auto r = __builtin_amdgcn_permlane16_swap(__float_as_uint(a), __float_as_uint(b), false, false); return __uint_as_float(r[0]) + __uint_as_float(r[1]); }
__device__ __forceinline__ float swapadd32(float a, float b) { auto r = __builtin_amdgcn_permlane32_swap(__float_as_uint(a), __float_as_uint(b), false, false); return __uint_as_float(r[0]) + __uint_as_float(r[1]); }
__device__ __forceinline__ int opaque_tid() { int t = threadIdx.x; asm volatile("" : "+v"(t)); return t; }
__device__ __forceinline__ int opaque_bid() { int t = blockIdx.x; asm volatile("" : "+s"(t)); return t; }
__device__ __forceinline__ f32x16 zero16() { f32x16 z; for (int i = 0; i < 16; ++i) z[i] = 0.f; return z; }

namespace pg8 {
constexpr int BM = 256, BK = 64, HALF = 128, HTB = HALF * BK * 2, STAGE_BYTES = 8 * HTB, NXCD = 8, WGM = 4;
__device__ __forceinline__ int lds_byte(int r, int c) { const int st = (r >> 4) * 2 + (c >> 5), rr = r & 15, cc = c & 31, ob = rr * 64 + cc * 2; return st * 1024 + (ob ^ (((ob >> 9) & 1) << 5)); }
__device__ __forceinline__ void stage_rc(int b, int& R, int& C) { const int st = b / 1024, sb = b % 1024, swz = sb ^ (((sb >> 9) & 1) << 5); R = (st >> 1) * 16 + swz / 64; C = (st & 1) * 32 + (swz % 64) / 2; }
__device__ __forceinline__ int perm32(int rho) { const int n = rho >> 4, i = rho & 15; return 8 * (i >> 2) + 4 * n + (i & 3); }
struct Unit { int pm, pn; };
struct Gemm { const bf16_t* A; const bf16_t* Bt; int M, N, K; };
struct StaticOrder {
    int nM, nN, nwg, G, c;
    __device__ void init(int M, int N, int G_, int c_) { nM = M / BM; nN = N / BM; nwg = nM * nN; G = G_; c = c_; }
    __device__ bool next(int i, Unit& u) const {
        const long L = (long)i * G + c; if (L >= nwg) return false;
        int wgid = (int)L; { const int q = nwg / NXCD, r = nwg % NXCD, xcd = wgid % NXCD, off = wgid / NXCD; wgid = (xcd < r ? xcd * (q + 1) : r * (q + 1) + (xcd - r) * q) + off; }
        const int nig = WGM * nN, gid = wgid / nig, fm = gid * WGM, gsz = (nM - fm) < WGM ? (nM - fm) : WGM;
        u.pm = fm + ((wgid % nig) % gsz); u.pn = (wgid % nig) / gsz; return true;
    }
};
template <class Epi>
__device__ __forceinline__ void gemm_phase(LAS unsigned char* lds, const Gemm g, const StaticOrder& S, const Epi& E) {
    const int tid = opaque_tid(), wid = __builtin_amdgcn_readfirstlane(tid >> 6), lane = tid & 63, wr = wid >> 2, wc = wid & 3, fr = lane & 15, fq = lane >> 4;
    const int K = g.K, nt = K / BK;
    unsigned voffA[2], voffB[2];
#pragma unroll
    for (int i = 0; i < 2; ++i) { int R, C; stage_rc(tid * 16 + i * 8192, R, C); const int Rb = Epi::PERM ? ((R & ~31) + perm32(R & 31)) : R;
        voffA[i] = (unsigned)(R * K + C) * 2u; voffB[i] = (unsigned)(Rb * K + C) * 2u; }
    const size_t kstep = (size_t)(BK * 2), hstep = (size_t)HALF * K * 2, tstep = 2 * hstep;
    const unsigned ldsw = (unsigned)wid * 1024u;
    const int aoff = lds_byte(wr * 64 + fr, fq * 8), boff = lds_byte(wc * 32 + fr, fq * 8);
#define PG8_SA(b, h) (((b) * 2 + (h)) * HTB)
#define PG8_SB(b, h) ((4 + (b) * 2 + (h)) * HTB)
#define PG8_STAGE(bufoff, gbase, voff) do { _Pragma("unroll") for (int _i = 0; _i < 2; ++_i) \
        __builtin_amdgcn_global_load_lds((const unsigned*)((const char*)(gbase) + (voff)[_i]), (LAS unsigned*)(lds + (bufoff) + ldsw + _i * 8192), 16, 0, 0); } while (0)
#define PG8_LDA(dst, b, h) do { _Pragma("unroll") for (int m = 0; m < 4; ++m) _Pragma("unroll") for (int k = 0; k < 2; ++k) dst[m][k] = *(const LAS bf16x8*)(lds + PG8_SA(b, h) + aoff + m * 2048 + k * 1024); } while (0)
#define PG8_LDB(dst, b, h) do { _Pragma("unroll") for (int n = 0; n < 2; ++n) _Pragma("unroll") for (int k = 0; k < 2; ++k) dst[n][k] = *(const LAS bf16x8*)(lds + PG8_SB(b, h) + boff + n * 2048 + k * 1024); } while (0)
#define PG8_MMA(ai, bj, At, Bt) do { __builtin_amdgcn_s_setprio(1); _Pragma("unroll") for (int m = 0; m < 4; ++m) _Pragma("unroll") for (int n = 0; n < 2; ++n) _Pragma("unroll") for (int k = 0; k < 2; ++k) \
        acc[ai][bj][m][n] = __builtin_amdgcn_mfma_f32_16x16x32_bf16(Bt[n][k], At[m][k], acc[ai][bj][m][n], 0, 0, 0); __builtin_amdgcn_s_setprio(0); } while (0)
#define PG8_WAIT_V(n) asm volatile("s_waitcnt vmcnt(" #n ")" ::: "memory")
#define PG8_WAIT_L(n) asm volatile("s_waitcnt lgkmcnt(" #n ")" ::: "memory")
#define PG8_BAR __builtin_amdgcn_s_barrier()
#define PG8_SCHED __builtin_amdgcn_sched_barrier(0)
    Unit cur, nxt; int ui = 0;
    if (!S.next(0, cur)) return;
    f32x4 acc[2][2][4][2];
#pragma unroll
    for (int a = 0; a < 2; ++a)
#pragma unroll
        for (int b = 0; b < 2; ++b)
#pragma unroll
            for (int m = 0; m < 4; ++m)
#pragma unroll
                for (int n = 0; n < 2; ++n) acc[a][b][m][n] = (f32x4){0.f, 0.f, 0.f, 0.f};
    bf16x8 At[4][2], B0[2][2], B1[2][2];
    const char* cA = (const char*)g.A + (size_t)cur.pm * tstep; const char* cB = (const char*)g.Bt + (size_t)cur.pn * tstep;
    PG8_STAGE(PG8_SB(0, 0), cB, voffB); PG8_STAGE(PG8_SA(0, 0), cA, voffA); PG8_STAGE(PG8_SB(0, 1), cB + hstep, voffB); PG8_STAGE(PG8_SA(0, 1), cA + hstep, voffA);
    if (wr == 1) PG8_BAR;
    PG8_WAIT_V(4); PG8_BAR;
    PG8_STAGE(PG8_SB(1, 0), cB + kstep, voffB); PG8_STAGE(PG8_SA(1, 0), cA + kstep, voffA); PG8_STAGE(PG8_SB(1, 1), cB + hstep + kstep, voffB);
    PG8_WAIT_V(6); PG8_BAR;
    for (;;) {
        const bool has_next = S.next(ui + 1, nxt);
        const char* nA = has_next ? (const char*)g.A + (size_t)nxt.pm * tstep : cA; const char* nB = has_next ? (const char*)g.Bt + (size_t)nxt.pn * tstep : cB;
        for (int t = 0; t < nt; t += 2) {
            const bool last = (t == nt - 2);
            const char* a1 = cA + (size_t)(t + 1) * kstep;
            const char* a2 = last ? nA : cA + (size_t)(t + 2) * kstep; const char* b2 = last ? nB : cB + (size_t)(t + 2) * kstep;
            const char* a3 = a2 + kstep; const char* b3 = b2 + kstep;
            PG8_LDB(B0, 0, 0); PG8_SCHED; PG8_LDA(At, 0, 0); PG8_STAGE(PG8_SA(1, 1), a1 + hstep, voffA);
            PG8_WAIT_L(8); PG8_BAR; PG8_WAIT_L(0); PG8_MMA(0, 0, At, B0); PG8_BAR; PG8_SCHED;
            PG8_LDB(B1, 0, 1); PG8_STAGE(PG8_SB(0, 0), b2, voffB);
            PG8_BAR; PG8_WAIT_L(0); PG8_MMA(0, 1, At, B1); PG8_BAR;
            PG8_LDA(At, 0, 1); PG8_STAGE(PG8_SA(0, 0), a2, voffA);
            PG8_BAR; PG8_WAIT_L(0); PG8_MMA(1, 0, At, B0); PG8_BAR; PG8_SCHED;
            PG8_STAGE(PG8_SB(0, 1), b2 + hstep, voffB);
            PG8_WAIT_V(6); PG8_BAR; PG8_MMA(1, 1, At, B1); PG8_BAR;
            PG8_LDB(B0, 1, 0); PG8_SCHED; PG8_LDA(At, 1, 0); PG8_STAGE(PG8_SA(0, 1), a2 + hstep, voffA);
            PG8_WAIT_L(8); PG8_BAR; PG8_WAIT_L(0); PG8_MMA(0, 0, At, B0); PG8_BAR; PG8_SCHED;
            PG8_LDB(B1, 1, 1); PG8_STAGE(PG8_SB(1, 0), b3, voffB);
            PG8_BAR; PG8_WAIT_L(0); PG8_MMA(0, 1, At, B1); PG8_BAR;
            PG8_LDA(At, 1, 1); PG8_STAGE(PG8_SA(1, 0), a3, voffA);
            PG8_BAR; PG8_WAIT_L(0); PG8_MMA(1, 0, At, B0); PG8_BAR; PG8_SCHED;
            PG8_STAGE(PG8_SB(1, 1), b3 + hstep, voffB);
            PG8_WAIT_V(6); PG8_BAR; PG8_MMA(1, 1, At, B1); PG8_BAR;
        }
        E(acc, cur, wr, wc, fr, fq);
        if (!has_next) break;
#pragma unroll
        for (int a = 0; a < 2; ++a)
#pragma unroll
            for (int b = 0; b < 2; ++b)
#pragma unroll
                for (int m = 0; m < 4; ++m)
#pragma unroll
                    for (int n = 0; n < 2; ++n) acc[a][b][m][n] = (f32x4){0.f, 0.f, 0.f, 0.f};
        cur = nxt; cA = nA; cB = nB; ++ui;
    }
    PG8_WAIT_V(0);
    if (wr == 0) PG8_BAR;
    PG8_BAR;
#undef PG8_SA
#undef PG8_SB
#undef PG8_STAGE
#undef PG8_LDA
#undef PG8_LDB
#undef PG8_MMA
#undef PG8_WAIT_V
#undef PG8_WAIT_L
#undef PG8_BAR
#undef PG8_SCHED
}
}
using pg8::Unit; using pg8::BM; using pg8::HALF;
typedef f32x4 Acc[2][2][4][2];

__device__ __forceinline__ float gelu_f(float v) {
    const float av = fabsf(v), t = __builtin_amdgcn_rcpf(av * 0.2316418882f + 1.0f);
    float q = t * 0.5307027145f + (-0.7265760135f); q = q * t + 0.7107068705f; q = q * t + (-0.142248368f); q = q * t + 0.127414796f; q = q * t;
    const float e = __builtin_amdgcn_exp2f((v * v) * (-0.72134752044f));
    const float m = v * (q * e);
    return v < 0.f ? m : v - m;
}

struct EpiSwiGLU {
    static constexpr bool PERM = true;
    bf16_t* H;
    __device__ __forceinline__ void operator()(const Acc& acc, const Unit& u, int wr, int wc, int fr, int fq) const {
        const int row0 = u.pm * BM + wr * 64 + fr, col0 = u.pn * 128 + wc * 32 + 8 * fq;
#pragma unroll
        for (int ai = 0; ai < 2; ++ai)
#pragma unroll
            for (int m = 0; m < 4; ++m) {
                float h[8];
#pragma unroll
                for (int n = 0; n < 2; ++n)
#pragma unroll
                    for (int j = 0; j < 4; ++j) h[4 * n + j] = silu_f(acc[ai][0][m][n][j]) * acc[ai][1][m][n][j];
                u32x4 w; w.x = cvt_pk_bf16(h[0], h[1]); w.y = cvt_pk_bf16(h[2], h[3]); w.z = cvt_pk_bf16(h[4], h[5]); w.w = cvt_pk_bf16(h[6], h[7]);
                *(u32x4*)(H + (size_t)(row0 + ai * HALF + m * 16) * DFF + col0) = w;
            }
    }
};
struct EpiRes {
    static constexpr bool PERM = false;
    const float* res; const bf16_t* resb; float* out; float scale;
    __device__ __forceinline__ void operator()(const Acc& acc, const Unit& u, int wr, int wc, int fr, int fq) const {
        const int row0 = u.pm * BM + wr * 64 + fr, col0 = u.pn * BM + wc * 32 + 4 * fq;
#pragma unroll
        for (int ai = 0; ai < 2; ++ai)
#pragma unroll
            for (int m = 0; m < 4; ++m) { const size_t ro = (size_t)(row0 + ai * HALF + m * 16) * DM + col0;
#pragma unroll
                for (int bj = 0; bj < 2; ++bj)
#pragma unroll
                    for (int n = 0; n < 2; ++n) { f32x4 r;
                        if (res) r = *(const f32x4*)(res + ro + bj * HALF + n * 16);
                        else { const u32x2 w = *(const u32x2*)(resb + ro + bj * HALF + n * 16); r = (f32x4){bf_lo(w.x), bf_hi(w.x), bf_lo(w.y), bf_hi(w.y)}; }
                        *(f32x4*)(out + ro + bj * HALF + n * 16) = r * ALPHA + acc[ai][bj][m][n] * scale; } }
    }
};
struct EpiPE {
    static constexpr bool PERM = false;
    float* pe;
    __device__ __forceinline__ void operator()(const Acc& acc, const Unit& u, int wr, int wc, int fr, int fq) const {
        const int row0 = u.pm * BM + wr * 64 + fr, col0 = u.pn * BM + wc * 32 + 4 * fq;
#pragma unroll
        for (int ai = 0; ai < 2; ++ai)
#pragma unroll
            for (int m = 0; m < 4; ++m) { const size_t ro = (size_t)(row0 + ai * HALF + m * 16) * DM + col0;
#pragma unroll
                for (int bj = 0; bj < 2; ++bj)
#pragma unroll
                    for (int n = 0; n < 2; ++n) *(f32x4*)(pe + ro + bj * HALF + n * 16) = acc[ai][bj][m][n]; }
    }
};
struct EpiGate {
    static constexpr bool PERM = false;
    float* X; const float* pe; const bf16_t* xb;
    __device__ __forceinline__ void operator()(const Acc& acc, const Unit& u, int wr, int wc, int fr, int fq) const {
        const int row0 = u.pm * BM + wr * 64 + fr, col0 = u.pn * BM + wc * 32 + 4 * fq;
#pragma unroll
        for (int ai = 0; ai < 2; ++ai)
#pragma unroll
            for (int m = 0; m < 4; ++m) { const size_t ro = (size_t)(row0 + ai * HALF + m * 16) * DM + col0;
#pragma unroll
                for (int bj = 0; bj < 2; ++bj)
#pragma unroll
                    for (int n = 0; n < 2; ++n) { const u32x2 w = *(const u32x2*)(xb + ro + bj * HALF + n * 16); const f32x4 r = (f32x4){bf_lo(w.x), bf_hi(w.x), bf_lo(w.y), bf_hi(w.y)}; const f32x4 pv = *(const f32x4*)(pe + ro + bj * HALF + n * 16);
                        f32x4 o;
#pragma unroll
                        for (int j = 0; j < 4; ++j) o[j] = r[j] * ALPHA + pv[j] * __builtin_amdgcn_rcpf(1.0f + __expf(-acc[ai][bj][m][n][j]));
                        *(f32x4*)(X + ro + bj * HALF + n * 16) = o; } }
    }
};
struct EpiMixIn {
    static constexpr bool PERM = true;
    bf16_t* Hm; const f32x2* cs; const float* loglb;
    __device__ __forceinline__ void operator()(const Acc& acc, const Unit& u, int wr, int wc, int fr, int fq) const {
        const int row0 = u.pm * BM + wr * 64 + fr;
        const int pn = u.pn;
        const int mode = (pn == 6 || pn == 7) ? 1 : (pn == 8 || pn == 9) ? 2 : (pn >= 14 && pn <= 17) ? 3 : (pn == 20 || pn == 21) ? 4 : 0;
#pragma unroll
        for (int ai = 0; ai < 2; ++ai)
#pragma unroll
            for (int m = 0; m < 4; ++m) {
                const int row = row0 + ai * HALF + m * 16;
#pragma unroll
                for (int bj = 0; bj < 2; ++bj) {
                    const int col = pn * BM + bj * HALF + wc * 32 + 8 * fq;
                    float v[8];
#pragma unroll
                    for (int n = 0; n < 2; ++n)
#pragma unroll
                        for (int j = 0; j < 4; ++j) v[4 * n + j] = acc[ai][bj][m][n][j];
                    if (mode == 1 || mode == 2) {
                        const int i0 = (col & 127) >> 1;
                        const f32x4 c01 = *(const f32x4*)(cs + (size_t)row * 64 + i0), c23 = *(const f32x4*)(cs + (size_t)row * 64 + i0 + 2);
                        const float sc = (mode == 2) ? 0.08838834764831845f : 1.0f;
                        const float cc[4] = {c01[0], c01[2], c23[0], c23[2]}, ss[4] = {c01[1], c01[3], c23[1], c23[3]};
#pragma unroll
                        for (int q = 0; q < 4; ++q) { const float x1 = v[2 * q], x2 = v[2 * q + 1]; v[2 * q] = (x1 * cc[q] - x2 * ss[q]) * sc; v[2 * q + 1] = (x1 * ss[q] + x2 * cc[q]) * sc; }
                    } else if (mode == 3) {
#pragma unroll
                        for (int q = 0; q < 8; ++q) v[q] = gelu_f(v[q]);
                    } else if (mode == 4) {
                        const int k0 = col - 5120;
                        const f32x4 l0 = *(const f32x4*)(loglb + k0), l1 = *(const f32x4*)(loglb + k0 + 4);
#pragma unroll
                        for (int q = 0; q < 8; ++q) { const float z = v[q], llb = q < 4 ? l0[q] : l1[q - 4];
                            const float az = fabsf(z), sp = __logf(1.0f + __expf(-az));
                            const float lsp = fminf(z, 0.f) - sp, lsn = fminf(-z, 0.f) - sp;
                            const float a = lsp, b = llb + lsn, mx = fmaxf(a, b), mn = fminf(a, b);
                            v[q] = mx + __logf(1.0f + __expf(mn - mx)); }
                    }
                    u32x4 w; w.x = cvt_pk_bf16(v[0], v[1]); w.y = cvt_pk_bf16(v[2], v[3]); w.z = cvt_pk_bf16(v[4], v[5]); w.w = cvt_pk_bf16(v[6], v[7]);
                    *(u32x4*)(Hm + (size_t)row * INC + col) = w;
                }
            }
    }
};

__device__ void conv_wT(const float* __restrict__ src, bf16_t* __restrict__ dst, int K, int N, int swiglu, LAS unsigned char* lds) {
    const int tid = opaque_tid(), bid = opaque_bid(), tilesN = N / 64, tilesK = K / 64, total = tilesN * tilesK;
    LAS bf16_t* t16 = (LAS bf16_t*)lds;
    for (int tile = bid; tile < total; tile += gridDim.x) {
        const int tn = tile % tilesN, tk = tile / tilesN;
        const int r = tid >> 4, c4 = (tid & 15) * 4;
#pragma unroll
        for (int p = 0; p < 2; ++p) {
            const f32x4 v = *(const f32x4*)(src + (size_t)(tk * 64 + r + 32 * p) * N + tn * 64 + c4);
#pragma unroll
            for (int j = 0; j < 4; ++j) t16[(c4 + j) * 72 + r + 32 * p] = (bf16_t)(cvt_pk_bf16(v[j], 0.f) & 0xffffu);
        }
        __syncthreads();
        const int n = tid >> 3, k8 = (tid & 7) * 8;
        const u32x4 w = *(const LAS u32x4*)(lds + n * 144 + k8 * 2);
        int nsrc = tn * 64 + n, ndst = nsrc;
        if (swiglu) { const int bj = nsrc >= DFF ? 1 : 0, hid = nsrc - DFF * bj; ndst = 256 * (hid >> 7) + 128 * bj + (hid & 127); }
        *(u32x4*)(dst + (size_t)ndst * K + tk * 64 + k8) = w;
        __syncthreads();
    }
}
__device__ void conv_flat(const float* __restrict__ src, bf16_t* __restrict__ dst, size_t n) {
    const size_t stride = (size_t)gridDim.x * 512 * 8;
    for (size_t i = ((size_t)opaque_bid() * 512 + opaque_tid()) * 8; i < n; i += stride) {
        const f32x4 a = *(const f32x4*)(src + i), b = *(const f32x4*)(src + i + 4);
        u32x4 w; w.x = cvt_pk_bf16(a[0], a[1]); w.y = cvt_pk_bf16(a[2], a[3]); w.z = cvt_pk_bf16(b[0], b[1]); w.w = cvt_pk_bf16(b[2], b[3]);
        *(u32x4*)(dst + i) = w;
    }
}
__device__ void prep_phase(const Params& P, LAS unsigned char* lds) {
    unsigned char* ws = P.ws;
    const int tid = opaque_tid(), bid = opaque_bid();
    float* tabf = (float*)(ws + WS_TAB); int* tabi = (int*)(ws + WS_TAB);
    if (bid == 0) {
        { const float l0 = P.lb_logits[tid], l1 = P.lb_logits[512 + tid]; const float s1 = 1.0f / (1.0f + expf(l0 - l1));
          tabf[TB_LOGLB + tid] = logf(1e-30f); tabf[TB_LOGLB + 512 + tid] = logf(fmaxf(s1, 1e-30f)); }
        for (int i2 = tid; i2 < 4 * 129; i2 += 512) { const int h = i2 / 129, n = i2 % 129; int bk;
            if (n < 16) bk = n; else { bk = 16 + (int)(logf((float)n / 16.0f) / 2.0794415416798357f * 16.0f); bk = bk > 31 ? 31 : bk; }
            tabf[TB_LUT + h * 132 + n] = P.rel_bias[bk * 4 + h] * LOG2E; }
        if (tid < DEPTH) { float s1 = 0.f, s2 = 0.f; const float* dl = P.dlam + tid * 256;
            for (int j = 0; j < 64; ++j) { s1 += dl[j] * dl[64 + j]; s2 += dl[128 + j] * dl[192 + j]; }
            const float lam_init = 0.8f - 0.6f * expf(-0.3f * (float)tid);
            tabf[TB_LAM + tid] = expf(s1) - expf(s2) + lam_init; }
        if (tid < 2) ((unsigned*)tabi)[TB_Q + tid] = 0u;
    }
    { f32x2* cs = (f32x2*)(ws + WS_CS);
      for (size_t i = (size_t)bid * 512 + tid; i < (size_t)MTOK * 64; i += (size_t)gridDim.x * 512) {
          const int tok = (int)(i >> 6), fi = (int)(i & 63);
          const double ang = (double)P.pos[tok] * P.inv[fi];
          const double rev = ang * 0.15915494309189535; const float fr = (float)(rev - rint(rev));
          cs[i] = (f32x2){__builtin_amdgcn_cosf(fr), __builtin_amdgcn_sinf(fr)};
      } }
    conv_flat(P.x, (bf16_t*)(ws + WS_XB), (size_t)MTOK * DM);
    conv_flat(P.p, (bf16_t*)(ws + WS_PB), (size_t)DEPTH * MTOK * PLE);
    for (int L = 0; L < DEPTH; ++L) {
        conv_wT(P.ffn1_in + (size_t)L * DM * 2 * DFF, (bf16_t*)(ws + WS_W1IN + L * SZ_W1IN), DM, 2 * DFF, 1, lds);
        conv_wT(P.ffn1_out + (size_t)L * DFF * DM, (bf16_t*)(ws + WS_W1OUT + L * SZ_W1OUT), DFF, DM, 0, lds);
        conv_wT(P.mix_in + (size_t)L * DM * INC, (bf16_t*)(ws + WS_WMI + L * SZ_WMI), DM, INC, 0, lds);
        conv_wT(P.mix_out + (size_t)L * DM * DM, (bf16_t*)(ws + WS_WMO + L * SZ_WMO), DM, DM, 0, lds);
        conv_wT(P.ffn2_in + (size_t)L * DM * 2 * DFF, (bf16_t*)(ws + WS_W2IN + L * SZ_W1IN), DM, 2 * DFF, 1, lds);
        conv_wT(P.ffn2_out + (size_t)L * DFF * DM, (bf16_t*)(ws + WS_W2OUT + L * SZ_W1OUT), DFF, DM, 0, lds);
        conv_wT(P.ple_gate + (size_t)L * DM * DM, (bf16_t*)(ws + WS_WG + L * SZ_WG), DM, DM, 0, lds);
        conv_wT(P.ple_proj + (size_t)L * PLE * DM, (bf16_t*)(ws + WS_WE + L * SZ_WE), PLE, DM, 0, lds);
    }
}

__device__ void ln_phase(float* X, const float* __restrict__ g, const float* __restrict__ b, bf16_t* Xb, bool write_x) {
    const int tid = opaque_tid(); const int lane = tid & 63, gw = opaque_bid() * 8 + (tid >> 6), nw = gridDim.x * 8;
    for (int row = gw; row + nw < MTOK; row += 2 * nw) {
        float* xr0 = X + (size_t)row * DM; float* xr1 = X + (size_t)(row + nw) * DM;
        bf16_t* xb0 = Xb + (size_t)row * DM; bf16_t* xb1 = Xb + (size_t)(row + nw) * DM;
        f32x4 v0[8], v1[8]; float s0 = 0.f, s1 = 0.f;
#pragma unroll
        for (int i = 0; i < 8; ++i) { v0[i] = *(const f32x4*)(xr0 + (i * 64 + lane) * 4); v1[i] = *(const f32x4*)(xr1 + (i * 64 + lane) * 4); }
#pragma unroll
        for (int i = 0; i < 8; ++i) { s0 += v0[i][0] + v0[i][1] + v0[i][2] + v0[i][3]; s1 += v1[i][0] + v1[i][1] + v1[i][2] + v1[i][3]; }
#pragma unroll
        for (int o = 32; o >= 1; o >>= 1) { s0 += shx(s0, o, lane); s1 += shx(s1, o, lane); }
        const float mu0 = s0 * (1.0f / DM), mu1 = s1 * (1.0f / DM); float q0 = 0.f, q1 = 0.f;
#pragma unroll
        for (int i = 0; i < 8; ++i)
#pragma unroll
            for (int j = 0; j < 4; ++j) { const float d0 = v0[i][j] - mu0, d1 = v1[i][j] - mu1; q0 += d0 * d0; q1 += d1 * d1; }
#pragma unroll
        for (int o = 32; o >= 1; o >>= 1) { q0 += shx(q0, o, lane); q1 += shx(q1, o, lane); }
        const float rs0 = rsqrtf(q0 * (1.0f / DM) + 1e-5f), rs1 = rsqrtf(q1 * (1.0f / DM) + 1e-5f);
#pragma unroll
        for (int i = 0; i < 8; ++i) { const int c = (i * 64 + lane) * 4; const f32x4 gg = *(const f32x4*)(g + c), bb = *(const f32x4*)(b + c); f32x4 o0, o1;
#pragma unroll
            for (int j = 0; j < 4; ++j) { o0[j] = (v0[i][j] - mu0) * rs0 * gg[j] + bb[j]; o1[j] = (v1[i][j] - mu1) * rs1 * gg[j] + bb[j]; }
            if (write_x) { *(f32x4*)(xr0 + c) = o0; *(f32x4*)(xr1 + c) = o1; }
            u32x2 w; w.x = cvt_pk_bf16(o0[0], o0[1]); w.y = cvt_pk_bf16(o0[2], o0[3]); *(u32x2*)(xb0 + c) = w;
            u32x2 w1; w1.x = cvt_pk_bf16(o1[0], o1[1]); w1.y = cvt_pk_bf16(o1[2], o1[3]); *(u32x2*)(xb1 + c) = w1; }
    }
}

__device__ void attn_unit(const Params& P, int layer, int b, int h, int qblk, LAS unsigned char* lds) {
    const int tid = opaque_tid(), wid = __builtin_amdgcn_readfirstlane(tid >> 6), lane_ = tid & 63, lane = lane_, l31 = lane & 31, hh = lane >> 5;
    const int c = wid & 1, rb = wid >> 1;
    const bf16_t* Hm = (const bf16_t*)(P.ws + WS_H);
    const float* tabf = (const float*)(P.ws + WS_TAB); const int* tabi = (const int*)(P.ws + WS_TAB);
    LAS float* lut = (LAS float*)(lds + 66048); LAS int* posk = (LAS int*)(lds + 65536); LAS int* pkmx = (LAS int*)(lds + 66576);
    const int q0w = qblk * 128 + rb * 32, qrow = q0w + l31;
    const size_t tok = (size_t)b * SEQ + qrow;
    bf16x8 qf[4];
    { const bf16_t* qp = Hm + tok * INC + h * 128 + c * 64 + 8 * hh;
#pragma unroll
      for (int ks = 0; ks < 4; ++ks) qf[ks] = *(const bf16x8*)(qp + 16 * ks); }
    const int pq = P.pos[b * SEQ + qrow];
    int pqmin = pq;
#pragma unroll
    for (int o = 16; o >= 1; o >>= 1) { const int t = shxi(pqmin, o, lane); pqmin = t < pqmin ? t : pqmin; }
    pqmin = __builtin_amdgcn_readfirstlane(pqmin);
    f32x16 O[4];
#pragma unroll
    for (int d = 0; d < 4; ++d) O[d] = zero16();
    float mrun = -1e30f, lrun = 0.f;
    const int nt = 2 * qblk + 2;
    const float sc2 = 0.125f * LOG2E;
    const int srow = (tid >> 4), sch = tid & 15;
    const bf16_t* gK = Hm + ((size_t)b * SEQ) * INC + 512 + h * 128 + sch * 8;
    const bf16_t* gV = gK + 512;
    u32x4 st[4];
    __syncthreads();
    if (tid < 129) lut[tid] = tabf[TB_LUT + h * 132 + tid];
#define ATT_LOAD(kt) do { const size_t r0 = (size_t)((kt) * 64 + srow) * INC; st[0] = *(const u32x4*)(gK + r0); st[1] = *(const u32x4*)(gK + r0 + (size_t)32 * INC); \
        st[2] = *(const u32x4*)(gV + r0); st[3] = *(const u32x4*)(gV + r0 + (size_t)32 * INC); } while (0)
#define ATT_STORE(buf, kt) do { LAS unsigned char* kb = lds + (buf) * 32768; *(LAS u32x4*)(kb + off_b(srow, sch)) = st[0]; *(LAS u32x4*)(kb + off_b(srow + 32, sch)) = st[1]; \
        *(LAS u32x4*)(kb + 16384 + off_b(srow, sch)) = st[2]; *(LAS u32x4*)(kb + 16384 + off_b(srow + 32, sch)) = st[3]; \
        if (tid < 64) { int pv_ = P.pos[b * SEQ + (kt) * 64 + tid]; posk[(buf) * 64 + tid] = pv_; _Pragma("unroll") for (int o_ = 32; o_ >= 1; o_ >>= 1) { const int t_ = shxi(pv_, o_, lane_); pv_ = t_ > pv_ ? t_ : pv_; } if (tid == 0) pkmx[buf] = pv_; } } while (0)
    ATT_LOAD(0); ATT_STORE(0, 0);
    __syncthreads();
    for (int kt = 0; kt < nt; ++kt) {
        const int buf = kt & 1, k0 = kt * 64;
        if (kt + 1 < nt) ATT_LOAD(kt + 1);
        if (k0 <= q0w + 31) {
            int lane = lane_; asm volatile("" : "+v"(lane)); const int l31 = lane & 31, hh = lane >> 5;
            LAS const unsigned char* Kimg = lds + buf * 32768; LAS const unsigned char* Vimg = Kimg + 16384;
            f32x16 S[2];
#pragma unroll
            for (int s2 = 0; s2 < 2; ++s2) { S[s2] = zero16();
#pragma unroll
                for (int ks = 0; ks < 4; ++ks) { const bf16x8 a = *(const LAS bf16x8*)(Kimg + off_b(32 * s2 + l31, 8 * c + 2 * ks + hh)); S[s2] = mfma32(a, qf[ks], S[s2]); } }
            const bool far = (pqmin - pkmx[buf]) >= 128;
            const bool needmask = (k0 + 63 > q0w);
            float mnew, rsum = 0.f;
            if (far && !needmask) {
                const float cb = lut[128];
                float mx = S[0][0];
#pragma unroll
                for (int s2 = 0; s2 < 2; ++s2)
#pragma unroll
                    for (int i = 0; i < 16; ++i) mx = fmaxf(mx, S[s2][i]);
                mx = fmaxf(mx, shx(mx, 32, lane));
                mnew = fmaxf(mrun, mx * sc2 + cb);
                const float off = cb - mnew;
#pragma unroll
                for (int s2 = 0; s2 < 2; ++s2)
#pragma unroll
                    for (int i = 0; i < 16; ++i) { const float pe = __builtin_amdgcn_exp2f(S[s2][i] * sc2 + off); S[s2][i] = pe; rsum += pe; }
            } else {
                if (far) { const float cb = lut[128];
#pragma unroll
                    for (int s2 = 0; s2 < 2; ++s2)
#pragma unroll
                        for (int i = 0; i < 16; ++i) S[s2][i] = S[s2][i] * sc2 + cb;
                } else {
#pragma unroll
                    for (int s2 = 0; s2 < 2; ++s2)
#pragma unroll
                        for (int i = 0; i < 16; ++i) { const int kk = 32 * s2 + 8 * (i >> 2) + 4 * hh + (i & 3); int rel = pq - posk[buf * 64 + kk]; rel = rel < 0 ? 0 : (rel > 128 ? 128 : rel);
                            S[s2][i] = S[s2][i] * sc2 + lut[rel]; }
                }
                if (needmask) {
#pragma unroll
                    for (int s2 = 0; s2 < 2; ++s2)
#pragma unroll
                        for (int i = 0; i < 16; ++i) { const int kk = k0 + 32 * s2 + 8 * (i >> 2) + 4 * hh + (i & 3); if (kk > qrow) S[s2][i] = -1e30f; }
                }
                float mx = S[0][0];
#pragma unroll
                for (int s2 = 0; s2 < 2; ++s2)
#pragma unroll
                    for (int i = 0; i < 16; ++i) mx = fmaxf(mx, S[s2][i]);
                mx = fmaxf(mx, shx(mx, 32, lane));
                mnew = fmaxf(mrun, mx);
#pragma unroll
                for (int s2 = 0; s2 < 2; ++s2)
#pragma unroll
                    for (int i = 0; i < 16; ++i) { const float pe = __builtin_amdgcn_exp2f(S[s2][i] - mnew); S[s2][i] = pe; rsum += pe; }
            }
            const float alpha = __builtin_amdgcn_exp2f(mrun - mnew);
            rsum += shx(rsum, 32, lane);
            lrun = lrun * alpha + rsum; mrun = mnew;
            if (__builtin_amdgcn_ballot_w64(alpha != 1.0f) != 0ull) {
#pragma unroll
                for (int d = 0; d < 4; ++d)
#pragma unroll
                    for (int i = 0; i < 16; ++i) O[d][i] *= alpha;
            }
#pragma unroll
            for (int s2 = 0; s2 < 2; ++s2)
#pragma unroll
                for (int sp = 0; sp < 2; ++sp) {
                    const bf16x8 pf = pack8(S[s2][8 * sp + 0], S[s2][8 * sp + 1], S[s2][8 * sp + 2], S[s2][8 * sp + 3], S[s2][8 * sp + 4], S[s2][8 * sp + 5], S[s2][8 * sp + 6], S[s2][8 * sp + 7]);
                    const unsigned rbase = 32 * s2 + 16 * sp + 4 * hh;
#pragma unroll
                    for (int d = 0; d < 4; ++d) { const bf16x8 va = cat8(tr_read(Vimg, lane, rbase, d), tr_read(Vimg, lane, rbase + 8, d)); O[d] = mfma32(va, pf, O[d]); }
                }
        }
        if (kt + 1 < nt) ATT_STORE(buf ^ 1, kt + 1);
        __syncthreads();
    }
#undef ATT_LOAD
#undef ATT_STORE
    LAS float* X = (LAS float*)lds;
    const float inv_l = 1.0f / lrun;
    if (c == 1) {
#pragma unroll
        for (int d = 0; d < 4; ++d)
#pragma unroll
            for (int i = 0; i < 16; ++i) X[(rb * 64 + d * 16 + i) * 64 + lane] = O[d][i] * inv_l;
    }
    __syncthreads();
    if (c == 0) {
        const float lam = tabf[TB_LAM + layer];
        const float lam_init = 0.8f - 0.6f * __expf(-0.3f * (float)layer);
        float ss = 0.f;
#pragma unroll
        for (int d = 0; d < 4; ++d)
#pragma unroll
            for (int i = 0; i < 16; ++i) { const float v = O[d][i] * inv_l - lam * X[(rb * 64 + d * 16 + i) * 64 + lane]; O[d][i] = v; ss += v * v; }
        ss += shx(ss, 32, lane);
        const float rs = rsqrtf(ss * (1.0f / 128.0f) + 1e-5f) * (1.0f - lam_init);
        bf16_t* Ob = (bf16_t*)(P.ws + WS_XB) + tok * DM + h * 128;
        const float* ng = P.dnorm_g + layer * 128;
#pragma unroll
        for (int d = 0; d < 4; ++d)
#pragma unroll
            for (int g4 = 0; g4 < 4; ++g4) { const int e0 = 32 * d + 8 * g4 + 4 * hh; const f32x4 gg = *(const f32x4*)(ng + e0);
                u32x2 w; w.x = cvt_pk_bf16(O[d][4 * g4] * rs * gg[0], O[d][4 * g4 + 1] * rs * gg[1]); w.y = cvt_pk_bf16(O[d][4 * g4 + 2] * rs * gg[2], O[d][4 * g4 + 3] * rs * gg[3]);
                *(u32x2*)(Ob + e0) = w; }
    }
    __syncthreads();
}

__device__ void gla_stream(const Params& P, int layer, int type, int b, int h, int sl, LAS unsigned char* lds) {
    const int tid = opaque_tid(), wid = __builtin_amdgcn_readfirstlane(tid >> 6), lane = tid & 63;
    const bf16_t* Hm = (const bf16_t*)(P.ws + WS_H);
    bf16_t* Ob = (bf16_t*)(P.ws + WS_XB);
    float* stat = (float*)(P.ws + WS_STAT);
    const int qcol = (type ? 4608 : 1536) + h * 128, kcol = (type ? 5120 : 2048) + h * 128, vcol = (type ? 5632 : 2560) + h * 128 + 32 * sl,
              ocol = (type ? 1536 : 512) + h * 128 + 32 * sl;
    const float gam = 1.0f - exp2f(-5.0f - (float)h);
    LAS float* FF = (LAS float*)lds; LAS unsigned* QK = (LAS unsigned*)lds + 2048; LAS float* VF = FF + 4096; LAS float* OP = FF + 4608;
    const int e_l = tid & 15, kg = tid >> 4;
    const int stok = tid >> 5, sc4 = (tid & 31) * 4;
    const int vtok = (tid >> 4) & 15, vc2 = (tid & 15) * 2;
    float S0[4] = {0.f, 0.f, 0.f, 0.f}, S1[4] = {0.f, 0.f, 0.f, 0.f};
    u32x2 pq2, pk2; unsigned pv1 = 0u;
    const bf16_t* gbase = Hm + ((size_t)b * SEQ + stok) * INC + sc4;
    const bf16_t* vbase = Hm + ((size_t)b * SEQ + vtok) * INC + vcol + vc2;
#define GLS_LOAD(bt) do { const bf16_t* gp = gbase + (size_t)(bt) * 16 * INC; pq2 = *(const u32x2*)(gp + qcol); pk2 = *(const u32x2*)(gp + kcol); \
        if (tid < 256) pv1 = *(const unsigned*)(vbase + (size_t)(bt) * 16 * INC); } while (0)
    GLS_LOAD(0);
    __syncthreads();
    for (int bt = 0; bt < 512; ++bt) {
        const size_t T0 = (size_t)b * SEQ + (size_t)bt * 16;
        { const int o = stok * 128 + sc4;
          if (type) { const float l0 = bf_lo(pk2.x), l1 = bf_hi(pk2.x), l2 = bf_lo(pk2.y), l3 = bf_hi(pk2.y);
              *(LAS f32x4*)(FF + o) = (f32x4){__expf(l0), __expf(l1), __expf(l2), __expf(l3)};
              const unsigned k01 = cvt_pk_bf16(1.0f - __expf(l0), 1.0f - __expf(l1)), k23 = cvt_pk_bf16(1.0f - __expf(l2), 1.0f - __expf(l3));
              *(LAS u32x4*)(QK + o) = (u32x4){(pq2.x & 0xffffu) | (k01 << 16), (pq2.x >> 16) | (k01 & 0xffff0000u), (pq2.y & 0xffffu) | (k23 << 16), (pq2.y >> 16) | (k23 & 0xffff0000u)}; }
          else {
              *(LAS u32x4*)(QK + o) = (u32x4){(pq2.x & 0xffffu) | (pk2.x << 16), (pq2.x >> 16) | (pk2.x & 0xffff0000u), (pq2.y & 0xffffu) | (pk2.y << 16), (pq2.y >> 16) | (pk2.y & 0xffff0000u)}; }
          if (tid < 256) { VF[vtok * 32 + vc2] = bf_lo(pv1); VF[vtok * 32 + vc2 + 1] = bf_hi(pv1); } }
        if (bt + 1 < 512) GLS_LOAD(bt + 1);
        __syncthreads();
        float accs[32];
#pragma unroll
        for (int tt = 0; tt < 16; ++tt) {
            const float v0 = VF[tt * 32 + e_l], v1 = VF[tt * 32 + 16 + e_l];
            f32x4 f4 = (f32x4){gam, gam, gam, gam}; if (type) f4 = *(const LAS f32x4*)(FF + tt * 128 + 4 * kg);
            const u32x4 qk = *(const LAS u32x4*)(QK + tt * 128 + 4 * kg);
            const unsigned qw[4] = {qk.x, qk.y, qk.z, qk.w};
            float a0 = 0.f, a1 = 0.f;
#pragma unroll
            for (int j = 0; j < 4; ++j) { const float q = bf_lo(qw[j]), c = bf_hi(qw[j]);
                S0[j] = f4[j] * S0[j] + c * v0; S1[j] = f4[j] * S1[j] + c * v1; a0 += q * S0[j]; a1 += q * S1[j]; }
            accs[2 * tt] = a0; accs[2 * tt + 1] = a1;
        }
        { const bool b0 = (lane & 16) != 0, b1 = (lane & 32) != 0;
          float r16[16];
#pragma unroll
          for (int i = 0; i < 16; ++i) r16[i] = swapadd16(accs[i], accs[16 + i]);
          float r8[8];
#pragma unroll
          for (int i = 0; i < 8; ++i) r8[i] = swapadd32(r16[i], r16[8 + i]);
          const int vb = (b0 ? 16 : 0) + (b1 ? 8 : 0);
#pragma unroll
          for (int i = 0; i < 8; ++i) { const int vi = vb + i; OP[((vi >> 1) * 8 + wid) * 32 + (vi & 1) * 16 + e_l] = r8[i]; } }
        __syncthreads();
        { const int tt = tid >> 5, e32 = tid & 31; const size_t tok = T0 + tt;
            float o = 0.f;
#pragma unroll
            for (int w = 0; w < 8; ++w) o += OP[(tt * 8 + w) * 32 + e32];
            Ob[tok * DM + ocol + e32] = (bf16_t)(cvt_pk_bf16(o, 0.f) & 0xffffu);
            float s1 = o, s2 = o * o;
#pragma unroll
            for (int of = 16; of >= 1; of >>= 1) { s1 += shx(s1, of, lane); s2 += shx(s2, of, lane); }
            if (e32 == 0) *(f32x4*)(stat + ((((size_t)type * MTOK + tok) * 4 + h) * 8 + 2 * sl) * 2) = (f32x4){s1, s2, 0.f, 0.f}; }
    }
#undef GLS_LOAD
    __syncthreads();
}

__device__ void gla_post_phase(const Params& P, int layer) {
    bf16_t* Ob = (bf16_t*)(P.ws + WS_XB); const bf16_t* Hm = (const bf16_t*)(P.ws + WS_H); const float* stat = (const float*)(P.ws + WS_STAT);
    const float* ng = P.hg_norm_g + layer * 512;
    const int tid = opaque_tid(); const int lane = tid & 63, gw = opaque_bid() * 8 + (tid >> 6), nw = gridDim.x * 8;
    const int hd = lane >> 4;
    const f32x4 n0 = *(const f32x4*)(ng + lane * 8), n1 = *(const f32x4*)(ng + lane * 8 + 4);
    const float nn[8] = {n0[0], n0[1], n0[2], n0[3], n1[0], n1[1], n1[2], n1[3]};
    for (int tok0 = gw; tok0 + nw < MTOK; tok0 += 2 * nw) {
        u32x4 wb[2], gb[2], wd[2], gd[2]; f32x4 sb[2][4], sd[2][16];
#pragma unroll
        for (int r = 0; r < 2; ++r) { const size_t tok = (size_t)(tok0 + r * nw);
            wb[r] = *(const u32x4*)(Ob + tok * DM + 512 + lane * 8); gb[r] = *(const u32x4*)(Hm + tok * INC + 3072 + lane * 8);
            wd[r] = *(const u32x4*)(Ob + tok * DM + 1536 + lane * 8); gd[r] = *(const u32x4*)(Hm + tok * INC + 6144 + lane * 8);
            const float* spb = stat + (tok * 4 + hd) * 16; const float* spd = stat + (((size_t)MTOK + tok) * 4) * 16;
#pragma unroll
            for (int q = 0; q < 4; ++q) sb[r][q] = *(const f32x4*)(spb + 4 * q);
#pragma unroll
            for (int q = 0; q < 16; ++q) sd[r][q] = *(const f32x4*)(spd + 4 * q); }
#pragma unroll
        for (int r = 0; r < 2; ++r) { const size_t tok = (size_t)(tok0 + r * nw);
            float s1 = 0.f, s2 = 0.f, d2 = 0.f;
#pragma unroll
            for (int q = 0; q < 4; ++q) { s1 += sb[r][q][0] + sb[r][q][2]; s2 += sb[r][q][1] + sb[r][q][3]; }
#pragma unroll
            for (int q = 0; q < 16; ++q) d2 += sd[r][q][1] + sd[r][q][3];
            const float mu = s1 * (1.0f / 128.0f), var = fmaxf(s2 * (1.0f / 128.0f) - mu * mu, 0.f), rs = rsqrtf(var + 1e-5f);
            const float rsd = rsqrtf(d2 * (1.0f / 512.0f) + 1e-5f);
            const unsigned ww[4] = {wb[r].x, wb[r].y, wb[r].z, wb[r].w}, gg[4] = {gb[r].x, gb[r].y, gb[r].z, gb[r].w};
            const unsigned wx[4] = {wd[r].x, wd[r].y, wd[r].z, wd[r].w}, gx[4] = {gd[r].x, gd[r].y, gd[r].z, gd[r].w};
            unsigned ob[4], od[4];
#pragma unroll
            for (int j = 0; j < 4; ++j) {
                ob[j] = cvt_pk_bf16((bf_lo(ww[j]) - mu) * rs * silu_f(bf_lo(gg[j])), (bf_hi(ww[j]) - mu) * rs * silu_f(bf_hi(gg[j])));
                od[j] = cvt_pk_bf16(bf_lo(wx[j]) * rsd * nn[2 * j] * silu_f(bf_lo(gx[j])), bf_hi(wx[j]) * rsd * nn[2 * j + 1] * silu_f(bf_hi(gx[j]))); }
            *(u32x4*)(Ob + tok * DM + 512 + lane * 8) = (u32x4){ob[0], ob[1], ob[2], ob[3]};
            *(u32x4*)(Ob + tok * DM + 1536 + lane * 8) = (u32x4){od[0], od[1], od[2], od[3]}; }
    }
}

__device__ void gmlp_unit(const Params& P, int layer, int b, int chunk, LAS unsigned char* lds) {
    constexpr unsigned VIMG = 0, WIMG = 32768, MU = 65536, RS = 66048;
    const int tid = opaque_tid(), wid = __builtin_amdgcn_readfirstlane(tid >> 6), lane = tid & 63, l31 = lane & 31, hh = lane >> 5;
    const bf16_t* Hm = (const bf16_t*)(P.ws + WS_H);
    bf16_t* Ob = (bf16_t*)(P.ws + WS_XB);
    const size_t T0 = (size_t)b * SEQ + chunk * 128;
    __syncthreads();
    for (int i = 0; i < 16; ++i) { const int t = wid * 16 + i; const u32x4 w = *(const u32x4*)(Hm + (T0 + t) * INC + 4096 + lane * 8);
        const float v[8] = {bf_lo(w.x), bf_hi(w.x), bf_lo(w.y), bf_hi(w.y), bf_lo(w.z), bf_hi(w.z), bf_lo(w.w), bf_hi(w.w)};
        float s = 0.f;
#pragma unroll
        for (int j = 0; j < 8; ++j) s += v[j];
#pragma unroll
        for (int o = 32; o >= 1; o >>= 1) s += shx(s, o, lane);
        const float mu = s * (1.0f / 512.0f); float q = 0.f;
#pragma unroll
        for (int j = 0; j < 8; ++j) { const float d = v[j] - mu; q += d * d; }
#pragma unroll
        for (int o = 32; o >= 1; o >>= 1) q += shx(q, o, lane);
        if (lane == 0) { ((LAS float*)(lds + MU))[t] = mu; ((LAS float*)(lds + RS))[t] = rsqrtf(q * (1.0f / 512.0f) + 1e-5f); } }
    __syncthreads();
    const int tb = wid & 3, ct0 = 2 * (wid >> 2);
    for (int g = 0; g < 4; ++g) {
        const float* lg = P.g_ln_g + layer * 512 + g * 128; const float* lb = P.g_ln_b + layer * 512 + g * 128;
        const float* Wg = P.g_ws + ((size_t)(layer * 4 + g)) * 128 * 128;
#pragma unroll
        for (int i = 0; i < 4; ++i) { const int n = tid + 512 * i, s = n >> 4, ch = n & 15;
            const u32x4 w = *(const u32x4*)(Hm + (T0 + s) * INC + 4096 + g * 128 + ch * 8);
            const float mu = ((LAS float*)(lds + MU))[s], rs = ((LAS float*)(lds + RS))[s];
            const f32x4 g0 = *(const f32x4*)(lg + ch * 8), g1 = *(const f32x4*)(lg + ch * 8 + 4), b0 = *(const f32x4*)(lb + ch * 8), b1 = *(const f32x4*)(lb + ch * 8 + 4);
            const float v[8] = {bf_lo(w.x), bf_hi(w.x), bf_lo(w.y), bf_hi(w.y), bf_lo(w.z), bf_hi(w.z), bf_lo(w.w), bf_hi(w.w)};
            float y[8];
#pragma unroll
            for (int j = 0; j < 8; ++j) y[j] = (v[j] - mu) * rs * (j < 4 ? g0[j] : g1[j - 4]) + (j < 4 ? b0[j] : b1[j - 4]);
            *(LAS bf16x8*)(lds + VIMG + off_b(s, ch)) = pack8(y[0], y[1], y[2], y[3], y[4], y[5], y[6], y[7]);
            const f32x4 w0 = *(const f32x4*)(Wg + s * 128 + ch * 8), w1 = *(const f32x4*)(Wg + s * 128 + ch * 8 + 4);
            float ww[8];
#pragma unroll
            for (int j = 0; j < 8; ++j) ww[j] = (ch * 8 + j <= s) ? (j < 4 ? w0[j] : w1[j - 4]) : 0.f;
            *(LAS bf16x8*)(lds + WIMG + off_b(s, ch)) = pack8(ww[0], ww[1], ww[2], ww[3], ww[4], ww[5], ww[6], ww[7]); }
        __syncthreads();
        f32x16 acc[2]; acc[0] = zero16(); acc[1] = zero16();
        for (int ks = 0; ks < 2 * (tb + 1); ++ks) {
            const bf16x8 bw = *(const LAS bf16x8*)(lds + WIMG + off_b(32 * tb + l31, 2 * ks + hh));
#pragma unroll
            for (int e = 0; e < 2; ++e) { const bf16x8 av = cat8(tr_read(lds + VIMG, lane, 16 * ks + 8 * hh, ct0 + e), tr_read(lds + VIMG, lane, 16 * ks + 8 * hh + 4, ct0 + e)); acc[e] = mfma32(av, bw, acc[e]); }
        }
        { const int t = 32 * tb + l31; const size_t tok = T0 + t; const float bs = P.g_bs[(layer * 4 + g) * 128 + t];
#pragma unroll
          for (int e = 0; e < 2; ++e)
#pragma unroll
              for (int g4 = 0; g4 < 4; ++g4) { const int c0 = 32 * (ct0 + e) + 8 * g4 + 4 * hh;
                  const u32x2 uw = *(const u32x2*)(Hm + tok * INC + 3584 + g * 128 + c0);
                  u32x2 w; w.x = cvt_pk_bf16(bf_lo(uw.x) * (acc[e][4 * g4] + bs), bf_hi(uw.x) * (acc[e][4 * g4 + 1] + bs)); w.y = cvt_pk_bf16(bf_lo(uw.y) * (acc[e][4 * g4 + 2] + bs), bf_hi(uw.y) * (acc[e][4 * g4 + 3] + bs));
                  *(u32x2*)(Ob + tok * DM + 1024 + g * 128 + c0) = w; } }
        __syncthreads();
    }
}

__device__ void mixer_phase(const Params& P, int layer, LAS unsigned char* lds) {
    unsigned* qc = (unsigned*)(P.ws + WS_TAB) + TB_Q + layer;
    LAS unsigned* slot = (LAS unsigned*)(lds + LDS_BYTES - 16);
    for (;;) {
        __syncthreads();
        if (threadIdx.x == 0) *slot = atomicAdd(qc, 1u);
        __syncthreads();
        const int item = (int)*slot;
        if (item >= 128 + 512 + 256) break;
        if (item < 128) { const int st = item >> 2; gla_stream(P, layer, 1 - (st >> 4), (st >> 2) & 3, st & 3, item & 3, lds); }
        else if (item < 640) { const int a = item - 128, bh = a >> 5, pr = a & 31;
            for (int u2 = 0; u2 < 2; ++u2) attn_unit(P, layer, bh >> 2, bh & 3, u2 ? pr : 63 - pr, lds); }
        else { const int c = item - 640; gmlp_unit(P, layer, c >> 6, c & 63, lds); }
    }
}

__device__ __forceinline__ void grid_barrier(unsigned* ctr, unsigned nbar) {
    asm volatile("s_waitcnt vmcnt(0)" ::: "memory");
    __syncthreads();
    if (threadIdx.x == 0) {
        __builtin_amdgcn_fence(__ATOMIC_RELEASE, "agent");
        asm volatile("s_waitcnt vmcnt(0)" ::: "memory");
        const unsigned gsz = gridDim.x >> 3;
        unsigned* gc = ctr + (blockIdx.x & 7u) * 32u; unsigned* glob = ctr + 8u * 32u;
        const unsigned old = __hip_atomic_fetch_add(gc, 1u, __ATOMIC_RELAXED, __HIP_MEMORY_SCOPE_AGENT);
        if (old + 1u == nbar * gsz) __hip_atomic_fetch_add(glob, 1u, __ATOMIC_RELAXED, __HIP_MEMORY_SCOPE_AGENT);
        while (__hip_atomic_load(glob, __ATOMIC_RELAXED, __HIP_MEMORY_SCOPE_AGENT) < nbar * 8u) __builtin_amdgcn_s_sleep(1);
        __builtin_amdgcn_fence(__ATOMIC_ACQUIRE, "agent");
        asm volatile("s_waitcnt vmcnt(0)" ::: "memory");
    }
    __syncthreads();
}

template <class Epi> __device__ __forceinline__ void run_gemm(LAS unsigned char* lds, const bf16_t* A, const bf16_t* Bt, int N, int K, const Epi& E) {
    pg8::Gemm g; g.A = A; g.Bt = Bt; g.M = MTOK; g.N = N; g.K = K;
    pg8::StaticOrder S; S.init(MTOK, N, (int)gridDim.x, opaque_bid());
    pg8::gemm_phase<Epi>(lds, g, S, E);
}

typedef const __attribute__((address_space(4))) Params* KParamsPtr;
__global__ __launch_bounds__(512, 2) void fwd_megakernel(const Params Pin) {
    extern __shared__ __attribute__((aligned(16))) unsigned char shm[];
    LAS unsigned char* lds = (LAS unsigned char*)shm;
    cg::grid_group grid = cg::this_grid();
    const KParamsPtr kp = (KParamsPtr)__builtin_amdgcn_kernarg_segment_ptr();
    unsigned nbar = 0u;
    for (int ph = Pin.ph_lo; ph < Pin.ph_hi; ++ph) {
        if (Pin.ph_lo < 0) grid.sync();
        if (ph > Pin.ph_lo) { nbar += 1u; grid_barrier((unsigned*)(Pin.ws + WS_TAB) + 8000, nbar); }
        KParamsPtr kq = kp; asm volatile("" : "+s"(kq));
        const Params& P = *(const Params*)kq;
        unsigned char* ws = P.ws;
        float* X = P.out;
        bf16_t* Xb = (bf16_t*)(ws + WS_XB);
        bf16_t* Hb = (bf16_t*)(ws + WS_H);
        if (ph == 0) { prep_phase(P, lds); continue; }
        const int L = (ph - 1) / 13, s = (ph - 1) % 13;
        { const int lnk = (s == 2) ? 0 : (s == 7) ? 1 : (s == 10) ? 2 : (s == 12) ? 3 : -1;
          if (lnk >= 0) { ln_phase(X, P.ln_g + (L * 4 + lnk) * DM, P.ln_b + (L * 4 + lnk) * DM, Xb, lnk == 0 || (lnk == 3 && L == DEPTH - 1)); continue; } }
        switch (s) {
        case 0: { EpiSwiGLU E; E.H = Hb; run_gemm(lds, Xb, (const bf16_t*)(ws + WS_W1IN + L * SZ_W1IN), 2 * DFF, DM, E); } break;
        case 1: { EpiRes E; E.res = (L == 0) ? P.x : nullptr; E.resb = Xb; E.out = X; E.scale = 0.5f; run_gemm(lds, Hb, (const bf16_t*)(ws + WS_W1OUT + L * SZ_W1OUT), DM, DFF, E); } break;
        case 3: { EpiMixIn E; E.Hm = Hb; E.cs = (const f32x2*)(ws + WS_CS); E.loglb = (const float*)(ws + WS_TAB) + TB_LOGLB + L * 512;
                  run_gemm(lds, Xb, (const bf16_t*)(ws + WS_WMI + L * SZ_WMI), INC, DM, E); } break;
        case 4: mixer_phase(P, L, lds); break;
        case 5: gla_post_phase(P, L); break;
        case 6: { EpiRes E; E.res = X; E.resb = nullptr; E.out = X; E.scale = 1.0f; run_gemm(lds, Xb, (const bf16_t*)(ws + WS_WMO + L * SZ_WMO), DM, DM, E); } break;
        case 8: { EpiSwiGLU E; E.H = Hb; run_gemm(lds, Xb, (const bf16_t*)(ws + WS_W2IN + L * SZ_W1IN), 2 * DFF, DM, E); } break;
        case 9: { EpiRes E; E.res = nullptr; E.resb = Xb; E.out = X; E.scale = 0.5f; run_gemm(lds, Hb, (const bf16_t*)(ws + WS_W2OUT + L * SZ_W1OUT), DM, DFF, E); } break;
        case 11: { EpiPE E1; E1.pe = (float*)(ws + WS_H); run_gemm(lds, (const bf16_t*)(ws + WS_PB) + (size_t)L * MTOK * PLE, (const bf16_t*)(ws + WS_WE + L * SZ_WE), DM, PLE, E1);
                   EpiGate E2; E2.X = X; E2.pe = (const float*)(ws + WS_H); E2.xb = Xb; run_gemm(lds, Xb, (const bf16_t*)(ws + WS_WG + L * SZ_WG), DM, DM, E2); } break;
        }
    }
}

extern "C" void kernel_launch(void* const* d_in, const int* in_sizes, int n_in, void* d_out, int out_size, void* d_ws, size_t ws_size, hipStream_t stream) {
    static int grid = 0;
    if (grid == 0) {
        if (n_in != 22 || out_size != MTOK * DM || ws_size < WS_END) { fprintf(stderr, "kernel_launch: unexpected shapes (n_in %d out %d ws %zu need %zu)\n", n_in, out_size, ws_size, (size_t)WS_END); grid = -1; return; }
        int dev = 0, cus = 0, per_cu = 0;
        (void)hipGetDevice(&dev); (void)hipDeviceGetAttribute(&cus, hipDeviceAttributeMultiprocessorCount, dev);
        if (hipFuncSetAttribute((const void*)fwd_megakernel, hipFuncAttributeMaxDynamicSharedMemorySize, LDS_BYTES) != hipSuccess) { fprintf(stderr, "kernel_launch: hipFuncSetAttribute failed\n"); grid = -1; return; }
        if (hipOccupancyMaxActiveBlocksPerMultiprocessor(&per_cu, (const void*)fwd_megakernel, 512, LDS_BYTES) != hipSuccess || per_cu < 1) { fprintf(stderr, "kernel_launch: occupancy query says %d\n", per_cu); per_cu = 1; }
        (void)hipGetLastError();
        grid = cus & ~7;
    }
    if (grid < 0) return;
    Params p; memset(&p, 0, sizeof(p));
    p.x = (const float*)d_in[0]; p.p = (const float*)d_in[1]; p.pos = (const int*)d_in[2];
    p.ffn1_in = (const float*)d_in[3]; p.ffn1_out = (const float*)d_in[4]; p.mix_in = (const float*)d_in[5]; p.mix_out = (const float*)d_in[6];
    p.rel_bias = (const float*)d_in[7]; p.dlam = (const float*)d_in[8]; p.dnorm_g = (const float*)d_in[9]; p.g_ln_g = (const float*)d_in[10]; p.g_ln_b = (const float*)d_in[11];
    p.g_ws = (const float*)d_in[12]; p.g_bs = (const float*)d_in[13]; p.lb_logits = (const float*)d_in[14]; p.hg_norm_g = (const float*)d_in[15];
    p.ffn2_in = (const float*)d_in[16]; p.ffn2_out = (const float*)d_in[17]; p.ple_gate = (const float*)d_in[18]; p.ple_proj = (const float*)d_in[19];
    p.ln_g = (const float*)d_in[20]; p.ln_b = (const float*)d_in[21];
    p.out = (float*)d_out; p.ws = (unsigned char*)d_ws;
    p.ph_lo = 0; p.ph_hi = NPH;
    for (int i = 0; i < 64; ++i) p.inv[i] = pow(10000.0, -(double)i / 63.0);
    (void)hipMemsetAsync((unsigned char*)d_ws + WS_TAB + 32000, 0, 9 * 128, stream);
    void* args[] = {&p};
    hipError_t e = hipLaunchCooperativeKernel((const void*)fwd_megakernel, dim3(grid), dim3(512), args, LDS_BYTES, stream);
    if (e != hipSuccess) fprintf(stderr, "kernel_launch: cooperative launch failed: %s (grid %d)\n", hipGetErrorString(e), grid);
}
```

```cpp
#include <hip/hip_runtime.h>
#include <hip/hip_cooperative_groups.h>
#include <math.h>
#include <stdio.h>
#include <string.h>
namespace cg = cooperative_groups;

#define LAS __attribute__((address_space(3)))
typedef unsigned short bf16_t;
typedef short bf16x8 __attribute__((ext_vector_type(8)));
typedef short s16x4 __attribute__((ext_vector_type(4)));
typedef float f32x2 __attribute__((ext_vector_type(2)));
typedef float f32x4 __attribute__((ext_vector_type(4)));
typedef float f32x16 __attribute__((ext_vector_type(16)));
typedef unsigned u32x2 __attribute__((ext_vector_type(2)));
typedef unsigned u32x4 __attribute__((ext_vector_type(4)));

constexpr int MTOK = 32768, SEQ = 8192, DM = 2048, DFF = 5632, INC = 6656, PLE = 256, DEPTH = 2;
constexpr float ALPHA = 1.41421356237f;
constexpr float LOG2E = 1.44269504089f;
constexpr int LDS_BYTES = 147456;
constexpr int NPH = 1 + 13 * DEPTH;

constexpr size_t SZ_W1IN = (size_t)2 * DFF * DM * 2, SZ_W1OUT = (size_t)DM * DFF * 2, SZ_WMI = (size_t)INC * DM * 2, SZ_WMO = (size_t)DM * DM * 2,
                 SZ_WG = (size_t)DM * DM * 2, SZ_WE = (size_t)DM * PLE * 2;
constexpr size_t WS_W1IN = 0, WS_W1OUT = WS_W1IN + DEPTH * SZ_W1IN, WS_WMI = WS_W1OUT + DEPTH * SZ_W1OUT, WS_WMO = WS_WMI + DEPTH * SZ_WMI,
                 WS_W2IN = WS_WMO + DEPTH * SZ_WMO, WS_W2OUT = WS_W2IN + DEPTH * SZ_W1IN, WS_WG = WS_W2OUT + DEPTH * SZ_W1OUT, WS_WE = WS_WG + DEPTH * SZ_WG,
                 WS_H = WS_WE + DEPTH * SZ_WE, WS_XB = WS_H + (size_t)MTOK * INC * 2, WS_PB = WS_XB + (size_t)MTOK * DM * 2,
                 WS_CS = WS_PB + (size_t)DEPTH * MTOK * PLE * 2, WS_SSQ = WS_CS + (size_t)MTOK * 64 * 8, WS_TAB = WS_SSQ + (size_t)MTOK * 4 * 4,
                 WS_STAT = WS_TAB + 65536, WS_END = WS_STAT + (size_t)2 * MTOK * 4 * 8 * 2 * 4;
constexpr int TB_LOGLB = 0  , TB_LUT = 1024  , TB_LAM = 1600  , TB_PMAX = 1664  , TB_Q = 2304  ;

struct Params {
    const float* x; const float* p; const int* pos;
    const float *ffn1_in, *ffn1_out, *mix_in, *mix_out, *rel_bias, *dlam, *dnorm_g, *g_ln_g, *g_ln_b, *g_ws, *g_bs, *lb_logits, *hg_norm_g,
        *ffn2_in, *ffn2_out, *ple_gate, *ple_proj, *ln_g, *ln_b;
    float* out; unsigned char* ws;
    int ph_lo, ph_hi;
    double inv[64];
};

__device__ __forceinline__ unsigned cvt_pk_bf16(float lo, float hi) { unsigned r; asm("v_cvt_pk_bf16_f32 %0, %1, %2" : "=v"(r) : "v"(lo), "v"(hi)); return r; }
__device__ __forceinline__ float bf_lo(unsigned w) { return __uint_as_float(w << 16); }
__device__ __forceinline__ float bf_hi(unsigned w) { return __uint_as_float(w & 0xffff0000u); }
__device__ __forceinline__ unsigned off_b(unsigned row, unsigned ch) { return 256u * row + 16u * (ch ^ (((row & 3u) << 2) | ((row >> 2) & 3u))); }
__device__ __forceinline__ s16x4 tr_read(LAS const unsigned char* img, unsigned lane, unsigned rowbase, unsigned c) {
    const unsigned blk = (lane >> 4) & 1u, qq = (lane & 15u) >> 2, p = lane & 3u;
    return __builtin_amdgcn_ds_read_tr16_b64_v4i16((LAS s16x4*)(img + off_b(rowbase + qq, 4u * c + 2u * blk + (p >> 1)) + 8u * (p & 1u)));
}
__device__ __forceinline__ bf16x8 cat8(s16x4 a, s16x4 b) { bf16x8 r; r[0] = a[0]; r[1] = a[1]; r[2] = a[2]; r[3] = a[3]; r[4] = b[0]; r[5] = b[1]; r[6] = b[2]; r[7] = b[3]; return r; }
__device__ __forceinline__ bf16x8 pack8(float a0, float a1, float a2, float a3, float a4, float a5, float a6, float a7) {
    u32x4 w; w.x = cvt_pk_bf16(a0, a1); w.y = cvt_pk_bf16(a2, a3); w.z = cvt_pk_bf16(a4, a5); w.w = cvt_pk_bf16(a6, a7);
    return __builtin_bit_cast(bf16x8, w);
}
__device__ __forceinline__ f32x16 mfma32(bf16x8 a, bf16x8 b, f32x16 c) { return __builtin_amdgcn_mfma_f32_32x32x16_bf16(a, b, c, 0, 0, 0); }
__device__ __forceinline__ float silu_f(float v) { return v * __builtin_amdgcn_rcpf(1.0f + __expf(-v)); }
__device__ __forceinline__ float shx(float v, int off, int lane) { return __int_as_float(__builtin_amdgcn_ds_bpermute((lane ^ off) << 2, __float_as_int(v))); }
__device__ __forceinline__ int shxi(int v, int off, int lane) { return __builtin_amdgcn_ds_bpermute((lane ^ off) << 2, v); }
__device__ __forceinline__ float swapadd16(float a, float b) { auto r = __builtin_amdgcn_permlane16_swap(__float_as_uint(a), __float_as_uint(b), false, false); return __uint_as_float(r[0]) + __uint_as_float(r[1]); }
__device__ __forceinline__ float swapadd32(float a, float b) { auto r = __builtin_amdgcn_permlane32_swap(__float_as_uint(a), __float_as_uint(b), false, false); return __uint_as_float(r[0]) + __uint_as_float(r[1]); }
__device__ __forceinline__ int opaque_tid() { int t = threadIdx.x; asm volatile("" : "+v"(t)); return t; }
__device__ __forceinline__ int opaque_bid() { int t = blockIdx.x; asm volatile("" : "+s"(t)); return t; }
__device__ __forceinline__ f32x16 zero16() { f32x16 z; for (int i = 0; i < 16; ++i) z[i] = 0.f; return z; }

namespace pg8 {
constexpr int BM = 256, BK = 64, HALF = 128, HTB = HALF * BK * 2, STAGE_BYTES = 8 * HTB, NXCD = 8, WGM = 4;
__device__ __forceinline__ int lds_byte(int r, int c) { const int st = (r >> 4) * 2 + (c >> 5), rr = r & 15, cc = c & 31, ob = rr * 64 + cc * 2; return st * 1024 + (ob ^ (((ob >> 9) & 1) << 5)); }
__device__ __forceinline__ void stage_rc(int b, int& R, int& C) { const int st = b / 1024, sb = b % 1024, swz = sb ^ (((sb >> 9) & 1) << 5); R = (st >> 1) * 16 + swz / 64; C = (st & 1) * 32 + (swz % 64) / 2; }
__device__ __forceinline__ int perm32(int rho) { const int n = rho >> 4, i = rho & 15; return 8 * (i >> 2) + 4 * n + (i & 3); }
struct Unit { int pm, pn; };
struct Gemm { const bf16_t* A; const bf16_t* Bt; int M, N, K; };
struct StaticOrder {
    int nM, nN, nwg, G, c;
    __device__ void init(int M, int N, int G_, int c_) { nM = M / BM; nN = N / BM; nwg = nM * nN; G = G_; c = c_; }
    __device__ bool next(int i, Unit& u) const {
        const long L = (long)i * G + c; if (L >= nwg) return false;
        int wgid = (int)L; { const int q = nwg / NXCD, r = nwg % NXCD, xcd = wgid % NXCD, off = wgid / NXCD; wgid = (xcd < r ? xcd * (q + 1) : r * (q + 1) + (xcd - r) * q) + off; }
        const int nig = WGM * nN, gid = wgid / nig, fm = gid * WGM, gsz = (nM - fm) < WGM ? (nM - fm) : WGM;
        u.pm = fm + ((wgid % nig) % gsz); u.pn = (wgid % nig) / gsz; return true;
    }
};
template <class Epi>
__device__ __forceinline__ void gemm_phase(LAS unsigned char* lds, const Gemm g, const StaticOrder& S, const Epi& E) {
    const int tid = opaque_tid(), wid = __builtin_amdgcn_readfirstlane(tid >> 6), lane = tid & 63, wr = wid >> 2, wc = wid & 3, fr = lane & 15, fq = lane >> 4;
    const int K = g.K, nt = K / BK;
    unsigned voffA[2], voffB[2];
#pragma unroll
    for (int i = 0; i < 2; ++i) { int R, C; stage_rc(tid * 16 + i * 8192, R, C); const int Rb = Epi::PERM ? ((R & ~31) + perm32(R & 31)) : R;
        voffA[i] = (unsigned)(R * K + C) * 2u; voffB[i] = (unsigned)(Rb * K + C) * 2u; }
    const size_t kstep = (size_t)(BK * 2), hstep = (size_t)HALF * K * 2, tstep = 2 * hstep;
    const unsigned ldsw = (unsigned)wid * 1024u;
    const int aoff = lds_byte(wr * 64 + fr, fq * 8), boff = lds_byte(wc * 32 + fr, fq * 8);
#define PG8_SA(b, h) (((b) * 2 + (h)) * HTB)
#define PG8_SB(b, h) ((4 + (b) * 2 + (h)) * HTB)
#define PG8_STAGE(bufoff, gbase, voff) do { _Pragma("unroll") for (int _i = 0; _i < 2; ++_i) \
        __builtin_amdgcn_global_load_lds((const unsigned*)((const char*)(gbase) + (voff)[_i]), (LAS unsigned*)(lds + (bufoff) + ldsw + _i * 8192), 16, 0, 0); } while (0)
#define PG8_LDA(dst, b, h) do { _Pragma("unroll") for (int m = 0; m < 4; ++m) _Pragma("unroll") for (int k = 0; k < 2; ++k) dst[m][k] = *(const LAS bf16x8*)(lds + PG8_SA(b, h) + aoff + m * 2048 + k * 1024); } while (0)
#define PG8_LDB(dst, b, h) do { _Pragma("unroll") for (int n = 0; n < 2; ++n) _Pragma("unroll") for (int k = 0; k < 2; ++k) dst[n][k] = *(const LAS bf16x8*)(lds + PG8_SB(b, h) + boff + n * 2048 + k * 1024); } while (0)
#define PG8_MMA(ai, bj, At, Bt) do { __builtin_amdgcn_s_setprio(1); _Pragma("unroll") for (int m = 0; m < 4; ++m) _Pragma("unroll") for (int n = 0; n < 2; ++n) _Pragma("unroll") for (int k = 0; k < 2; ++k) \
        acc[ai][bj][m][n] = __builtin_amdgcn_mfma_f32_16x16x32_bf16(Bt[n][k], At[m][k], acc[ai][bj][m][n], 0, 0, 0); __builtin_amdgcn_s_setprio(0); } while (0)
#define PG8_WAIT_V(n) asm volatile("s_waitcnt vmcnt(" #n ")" ::: "memory")
#define PG8_WAIT_L(n) asm volatile("s_waitcnt lgkmcnt(" #n ")" ::: "memory")
#define PG8_BAR __builtin_amdgcn_s_barrier()
#define PG8_SCHED __builtin_amdgcn_sched_barrier(0)
    Unit cur, nxt; int ui = 0;
    if (!S.next(0, cur)) return;
    f32x4 acc[2][2][4][2];
#pragma unroll
    for (int a = 0; a < 2; ++a)
#pragma unroll
        for (int b = 0; b < 2; ++b)
#pragma unroll
            for (int m = 0; m < 4; ++m)
#pragma unroll
                for (int n = 0; n < 2; ++n) acc[a][b][m][n] = (f32x4){0.f, 0.f, 0.f, 0.f};
    bf16x8 At[4][2], B0[2][2], B1[2][2];
    const char* cA = (const char*)g.A + (size_t)cur.pm * tstep; const char* cB = (const char*)g.Bt + (size_t)cur.pn * tstep;
    PG8_STAGE(PG8_SB(0, 0), cB, voffB); PG8_STAGE(PG8_SA(0, 0), cA, voffA); PG8_STAGE(PG8_SB(0, 1), cB + hstep, voffB); PG8_STAGE(PG8_SA(0, 1), cA + hstep, voffA);
    if (wr == 1) PG8_BAR;
    PG8_WAIT_V(4); PG8_BAR;
    PG8_STAGE(PG8_SB(1, 0), cB + kstep, voffB); PG8_STAGE(PG8_SA(1, 0), cA + kstep, voffA); PG8_STAGE(PG8_SB(1, 1), cB + hstep + kstep, voffB);
    PG8_WAIT_V(6); PG8_BAR;
    for (;;) {
        const bool has_next = S.next(ui + 1, nxt);
        const char* nA = has_next ? (const char*)g.A + (size_t)nxt.pm * tstep : cA; const char* nB = has_next ? (const char*)g.Bt + (size_t)nxt.pn * tstep : cB;
        for (int t = 0; t < nt; t += 2) {
            const bool last = (t == nt - 2);
            const char* a1 = cA + (size_t)(t + 1) * kstep;
            const char* a2 = last ? nA : cA + (size_t)(t + 2) * kstep; const char* b2 = last ? nB : cB + (size_t)(t + 2) * kstep;
            const char* a3 = a2 + kstep; const char* b3 = b2 + kstep;
            PG8_LDB(B0, 0, 0); PG8_SCHED; PG8_LDA(At, 0, 0); PG8_STAGE(PG8_SA(1, 1), a1 + hstep, voffA);
            PG8_WAIT_L(8); PG8_BAR; PG8_WAIT_L(0); PG8_MMA(0, 0, At, B0); PG8_BAR; PG8_SCHED;
            PG8_LDB(B1, 0, 1); PG8_STAGE(PG8_SB(0, 0), b2, voffB);
            PG8_BAR; PG8_WAIT_L(0); PG8_MMA(0, 1, At, B1); PG8_BAR;
            PG8_LDA(At, 0, 1); PG8_STAGE(PG8_SA(0, 0), a2, voffA);
            PG8_BAR; PG8_WAIT_L(0); PG8_MMA(1, 0, At, B0); PG8_BAR; PG8_SCHED;
            PG8_STAGE(PG8_SB(0, 1), b2 + hstep, voffB);
            PG8_WAIT_V(6); PG8_BAR; PG8_MMA(1, 1, At, B1); PG8_BAR;
            PG8_LDB(B0, 1, 0); PG8_SCHED; PG8_LDA(At, 1, 0); PG8_STAGE(PG8_SA(0, 1), a2 + hstep, voffA);
            PG8_WAIT_L(8); PG8_BAR; PG8_WAIT_L(0); PG8_MMA(0, 0, At, B0); PG8_BAR; PG8_SCHED;
            PG8_LDB(B1, 1, 1); PG8_STAGE(PG8_SB(1, 0), b3, voffB);
            PG8_BAR; PG8_WAIT_L(0); PG8_MMA(0, 1, At, B1); PG8_BAR;
            PG8_LDA(At, 1, 1); PG8_STAGE(PG8_SA(1, 0), a3, voffA);
            PG8_BAR; PG8_WAIT_L(0); PG8_MMA(1, 0, At, B0); PG8_BAR; PG8_SCHED;
            PG8_STAGE(PG8_SB(1, 1), b3 + hstep, voffB);
            PG8_WAIT_V(6); PG8_BAR; PG8_MMA(1, 1, At, B1); PG8_BAR;
        }
        E(acc, cur, wr, wc, fr, fq);
        if (!has_next) break;
#pragma unroll
        for (int a = 0; a < 2; ++a)
#pragma unroll
            for (int b = 0; b < 2; ++b)
#pragma unroll
                for (int m = 0; m < 4; ++m)
#pragma unroll
                    for (int n = 0; n < 2; ++n) acc[a][b][m][n] = (f32x4){0.f, 0.f, 0.f, 0.f};
        cur = nxt; cA = nA; cB = nB; ++ui;
    }
    PG8_WAIT_V(0);
    if (wr == 0) PG8_BAR;
    PG8_BAR;
#undef PG8_SA
#undef PG8_SB
#undef PG8_STAGE
#undef PG8_LDA
#undef PG8_LDB
#undef PG8_MMA
#undef PG8_WAIT_V
#undef PG8_WAIT_L
#undef PG8_BAR
#undef PG8_SCHED
}
}
using pg8::Unit; using pg8::BM; using pg8::HALF;
typedef f32x4 Acc[2][2][4][2];

__device__ __forceinline__ float gelu_f(float v) {
    const float av = fabsf(v), t = __builtin_amdgcn_rcpf(av * 0.2316418882f + 1.0f);
    float q = t * 0.5307027145f + (-0.7265760135f); q = q * t + 0.7107068705f; q = q * t + (-0.142248368f); q = q * t + 0.127414796f; q = q * t;
    const float e = __builtin_amdgcn_exp2f((v * v) * (-0.72134752044f));
    const float m = v * (q * e);
    return v < 0.f ? m : v - m;
}

struct EpiSwiGLU {
    static constexpr bool PERM = true;
    bf16_t* H;
    __device__ __forceinline__ void operator()(const Acc& acc, const Unit& u, int wr, int wc, int fr, int fq) const {
        const int row0 = u.pm * BM + wr * 64 + fr, col0 = u.pn * 128 + wc * 32 + 8 * fq;
#pragma unroll
        for (int ai = 0; ai < 2; ++ai)
#pragma unroll
            for (int m = 0; m < 4; ++m) {
                float h[8];
#pragma unroll
                for (int n = 0; n < 2; ++n)
#pragma unroll
                    for (int j = 0; j < 4; ++j) h[4 * n + j] = silu_f(acc[ai][0][m][n][j]) * acc[ai][1][m][n][j];
                u32x4 w; w.x = cvt_pk_bf16(h[0], h[1]); w.y = cvt_pk_bf16(h[2], h[3]); w.z = cvt_pk_bf16(h[4], h[5]); w.w = cvt_pk_bf16(h[6], h[7]);
                *(u32x4*)(H + (size_t)(row0 + ai * HALF + m * 16) * DFF + col0) = w;
            }
    }
};
struct EpiRes {
    static constexpr bool PERM = false;
    const float* res; const bf16_t* resb; float* out; float scale;
    __device__ __forceinline__ void operator()(const Acc& acc, const Unit& u, int wr, int wc, int fr, int fq) const {
        const int row0 = u.pm * BM + wr * 64 + fr, col0 = u.pn * BM + wc * 32 + 4 * fq;
#pragma unroll
        for (int ai = 0; ai < 2; ++ai)
#pragma unroll
            for (int m = 0; m < 4; ++m) { const size_t ro = (size_t)(row0 + ai * HALF + m * 16) * DM + col0;
#pragma unroll
                for (int bj = 0; bj < 2; ++bj)
#pragma unroll
                    for (int n = 0; n < 2; ++n) { f32x4 r;
                        if (res) r = *(const f32x4*)(res + ro + bj * HALF + n * 16);
                        else { const u32x2 w = *(const u32x2*)(resb + ro + bj * HALF + n * 16); r = (f32x4){bf_lo(w.x), bf_hi(w.x), bf_lo(w.y), bf_hi(w.y)}; }
                        *(f32x4*)(out + ro + bj * HALF + n * 16) = r * ALPHA + acc[ai][bj][m][n] * scale; } }
    }
};
struct EpiPE {
    static constexpr bool PERM = false;
    float* pe;
    __device__ __forceinline__ void operator()(const Acc& acc, const Unit& u, int wr, int wc, int fr, int fq) const {
        const int row0 = u.pm * BM + wr * 64 + fr, col0 = u.pn * BM + wc * 32 + 4 * fq;
#pragma unroll
        for (int ai = 0; ai < 2; ++ai)
#pragma unroll
            for (int m = 0; m < 4; ++m) { const size_t ro = (size_t)(row0 + ai * HALF + m * 16) * DM + col0;
#pragma unroll
                for (int bj = 0; bj < 2; ++bj)
#pragma unroll
                    for (int n = 0; n < 2; ++n) *(f32x4*)(pe + ro + bj * HALF + n * 16) = acc[ai][bj][m][n]; }
    }
};
struct EpiGate {
    static constexpr bool PERM = false;
    float* X; const float* pe; const bf16_t* xb;
    __device__ __forceinline__ void operator()(const Acc& acc, const Unit& u, int wr, int wc, int fr, int fq) const {
        const int row0 = u.pm * BM + wr * 64 + fr, col0 = u.pn * BM + wc * 32 + 4 * fq;
#pragma unroll
        for (int ai = 0; ai < 2; ++ai)
#pragma unroll
            for (int m = 0; m < 4; ++m) { const size_t ro = (size_t)(row0 + ai * HALF + m * 16) * DM + col0;
#pragma unroll
                for (int bj = 0; bj < 2; ++bj)
#pragma unroll
                    for (int n = 0; n < 2; ++n) { const u32x2 w = *(const u32x2*)(xb + ro + bj * HALF + n * 16); const f32x4 r = (f32x4){bf_lo(w.x), bf_hi(w.x), bf_lo(w.y), bf_hi(w.y)}; const f32x4 pv = *(const f32x4*)(pe + ro + bj * HALF + n * 16);
                        f32x4 o;
#pragma unroll
                        for (int j = 0; j < 4; ++j) o[j] = r[j] * ALPHA + pv[j] * __builtin_amdgcn_rcpf(1.0f + __expf(-acc[ai][bj][m][n][j]));
                        *(f32x4*)(X + ro + bj * HALF + n * 16) = o; } }
    }
};
struct EpiMixIn {
    static constexpr bool PERM = true;
    bf16_t* Hm; const f32x2* cs; const float* loglb;
    __device__ __forceinline__ void operator()(const Acc& acc, const Unit& u, int wr, int wc, int fr, int fq) const {
        const int row0 = u.pm * BM + wr * 64 + fr;
        const int pn = u.pn;
        const int mode = (pn == 6 || pn == 7) ? 1 : (pn == 8 || pn == 9) ? 2 : (pn >= 14 && pn <= 17) ? 3 : (pn == 20 || pn == 21) ? 4 : 0;
#pragma unroll
        for (int ai = 0; ai < 2; ++ai)
#pragma unroll
            for (int m = 0; m < 4; ++m) {
                const int row = row0 + ai * HALF + m * 16;
#pragma unroll
                for (int bj = 0; bj < 2; ++bj) {
                    const int col = pn * BM + bj * HALF + wc * 32 + 8 * fq;
                    float v[8];
#pragma unroll
                    for (int n = 0; n < 2; ++n)
#pragma unroll
                        for (int j = 0; j < 4; ++j) v[4 * n + j] = acc[ai][bj][m][n][j];
                    if (mode == 1 || mode == 2) {
                        const int i0 = (col & 127) >> 1;
                        const f32x4 c01 = *(const f32x4*)(cs + (size_t)row * 64 + i0), c23 = *(const f32x4*)(cs + (size_t)row * 64 + i0 + 2);
                        const float sc = (mode == 2) ? 0.08838834764831845f : 1.0f;
                        const float cc[4] = {c01[0], c01[2], c23[0], c23[2]}, ss[4] = {c01[1], c01[3], c23[1], c23[3]};
#pragma unroll
                        for (int q = 0; q < 4; ++q) { const float x1 = v[2 * q], x2 = v[2 * q + 1]; v[2 * q] = (x1 * cc[q] - x2 * ss[q]) * sc; v[2 * q + 1] = (x1 * ss[q] + x2 * cc[q]) * sc; }
                    } else if (mode == 3) {
#pragma unroll
                        for (int q = 0; q < 8; ++q) v[q] = gelu_f(v[q]);
                    } else if (mode == 4) {
                        const int k0 = col - 5120;
                        const f32x4 l0 = *(const f32x4*)(loglb + k0), l1 = *(const f32x4*)(loglb + k0 + 4);
#pragma unroll
                        for (int q = 0; q < 8; ++q) { const float z = v[q], llb = q < 4 ? l0[q] : l1[q - 4];
                            const float az = fabsf(z), sp = __logf(1.0f + __expf(-az));
                            const float lsp = fminf(z, 0.f) - sp, lsn = fminf(-z, 0.f) - sp;
                            const float a = lsp, b = llb + lsn, mx = fmaxf(a, b), mn = fminf(a, b);
                            v[q] = mx + __logf(1.0f + __expf(mn - mx)); }
                    }
                    u32x4 w; w.x = cvt_pk_bf16(v[0], v[1]); w.y = cvt_pk_bf16(v[2], v[3]); w.z = cvt_pk_bf16(v[4], v[5]); w.w = cvt_pk_bf16(v[6], v[7]);
                    *(u32x4*)(Hm + (size_t)row * INC + col) = w;
                }
            }
    }
};

__device__ void conv_wT(const float* __restrict__ src, bf16_t* __restrict__ dst, int K, int N, int swiglu, LAS unsigned char* lds) {
    const int tid = opaque_tid(), bid = opaque_bid(), tilesN = N / 64, tilesK = K / 64, total = tilesN * tilesK;
    LAS bf16_t* t16 = (LAS bf16_t*)lds;
    for (int tile = bid; tile < total; tile += gridDim.x) {
        const int tn = tile % tilesN, tk = tile / tilesN;
        const int r = tid >> 4, c4 = (tid & 15) * 4;
#pragma unroll
        for (int p = 0; p < 2; ++p) {
            const f32x4 v = *(const f32x4*)(src + (size_t)(tk * 64 + r + 32 * p) * N + tn * 64 + c4);
#pragma unroll
            for (int j = 0; j < 4; ++j) t16[(c4 + j) * 72 + r + 32 * p] = (bf16_t)(cvt_pk_bf16(v[j], 0.f) & 0xffffu);
        }
        __syncthreads();
        const int n = tid >> 3, k8 = (tid & 7) * 8;
        const u32x4 w = *(const LAS u32x4*)(lds + n * 144 + k8 * 2);
        int nsrc = tn * 64 + n, ndst = nsrc;
        if (swiglu) { const int bj = nsrc >= DFF ? 1 : 0, hid = nsrc - DFF * bj; ndst = 256 * (hid >> 7) + 128 * bj + (hid & 127); }
        *(u32x4*)(dst + (size_t)ndst * K + tk * 64 + k8) = w;
        __syncthreads();
    }
}
__device__ void conv_flat(const float* __restrict__ src, bf16_t* __restrict__ dst, size_t n) {
    const size_t stride = (size_t)gridDim.x * 512 * 8;
    for (size_t i = ((size_t)opaque_bid() * 512 + opaque_tid()) * 8; i < n; i += stride) {
        const f32x4 a = *(const f32x4*)(src + i), b = *(const f32x4*)(src + i + 4);
        u32x4 w; w.x = cvt_pk_bf16(a[0], a[1]); w.y = cvt_pk_bf16(a[2], a[3]); w.z = cvt_pk_bf16(b[0], b[1]); w.w = cvt_pk_bf16(b[2], b[3]);
        *(u32x4*)(dst + i) = w;
    }
}
__device__ void prep_phase(const Params& P, LAS unsigned char* lds) {
    unsigned char* ws = P.ws;
    const int tid = opaque_tid(), bid = opaque_bid();
    float* tabf = (float*)(ws + WS_TAB); int* tabi = (int*)(ws + WS_TAB);
    if (bid == 0) {
        { const float l0 = P.lb_logits[tid], l1 = P.lb_logits[512 + tid]; const float s1 = 1.0f / (1.0f + expf(l0 - l1));
          tabf[TB_LOGLB + tid] = logf(1e-30f); tabf[TB_LOGLB + 512 + tid] = logf(fmaxf(s1, 1e-30f)); }
        for (int i2 = tid; i2 < 4 * 129; i2 += 512) { const int h = i2 / 129, n = i2 % 129; int bk;
            if (n < 16) bk = n; else { bk = 16 + (int)(logf((float)n / 16.0f) / 2.0794415416798357f * 16.0f); bk = bk > 31 ? 31 : bk; }
            tabf[TB_LUT + h * 132 + n] = P.rel_bias[bk * 4 + h] * LOG2E; }
        if (tid < DEPTH) { float s1 = 0.f, s2 = 0.f; const float* dl = P.dlam + tid * 256;
            for (int j = 0; j < 64; ++j) { s1 += dl[j] * dl[64 + j]; s2 += dl[128 + j] * dl[192 + j]; }
            const float lam_init = 0.8f - 0.6f * expf(-0.3f * (float)tid);
            tabf[TB_LAM + tid] = expf(s1) - expf(s2) + lam_init; }
        if (tid < 2) ((unsigned*)tabi)[TB_Q + tid] = 0u;
    }
    { f32x2* cs = (f32x2*)(ws + WS_CS);
      for (size_t i = (size_t)bid * 512 + tid; i < (size_t)MTOK * 64; i += (size_t)gridDim.x * 512) {
          const int tok = (int)(i >> 6), fi = (int)(i & 63);
          const double ang = (double)P.pos[tok] * P.inv[fi];
          const double rev = ang * 0.15915494309189535; const float fr = (float)(rev - rint(rev));
          cs[i] = (f32x2){__builtin_amdgcn_cosf(fr), __builtin_amdgcn_sinf(fr)};
      } }
    conv_flat(P.x, (bf16_t*)(ws + WS_XB), (size_t)MTOK * DM);
    conv_flat(P.p, (bf16_t*)(ws + WS_PB), (size_t)DEPTH * MTOK * PLE);
    for (int L = 0; L < DEPTH; ++L) {
        conv_wT(P.ffn1_in + (size_t)L * DM * 2 * DFF, (bf16_t*)(ws + WS_W1IN + L * SZ_W1IN), DM, 2 * DFF, 1, lds);
        conv_wT(P.ffn1_out + (size_t)L * DFF * DM, (bf16_t*)(ws + WS_W1OUT + L * SZ_W1OUT), DFF, DM, 0, lds);
        conv_wT(P.mix_in + (size_t)L * DM * INC, (bf16_t*)(ws + WS_WMI + L * SZ_WMI), DM, INC, 0, lds);
        conv_wT(P.mix_out + (size_t)L * DM * DM, (bf16_t*)(ws + WS_WMO + L * SZ_WMO), DM, DM, 0, lds);
        conv_wT(P.ffn2_in + (size_t)L * DM * 2 * DFF, (bf16_t*)(ws + WS_W2IN + L * SZ_W1IN), DM, 2 * DFF, 1, lds);
        conv_wT(P.ffn2_out + (size_t)L * DFF * DM, (bf16_t*)(ws + WS_W2OUT + L * SZ_W1OUT), DFF, DM, 0, lds);
        conv_wT(P.ple_gate + (size_t)L * DM * DM, (bf16_t*)(ws + WS_WG + L * SZ_WG), DM, DM, 0, lds);
        conv_wT(P.ple_proj + (size_t)L * PLE * DM, (bf16_t*)(ws + WS_WE + L * SZ_WE), PLE, DM, 0, lds);
    }
}

__device__ void ln_phase(float* X, const float* __restrict__ g, const float* __restrict__ b, bf16_t* Xb, bool write_x) {
    const int tid = opaque_tid(); const int lane = tid & 63, gw = opaque_bid() * 8 + (tid >> 6), nw = gridDim.x * 8;
    for (int row = gw; row + nw < MTOK; row += 2 * nw) {
        float* xr0 = X + (size_t)row * DM; float* xr1 = X + (size_t)(row + nw) * DM;
        bf16_t* xb0 = Xb + (size_t)row * DM; bf16_t* xb1 = Xb + (size_t)(row + nw) * DM;
        f32x4 v0[8], v1[8]; float s0 = 0.f, s1 = 0.f;
#pragma unroll
        for (int i = 0; i < 8; ++i) { v0[i] = *(const f32x4*)(xr0 + (i * 64 + lane) * 4); v1[i] = *(const f32x4*)(xr1 + (i * 64 + lane) * 4); }
#pragma unroll
        for (int i = 0; i < 8; ++i) { s0 += v0[i][0] + v0[i][1] + v0[i][2] + v0[i][3]; s1 += v1[i][0] + v1[i][1] + v1[i][2] + v1[i][3]; }
#pragma unroll
        for (int o = 32; o >= 1; o >>= 1) { s0 += shx(s0, o, lane); s1 += shx(s1, o, lane); }
        const float mu0 = s0 * (1.0f / DM), mu1 = s1 * (1.0f / DM); float q0 = 0.f, q1 = 0.f;
#pragma unroll
        for (int i = 0; i < 8; ++i)
#pragma unroll
            for (int j = 0; j < 4; ++j) { const float d0 = v0[i][j] - mu0, d1 = v1[i][j] - mu1; q0 += d0 * d0; q1 += d1 * d1; }
#pragma unroll
        for (int o = 32; o >= 1; o >>= 1) { q0 += shx(q0, o, lane); q1 += shx(q1, o, lane); }
        const float rs0 = rsqrtf(q0 * (1.0f / DM) + 1e-5f), rs1 = rsqrtf(q1 * (1.0f / DM) + 1e-5f);
#pragma unroll
        for (int i = 0; i < 8; ++i) { const int c = (i * 64 + lane) * 4; const f32x4 gg = *(const f32x4*)(g + c), bb = *(const f32x4*)(b + c); f32x4 o0, o1;
#pragma unroll
            for (int j = 0; j < 4; ++j) { o0[j] = (v0[i][j] - mu0) * rs0 * gg[j] + bb[j]; o1[j] = (v1[i][j] - mu1) * rs1 * gg[j] + bb[j]; }
            if (write_x) { *(f32x4*)(xr0 + c) = o0; *(f32x4*)(xr1 + c) = o1; }
            u32x2 w; w.x = cvt_pk_bf16(o0[0], o0[1]); w.y = cvt_pk_bf16(o0[2], o0[3]); *(u32x2*)(xb0 + c) = w;
            u32x2 w1; w1.x = cvt_pk_bf16(o1[0], o1[1]); w1.y = cvt_pk_bf16(o1[2], o1[3]); *(u32x2*)(xb1 + c) = w1; }
    }
}

__device__ void attn_unit(const Params& P, int layer, int b, int h, int qblk, LAS unsigned char* lds) {
    const int tid = opaque_tid(), wid = __builtin_amdgcn_readfirstlane(tid >> 6), lane_ = tid & 63, lane = lane_, l31 = lane & 31, hh = lane >> 5;
    const int c = wid & 1, rb = wid >> 1;
    const bf16_t* Hm = (const bf16_t*)(P.ws + WS_H);
    const float* tabf = (const float*)(P.ws + WS_TAB); const int* tabi = (const int*)(P.ws + WS_TAB);
    LAS float* lut = (LAS float*)(lds + 66048); LAS int* posk = (LAS int*)(lds + 65536); LAS int* pkmx = (LAS int*)(lds + 66576);
    const int q0w = qblk * 128 + rb * 32, qrow = q0w + l31;
    const size_t tok = (size_t)b * SEQ + qrow;
    bf16x8 qf[4];
    { const bf16_t* qp = Hm + tok * INC + h * 128 + c * 64 + 8 * hh;
#pragma unroll
      for (int ks = 0; ks < 4; ++ks) qf[ks] = *(const bf16x8*)(qp + 16 * ks); }
    const int pq = P.pos[b * SEQ + qrow];
    int pqmin = pq;
#pragma unroll
    for (int o = 16; o >= 1; o >>= 1) { const int t = shxi(pqmin, o, lane); pqmin = t < pqmin ? t : pqmin; }
    pqmin = __builtin_amdgcn_readfirstlane(pqmin);
    f32x16 O[4];
#pragma unroll
    for (int d = 0; d < 4; ++d) O[d] = zero16();
    float mrun = -1e30f, lrun = 0.f;
    const int nt = 2 * qblk + 2;
    const float sc2 = 0.125f * LOG2E;
    const int srow = (tid >> 4), sch = tid & 15;
    const bf16_t* gK = Hm + ((size_t)b * SEQ) * INC + 512 + h * 128 + sch * 8;
    const bf16_t* gV = gK + 512;
    u32x4 st[4];
    __syncthreads();
    if (tid < 129) lut[tid] = tabf[TB_LUT + h * 132 + tid];
#define ATT_LOAD(kt) do { const size_t r0 = (size_t)((kt) * 64 + srow) * INC; st[0] = *(const u32x4*)(gK + r0); st[1] = *(const u32x4*)(gK + r0 + (size_t)32 * INC); \
        st[2] = *(const u32x4*)(gV + r0); st[3] = *(const u32x4*)(gV + r0 + (size_t)32 * INC); } while (0)
#define ATT_STORE(buf, kt) do { LAS unsigned char* kb = lds + (buf) * 32768; *(LAS u32x4*)(kb + off_b(srow, sch)) = st[0]; *(LAS u32x4*)(kb + off_b(srow + 32, sch)) = st[1]; \
        *(LAS u32x4*)(kb + 16384 + off_b(srow, sch)) = st[2]; *(LAS u32x4*)(kb + 16384 + off_b(srow + 32, sch)) = st[3]; \
        if (tid < 64) { int pv_ = P.pos[b * SEQ + (kt) * 64 + tid]; posk[(buf) * 64 + tid] = pv_; _Pragma("unroll") for (int o_ = 32; o_ >= 1; o_ >>= 1) { const int t_ = shxi(pv_, o_, lane_); pv_ = t_ > pv_ ? t_ : pv_; } if (tid == 0) pkmx[buf] = pv_; } } while (0)
    ATT_LOAD(0); ATT_STORE(0, 0);
    __syncthreads();
    for (int kt = 0; kt < nt; ++kt) {
        const int buf = kt & 1, k0 = kt * 64;
        if (kt + 1 < nt) ATT_LOAD(kt + 1);
        if (k0 <= q0w + 31) {
            int lane = lane_; asm volatile("" : "+v"(lane)); const int l31 = lane & 31, hh = lane >> 5;
            LAS const unsigned char* Kimg = lds + buf * 32768; LAS const unsigned char* Vimg = Kimg + 16384;
            f32x16 S[2];
            __builtin_amdgcn_s_setprio(1);
#pragma unroll
            for (int s2 = 0; s2 < 2; ++s2) { S[s2] = zero16();
#pragma unroll
                for (int ks = 0; ks < 4; ++ks) { const bf16x8 a = *(const LAS bf16x8*)(Kimg + off_b(32 * s2 + l31, 8 * c + 2 * ks + hh)); S[s2] = mfma32(a, qf[ks], S[s2]); } }
            __builtin_amdgcn_s_setprio(0);
            const bool far = (pqmin - pkmx[buf]) >= 128;
            const bool needmask = (k0 + 63 > q0w);
            float mnew, rsum = 0.f;
            if (far && !needmask) {
                const float cb = lut[128];
                float mx = S[0][0];
#pragma unroll
                for (int s2 = 0; s2 < 2; ++s2)
#pragma unroll
                    for (int i = 0; i < 16; ++i) mx = fmaxf(mx, S[s2][i]);
                mx = fmaxf(mx, shx(mx, 32, lane));
                mnew = fmaxf(mrun, mx * sc2 + cb);
                const float off = cb - mnew;
#pragma unroll
                for (int s2 = 0; s2 < 2; ++s2)
#pragma unroll
                    for (int i = 0; i < 16; ++i) { const float pe = __builtin_amdgcn_exp2f(S[s2][i] * sc2 + off); S[s2][i] = pe; rsum += pe; }
            } else {
                if (far) { const float cb = lut[128];
#pragma unroll
                    for (int s2 = 0; s2 < 2; ++s2)
#pragma unroll
                        for (int i = 0; i < 16; ++i) S[s2][i] = S[s2][i] * sc2 + cb;
                } else {
#pragma unroll
                    for (int s2 = 0; s2 < 2; ++s2)
#pragma unroll
                        for (int i = 0; i < 16; ++i) { const int kk = 32 * s2 + 8 * (i >> 2) + 4 * hh + (i & 3); int rel = pq - posk[buf * 64 + kk]; rel = rel < 0 ? 0 : (rel > 128 ? 128 : rel);
                            S[s2][i] = S[s2][i] * sc2 + lut[rel]; }
                }
                if (needmask) {
#pragma unroll
                    for (int s2 = 0; s2 < 2; ++s2)
#pragma unroll
                        for (int i = 0; i < 16; ++i) { const int kk = k0 + 32 * s2 + 8 * (i >> 2) + 4 * hh + (i & 3); if (kk > qrow) S[s2][i] = -1e30f; }
                }
                float mx = S[0][0];
#pragma unroll
                for (int s2 = 0; s2 < 2; ++s2)
#pragma unroll
                    for (int i = 0; i < 16; ++i) mx = fmaxf(mx, S[s2][i]);
                mx = fmaxf(mx, shx(mx, 32, lane));
                mnew = fmaxf(mrun, mx);
#pragma unroll
                for (int s2 = 0; s2 < 2; ++s2)
#pragma unroll
                    for (int i = 0; i < 16; ++i) { const float pe = __builtin_amdgcn_exp2f(S[s2][i] - mnew); S[s2][i] = pe; rsum += pe; }
            }
            const float alpha = __builtin_amdgcn_exp2f(mrun - mnew);
            rsum += shx(rsum, 32, lane);
            lrun = lrun * alpha + rsum; mrun = mnew;
            if (__builtin_amdgcn_ballot_w64(alpha != 1.0f) != 0ull) {
#pragma unroll
                for (int d = 0; d < 4; ++d)
#pragma unroll
                    for (int i = 0; i < 16; ++i) O[d][i] *= alpha;
            }
            __builtin_amdgcn_s_setprio(1);
#pragma unroll
            for (int s2 = 0; s2 < 2; ++s2)
#pragma unroll
                for (int sp = 0; sp < 2; ++sp) {
                    const bf16x8 pf = pack8(S[s2][8 * sp + 0], S[s2][8 * sp + 1], S[s2][8 * sp + 2], S[s2][8 * sp + 3], S[s2][8 * sp + 4], S[s2][8 * sp + 5], S[s2][8 * sp + 6], S[s2][8 * sp + 7]);
                    const unsigned rbase = 32 * s2 + 16 * sp + 4 * hh;
#pragma unroll
                    for (int d = 0; d < 4; ++d) { const bf16x8 va = cat8(tr_read(Vimg, lane, rbase, d), tr_read(Vimg, lane, rbase + 8, d)); O[d] = mfma32(va, pf, O[d]); }
                }
            __builtin_amdgcn_s_setprio(0);
        }
        if (kt + 1 < nt) ATT_STORE(buf ^ 1, kt + 1);
        __syncthreads();
    }
#undef ATT_LOAD
#undef ATT_STORE
    LAS float* X = (LAS float*)lds;
    const float inv_l = 1.0f / lrun;
    if (c == 1) {
#pragma unroll
        for (int d = 0; d < 4; ++d)
#pragma unroll
            for (int i = 0; i < 16; ++i) X[(rb * 64 + d * 16 + i) * 64 + lane] = O[d][i] * inv_l;
    }
    __syncthreads();
    if (c == 0) {
        const float lam = tabf[TB_LAM + layer];
        const float lam_init = 0.8f - 0.6f * __expf(-0.3f * (float)layer);
        float ss = 0.f;
#pragma unroll
        for (int d = 0; d < 4; ++d)
#pragma unroll
            for (int i = 0; i < 16; ++i) { const float v = O[d][i] * inv_l - lam * X[(rb * 64 + d * 16 + i) * 64 + lane]; O[d][i] = v; ss += v * v; }
        ss += shx(ss, 32, lane);
        const float rs = rsqrtf(ss * (1.0f / 128.0f) + 1e-5f) * (1.0f - lam_init);
        bf16_t* Ob = (bf16_t*)(P.ws + WS_XB) + tok * DM + h * 128;
        const float* ng = P.dnorm_g + layer * 128;
#pragma unroll
        for (int d = 0; d < 4; ++d)
#pragma unroll
            for (int g4 = 0; g4 < 4; ++g4) { const int e0 = 32 * d + 8 * g4 + 4 * hh; const f32x4 gg = *(const f32x4*)(ng + e0);
                u32x2 w; w.x = cvt_pk_bf16(O[d][4 * g4] * rs * gg[0], O[d][4 * g4 + 1] * rs * gg[1]); w.y = cvt_pk_bf16(O[d][4 * g4 + 2] * rs * gg[2], O[d][4 * g4 + 3] * rs * gg[3]);
                *(u32x2*)(Ob + e0) = w; }
    }
    __syncthreads();
}

__device__ void gla_stream(const Params& P, int layer, int type, int b, int h, int sl, LAS unsigned char* lds) {
    const int tid = opaque_tid(), wid = __builtin_amdgcn_readfirstlane(tid >> 6), lane = tid & 63;
    const bf16_t* Hm = (const bf16_t*)(P.ws + WS_H);
    bf16_t* Ob = (bf16_t*)(P.ws + WS_XB);
    float* stat = (float*)(P.ws + WS_STAT);
    const int qcol = (type ? 4608 : 1536) + h * 128, kcol = (type ? 5120 : 2048) + h * 128, vcol = (type ? 5632 : 2560) + h * 128 + 32 * sl,
              ocol = (type ? 1536 : 512) + h * 128 + 32 * sl;
    const float gam = 1.0f - exp2f(-5.0f - (float)h);
    LAS float* FF = (LAS float*)lds; LAS unsigned* QK = (LAS unsigned*)lds + 2048; LAS float* VF = FF + 4096; LAS float* OP = FF + 4608;
    const int e_l = tid & 15, kg = tid >> 4;
    const int stok = tid >> 5, sc4 = (tid & 31) * 4;
    const int vtok = (tid >> 4) & 15, vc2 = (tid & 15) * 2;
    float S0[4] = {0.f, 0.f, 0.f, 0.f}, S1[4] = {0.f, 0.f, 0.f, 0.f};
    u32x2 pq2, pk2; unsigned pv1 = 0u;
    const bf16_t* gbase = Hm + ((size_t)b * SEQ + stok) * INC + sc4;
    const bf16_t* vbase = Hm + ((size_t)b * SEQ + vtok) * INC + vcol + vc2;
#define GLS_LOAD(bt) do { const bf16_t* gp = gbase + (size_t)(bt) * 16 * INC; pq2 = *(const u32x2*)(gp + qcol); pk2 = *(const u32x2*)(gp + kcol); \
        if (tid < 256) pv1 = *(const unsigned*)(vbase + (size_t)(bt) * 16 * INC); } while (0)
    GLS_LOAD(0);
    __syncthreads();
    for (int bt = 0; bt < 512; ++bt) {
        const size_t T0 = (size_t)b * SEQ + (size_t)bt * 16;
        { const int o = stok * 128 + sc4;
          if (type) { const float l0 = bf_lo(pk2.x), l1 = bf_hi(pk2.x), l2 = bf_lo(pk2.y), l3 = bf_hi(pk2.y);
              *(LAS f32x4*)(FF + o) = (f32x4){__expf(l0), __expf(l1), __expf(l2), __expf(l3)};
              const unsigned k01 = cvt_pk_bf16(1.0f - __expf(l0), 1.0f - __expf(l1)), k23 = cvt_pk_bf16(1.0f - __expf(l2), 1.0f - __expf(l3));
              *(LAS u32x4*)(QK + o) = (u32x4){(pq2.x & 0xffffu) | (k01 << 16), (pq2.x >> 16) | (k01 & 0xffff0000u), (pq2.y & 0xffffu) | (k23 << 16), (pq2.y >> 16) | (k23 & 0xffff0000u)}; }
          else {
              *(LAS u32x4*)(QK + o) = (u32x4){(pq2.x & 0xffffu) | (pk2.x << 16), (pq2.x >> 16) | (pk2.x & 0xffff0000u), (pq2.y & 0xffffu) | (pk2.y << 16), (pq2.y >> 16) | (pk2.y & 0xffff0000u)}; }
          if (tid < 256) { VF[vtok * 32 + vc2] = bf_lo(pv1); VF[vtok * 32 + vc2 + 1] = bf_hi(pv1); } }
        if (bt + 1 < 512) GLS_LOAD(bt + 1);
        __syncthreads();
        float accs[32];
#pragma unroll
        for (int tt = 0; tt < 16; ++tt) {
            const float v0 = VF[tt * 32 + e_l], v1 = VF[tt * 32 + 16 + e_l];
            f32x4 f4 = (f32x4){gam, gam, gam, gam}; if (type) f4 = *(const LAS f32x4*)(FF + tt * 128 + 4 * kg);
            const u32x4 qk = *(const LAS u32x4*)(QK + tt * 128 + 4 * kg);
            const unsigned qw[4] = {qk.x, qk.y, qk.z, qk.w};
            float a0 = 0.f, a1 = 0.f;
#pragma unroll
            for (int j = 0; j < 4; ++j) { const float q = bf_lo(qw[j]), c = bf_hi(qw[j]);
                S0[j] = f4[j] * S0[j] + c * v0; S1[j] = f4[j] * S1[j] + c * v1; a0 += q * S0[j]; a1 += q * S1[j]; }
            accs[2 * tt] = a0; accs[2 * tt + 1] = a1;
        }
        { const bool b0 = (lane & 16) != 0, b1 = (lane & 32) != 0;
          float r16[16];
#pragma unroll
          for (int i = 0; i < 16; ++i) r16[i] = swapadd16(accs[i], accs[16 + i]);
          float r8[8];
#pragma unroll
          for (int i = 0; i < 8; ++i) r8[i] = swapadd32(r16[i], r16[8 + i]);
          const int vb = (b0 ? 16 : 0) + (b1 ? 8 : 0);
#pragma unroll
          for (int i = 0; i < 8; ++i) { const int vi = vb + i; OP[((vi >> 1) * 8 + wid) * 32 + (vi & 1) * 16 + e_l] = r8[i]; } }
        __syncthreads();
        { const int tt = tid >> 5, e32 = tid & 31; const size_t tok = T0 + tt;
            float o = 0.f;
#pragma unroll
            for (int w = 0; w < 8; ++w) o += OP[(tt * 8 + w) * 32 + e32];
            Ob[tok * DM + ocol + e32] = (bf16_t)(cvt_pk_bf16(o, 0.f) & 0xffffu);
            float s1 = o, s2 = o * o;
#pragma unroll
            for (int of = 16; of >= 1; of >>= 1) { s1 += shx(s1, of, lane); s2 += shx(s2, of, lane); }
            if (e32 == 0) *(f32x4*)(stat + ((((size_t)type * MTOK + tok) * 4 + h) * 8 + 2 * sl) * 2) = (f32x4){s1, s2, 0.f, 0.f}; }
    }
#undef GLS_LOAD
    __syncthreads();
}

__device__ void gla_post_phase(const Params& P, int layer) {
    bf16_t* Ob = (bf16_t*)(P.ws + WS_XB); const bf16_t* Hm = (const bf16_t*)(P.ws + WS_H); const float* stat = (const float*)(P.ws + WS_STAT);
    const float* ng = P.hg_norm_g + layer * 512;
    const int tid = opaque_tid(); const int lane = tid & 63, gw = opaque_bid() * 8 + (tid >> 6), nw = gridDim.x * 8;
    const int hd = lane >> 4;
    const f32x4 n0 = *(const f32x4*)(ng + lane * 8), n1 = *(const f32x4*)(ng + lane * 8 + 4);
    const float nn[8] = {n0[0], n0[1], n0[2], n0[3], n1[0], n1[1], n1[2], n1[3]};
    for (int tok0 = gw; tok0 + nw < MTOK; tok0 += 2 * nw) {
        u32x4 wb[2], gb[2], wd[2], gd[2]; f32x4 sb[2][4], sd[2][16];
#pragma unroll
        for (int r = 0; r < 2; ++r) { const size_t tok = (size_t)(tok0 + r * nw);
            wb[r] = *(const u32x4*)(Ob + tok * DM + 512 + lane * 8); gb[r] = *(const u32x4*)(Hm + tok * INC + 3072 + lane * 8);
            wd[r] = *(const u32x4*)(Ob + tok * DM + 1536 + lane * 8); gd[r] = *(const u32x4*)(Hm + tok * INC + 6144 + lane * 8);
            const float* spb = stat + (tok * 4 + hd) * 16; const float* spd = stat + (((size_t)MTOK + tok) * 4) * 16;
#pragma unroll
            for (int q = 0; q < 4; ++q) sb[r][q] = *(const f32x4*)(spb + 4 * q);
#pragma unroll
            for (int q = 0; q < 16; ++q) sd[r][q] = *(const f32x4*)(spd + 4 * q); }
#pragma unroll
        for (int r = 0; r < 2; ++r) { const size_t tok = (size_t)(tok0 + r * nw);
            float s1 = 0.f, s2 = 0.f, d2 = 0.f;
#pragma unroll
            for (int q = 0; q < 4; ++q) { s1 += sb[r][q][0] + sb[r][q][2]; s2 += sb[r][q][1] + sb[r][q][3]; }
#pragma unroll
            for (int q = 0; q < 16; ++q) d2 += sd[r][q][1] + sd[r][q][3];
            const float mu = s1 * (1.0f / 128.0f), var = fmaxf(s2 * (1.0f / 128.0f) - mu * mu, 0.f), rs = rsqrtf(var + 1e-5f);
            const float rsd = rsqrtf(d2 * (1.0f / 512.0f) + 1e-5f);
            const unsigned ww[4] = {wb[r].x, wb[r].y, wb[r].z, wb[r].w}, gg[4] = {gb[r].x, gb[r].y, gb[r].z, gb[r].w};
            const unsigned wx[4] = {wd[r].x, wd[r].y, wd[r].z, wd[r].w}, gx[4] = {gd[r].x, gd[r].y, gd[r].z, gd[r].w};
            unsigned ob[4], od[4];
#pragma unroll
            for (int j = 0; j < 4; ++j) {
                ob[j] = cvt_pk_bf16((bf_lo(ww[j]) - mu) * rs * silu_f(bf_lo(gg[j])), (bf_hi(ww[j]) - mu) * rs * silu_f(bf_hi(gg[j])));
                od[j] = cvt_pk_bf16(bf_lo(wx[j]) * rsd * nn[2 * j] * silu_f(bf_lo(gx[j])), bf_hi(wx[j]) * rsd * nn[2 * j + 1] * silu_f(bf_hi(gx[j]))); }
            *(u32x4*)(Ob + tok * DM + 512 + lane * 8) = (u32x4){ob[0], ob[1], ob[2], ob[3]};
            *(u32x4*)(Ob + tok * DM + 1536 + lane * 8) = (u32x4){od[0], od[1], od[2], od[3]}; }
    }
}

__device__ void gmlp_unit(const Params& P, int layer, int b, int chunk, LAS unsigned char* lds) {
    constexpr unsigned VIMG = 0, WIMG = 32768, MU = 65536, RS = 66048;
    const int tid = opaque_tid(), wid = __builtin_amdgcn_readfirstlane(tid >> 6), lane = tid & 63, l31 = lane & 31, hh = lane >> 5;
    const bf16_t* Hm = (const bf16_t*)(P.ws + WS_H);
    bf16_t* Ob = (bf16_t*)(P.ws + WS_XB);
    const size_t T0 = (size_t)b * SEQ + chunk * 128;
    __syncthreads();
    for (int i = 0; i < 16; ++i) { const int t = wid * 16 + i; const u32x4 w = *(const u32x4*)(Hm + (T0 + t) * INC + 4096 + lane * 8);
        const float v[8] = {bf_lo(w.x), bf_hi(w.x), bf_lo(w.y), bf_hi(w.y), bf_lo(w.z), bf_hi(w.z), bf_lo(w.w), bf_hi(w.w)};
        float s = 0.f;
#pragma unroll
        for (int j = 0; j < 8; ++j) s += v[j];
#pragma unroll
        for (int o = 32; o >= 1; o >>= 1) s += shx(s, o, lane);
        const float mu = s * (1.0f / 512.0f); float q = 0.f;
#pragma unroll
        for (int j = 0; j < 8; ++j) { const float d = v[j] - mu; q += d * d; }
#pragma unroll
        for (int o = 32; o >= 1; o >>= 1) q += shx(q, o, lane);
        if (lane == 0) { ((LAS float*)(lds + MU))[t] = mu; ((LAS float*)(lds + RS))[t] = rsqrtf(q * (1.0f / 512.0f) + 1e-5f); } }
    __syncthreads();
    const int tb = wid & 3, ct0 = 2 * (wid >> 2);
    for (int g = 0; g < 4; ++g) {
        const float* lg = P.g_ln_g + layer * 512 + g * 128; const float* lb = P.g_ln_b + layer * 512 + g * 128;
        const float* Wg = P.g_ws + ((size_t)(layer * 4 + g)) * 128 * 128;
#pragma unroll
        for (int i = 0; i < 4; ++i) { const int n = tid + 512 * i, s = n >> 4, ch = n & 15;
            const u32x4 w = *(const u32x4*)(Hm + (T0 + s) * INC + 4096 + g * 128 + ch * 8);
            const float mu = ((LAS float*)(lds + MU))[s], rs = ((LAS float*)(lds + RS))[s];
            const f32x4 g0 = *(const f32x4*)(lg + ch * 8), g1 = *(const f32x4*)(lg + ch * 8 + 4), b0 = *(const f32x4*)(lb + ch * 8), b1 = *(const f32x4*)(lb + ch * 8 + 4);
            const float v[8] = {bf_lo(w.x), bf_hi(w.x), bf_lo(w.y), bf_hi(w.y), bf_lo(w.z), bf_hi(w.z), bf_lo(w.w), bf_hi(w.w)};
            float y[8];
#pragma unroll
            for (int j = 0; j < 8; ++j) y[j] = (v[j] - mu) * rs * (j < 4 ? g0[j] : g1[j - 4]) + (j < 4 ? b0[j] : b1[j - 4]);
            *(LAS bf16x8*)(lds + VIMG + off_b(s, ch)) = pack8(y[0], y[1], y[2], y[3], y[4], y[5], y[6], y[7]);
            const f32x4 w0 = *(const f32x4*)(Wg + s * 128 + ch * 8), w1 = *(const f32x4*)(Wg + s * 128 + ch * 8 + 4);
            float ww[8];
#pragma unroll
            for (int j = 0; j < 8; ++j) ww[j] = (ch * 8 + j <= s) ? (j < 4 ? w0[j] : w1[j - 4]) : 0.f;
            *(LAS bf16x8*)(lds + WIMG + off_b(s, ch)) = pack8(ww[0], ww[1], ww[2], ww[3], ww[4], ww[5], ww[6], ww[7]); }
        __syncthreads();
        f32x16 acc[2]; acc[0] = zero16(); acc[1] = zero16();
        for (int ks = 0; ks < 2 * (tb + 1); ++ks) {
            const bf16x8 bw = *(const LAS bf16x8*)(lds + WIMG + off_b(32 * tb + l31, 2 * ks + hh));
#pragma unroll
            for (int e = 0; e < 2; ++e) { const bf16x8 av = cat8(tr_read(lds + VIMG, lane, 16 * ks + 8 * hh, ct0 + e), tr_read(lds + VIMG, lane, 16 * ks + 8 * hh + 4, ct0 + e)); acc[e] = mfma32(av, bw, acc[e]); }
        }
        { const int t = 32 * tb + l31; const size_t tok = T0 + t; const float bs = P.g_bs[(layer * 4 + g) * 128 + t];
#pragma unroll
          for (int e = 0; e < 2; ++e)
#pragma unroll
              for (int g4 = 0; g4 < 4; ++g4) { const int c0 = 32 * (ct0 + e) + 8 * g4 + 4 * hh;
                  const u32x2 uw = *(const u32x2*)(Hm + tok * INC + 3584 + g * 128 + c0);
                  u32x2 w; w.x = cvt_pk_bf16(bf_lo(uw.x) * (acc[e][4 * g4] + bs), bf_hi(uw.x) * (acc[e][4 * g4 + 1] + bs)); w.y = cvt_pk_bf16(bf_lo(uw.y) * (acc[e][4 * g4 + 2] + bs), bf_hi(uw.y) * (acc[e][4 * g4 + 3] + bs));
                  *(u32x2*)(Ob + tok * DM + 1024 + g * 128 + c0) = w; } }
        __syncthreads();
    }
}

__device__ void mixer_phase(const Params& P, int layer, LAS unsigned char* lds) {
    unsigned* qc = (unsigned*)(P.ws + WS_TAB) + TB_Q + layer;
    LAS unsigned* slot = (LAS unsigned*)(lds + LDS_BYTES - 16);
    for (;;) {
        __syncthreads();
        if (threadIdx.x == 0) *slot = atomicAdd(qc, 1u);
        __syncthreads();
        const int item = (int)*slot;
        if (item >= 128 + 512 + 256) break;
        if (item < 128) { const int st = item >> 2; gla_stream(P, layer, 1 - (st >> 4), (st >> 2) & 3, st & 3, item & 3, lds); }
        else if (item < 640) { const int a = item - 128, bh = a >> 5, pr = a & 31;
            for (int u2 = 0; u2 < 2; ++u2) attn_unit(P, layer, bh >> 2, bh & 3, u2 ? pr : 63 - pr, lds); }
        else { const int c = item - 640; gmlp_unit(P, layer, c >> 6, c & 63, lds); }
    }
}

__device__ __forceinline__ void grid_barrier(unsigned* ctr, unsigned nbar) {
    asm volatile("s_waitcnt vmcnt(0)" ::: "memory");
    __syncthreads();
    if (threadIdx.x == 0) {
        __builtin_amdgcn_fence(__ATOMIC_RELEASE, "agent");
        asm volatile("s_waitcnt vmcnt(0)" ::: "memory");
        const unsigned gsz = gridDim.x >> 3;
        unsigned* gc = ctr + (blockIdx.x & 7u) * 32u; unsigned* glob = ctr + 8u * 32u;
        const unsigned old = __hip_atomic_fetch_add(gc, 1u, __ATOMIC_RELAXED, __HIP_MEMORY_SCOPE_AGENT);
        if (old + 1u == nbar * gsz) __hip_atomic_fetch_add(glob, 1u, __ATOMIC_RELAXED, __HIP_MEMORY_SCOPE_AGENT);
        while (__hip_atomic_load(glob, __ATOMIC_RELAXED, __HIP_MEMORY_SCOPE_AGENT) < nbar * 8u) __builtin_amdgcn_s_sleep(1);
        __builtin_amdgcn_fence(__ATOMIC_ACQUIRE, "agent");
        asm volatile("s_waitcnt vmcnt(0)" ::: "memory");
    }
    __syncthreads();
}

template <class Epi> __device__ __forceinline__ void run_gemm(LAS unsigned char* lds, const bf16_t* A, const bf16_t* Bt, int N, int K, const Epi& E) {
    pg8::Gemm g; g.A = A; g.Bt = Bt; g.M = MTOK; g.N = N; g.K = K;
    pg8::StaticOrder S; S.init(MTOK, N, (int)gridDim.x, opaque_bid());
    pg8::gemm_phase<Epi>(lds, g, S, E);
}

typedef const __attribute__((address_space(4))) Params* KParamsPtr;
__global__ __launch_bounds__(512, 2) void fwd_megakernel(const Params Pin) {
    extern __shared__ __attribute__((aligned(16))) unsigned char shm[];
    LAS unsigned char* lds = (LAS unsigned char*)shm;
    cg::grid_group grid = cg::this_grid();
    const KParamsPtr kp = (KParamsPtr)__builtin_amdgcn_kernarg_segment_ptr();
    unsigned nbar = 0u;
    for (int ph = Pin.ph_lo; ph < Pin.ph_hi; ++ph) {
        if (Pin.ph_lo < 0) grid.sync();
        if (ph > Pin.ph_lo) { nbar += 1u; grid_barrier((unsigned*)(Pin.ws + WS_TAB) + 8000, nbar); }
        KParamsPtr kq = kp; asm volatile("" : "+s"(kq));
        const Params& P = *(const Params*)kq;
        unsigned char* ws = P.ws;
        float* X = P.out;
        bf16_t* Xb = (bf16_t*)(ws + WS_XB);
        bf16_t* Hb = (bf16_t*)(ws + WS_H);
        if (ph == 0) { prep_phase(P, lds); continue; }
        const int L = (ph - 1) / 13, s = (ph - 1) % 13;
        { const int lnk = (s == 2) ? 0 : (s == 7) ? 1 : (s == 10) ? 2 : (s == 12) ? 3 : -1;
          if (lnk >= 0) { ln_phase(X, P.ln_g + (L * 4 + lnk) * DM, P.ln_b + (L * 4 + lnk) * DM, Xb, lnk == 0 || (lnk == 3 && L == DEPTH - 1)); continue; } }
        switch (s) {
        case 0: { EpiSwiGLU E; E.H = Hb; run_gemm(lds, Xb, (const bf16_t*)(ws + WS_W1IN + L * SZ_W1IN), 2 * DFF, DM, E); } break;
        case 1: { EpiRes E; E.res = (L == 0) ? P.x : nullptr; E.resb = Xb; E.out = X; E.scale = 0.5f; run_gemm(lds, Hb, (const bf16_t*)(ws + WS_W1OUT + L * SZ_W1OUT), DM, DFF, E); } break;
        case 3: { EpiMixIn E; E.Hm = Hb; E.cs = (const f32x2*)(ws + WS_CS); E.loglb = (const float*)(ws + WS_TAB) + TB_LOGLB + L * 512;
                  run_gemm(lds, Xb, (const bf16_t*)(ws + WS_WMI + L * SZ_WMI), INC, DM, E); } break;
        case 4: mixer_phase(P, L, lds); break;
        case 5: gla_post_phase(P, L); break;
        case 6: { EpiRes E; E.res = X; E.resb = nullptr; E.out = X; E.scale = 1.0f; run_gemm(lds, Xb, (const bf16_t*)(ws + WS_WMO + L * SZ_WMO), DM, DM, E); } break;
        case 8: { EpiSwiGLU E; E.H = Hb; run_gemm(lds, Xb, (const bf16_t*)(ws + WS_W2IN + L * SZ_W1IN), 2 * DFF, DM, E); } break;
        case 9: { EpiRes E; E.res = nullptr; E.resb = Xb; E.out = X; E.scale = 0.5f; run_gemm(lds, Hb, (const bf16_t*)(ws + WS_W2OUT + L * SZ_W1OUT), DM, DFF, E); } break;
        case 11: { EpiPE E1; E1.pe = (float*)(ws + WS_H); run_gemm(lds, (const bf16_t*)(ws + WS_PB) + (size_t)L * MTOK * PLE, (const bf16_t*)(ws + WS_WE + L * SZ_WE), DM, PLE, E1);
                   EpiGate E2; E2.X = X; E2.pe = (const float*)(ws + WS_H); E2.xb = Xb; run_gemm(lds, Xb, (const bf16_t*)(ws + WS_WG + L * SZ_WG), DM, DM, E2); } break;
        }
    }
}

extern "C" void kernel_launch(void* const* d_in, const int* in_sizes, int n_in, void* d_out, int out_size, void* d_ws, size_t ws_size, hipStream_t stream) {
    static int grid = 0;
    if (grid == 0) {
        if (n_in != 22 || out_size != MTOK * DM || ws_size < WS_END) { fprintf(stderr, "kernel_launch: unexpected shapes (n_in %d out %d ws %zu need %zu)\n", n_in, out_size, ws_size, (size_t)WS_END); grid = -1; return; }
        int dev = 0, cus = 0, per_cu = 0;
        (void)hipGetDevice(&dev); (void)hipDeviceGetAttribute(&cus, hipDeviceAttributeMultiprocessorCount, dev);
        if (hipFuncSetAttribute((const void*)fwd_megakernel, hipFuncAttributeMaxDynamicSharedMemorySize, LDS_BYTES) != hipSuccess) { fprintf(stderr, "kernel_launch: hipFuncSetAttribute failed\n"); grid = -1; return; }
        if (hipOccupancyMaxActiveBlocksPerMultiprocessor(&per_cu, (const void*)fwd_megakernel, 512, LDS_BYTES) != hipSuccess || per_cu < 1) { fprintf(stderr, "kernel_launch: occupancy query says %d\n", per_cu); per_cu = 1; }
        (void)hipGetLastError();
        grid = cus & ~7;
    }
    if (grid < 0) return;
    Params p; memset(&p, 0, sizeof(p));
    p.x = (const float*)d_in[0]; p.p = (const float*)d_in[1]; p.pos = (const int*)d_in[2];
    p.ffn1_in = (const float*)d_in[3]; p.ffn1_out = (const float*)d_in[4]; p.mix_in = (const float*)d_in[5]; p.mix_out = (const float*)d_in[6];
    p.rel_bias = (const float*)d_in[7]; p.dlam = (const float*)d_in[8]; p.dnorm_g = (const float*)d_in[9]; p.g_ln_g = (const float*)d_in[10]; p.g_ln_b = (const float*)d_in[11];
    p.g_ws = (const float*)d_in[12]; p.g_bs = (const float*)d_in[13]; p.lb_logits = (const float*)d_in[14]; p.hg_norm_g = (const float*)d_in[15];
    p.ffn2_in = (const float*)d_in[16]; p.ffn2_out = (const float*)d_in[17]; p.ple_gate = (const float*)d_in[18]; p.ple_proj = (const float*)d_in[19];
    p.ln_g = (const float*)d_in[20]; p.ln_b = (const float*)d_in[21];
    p.out = (float*)d_out; p.ws = (unsigned char*)d_ws;
    p.ph_lo = 0; p.ph_hi = NPH;
    for (int i = 0; i < 64; ++i) p.inv[i] = pow(10000.0, -(double)i / 63.0);
    (void)hipMemsetAsync((unsigned char*)d_ws + WS_TAB + 32000, 0, 9 * 128, stream);
    void* args[] = {&p};
    hipError_t e = hipLaunchCooperativeKernel((const void*)fwd_megakernel, dim3(grid), dim3(512), args, LDS_BYTES, stream);
    if (e != hipSuccess) fprintf(stderr, "kernel_launch: cooperative launch failed: %s (grid %d)\n", hipGetErrorString(e), grid);
}
```
